# Optimizing an MI355X kernel written in HIP

```python
import math, functools
import jax, jax.numpy as jnp
from jax import lax
import numpy as np

D_MODEL = 2048
BATCH = 4
SEQ = 8192
DEPTH = 2
DEC_BATCH = 32
DEC_SEQ = 16
PAST_LEN = 2048

CHUNK = 64
Q_BLOCK = 128
EPS = 1e-6
ROPE_BASE = 10000.0
D_FF = 5632
SSD_INNER = D_MODEL
SSD_HEAD_DIM = 64
SSD_HEADS = SSD_INNER // SSD_HEAD_DIM
SSD_GROUPS = 4
SSD_HPG = SSD_HEADS // SSD_GROUPS
SSD_STATE = 128
CONV_K = 4
CONV_DIM = SSD_INNER + 2 * SSD_GROUPS * SSD_STATE
RET_HEAD_DIM = 256
RET_INNER = D_MODEL
RET_HEADS = RET_INNER // RET_HEAD_DIM
AB_IN = SSD_INNER + CONV_DIM + SSD_HEADS + 4 * RET_INNER
AB_SPLITS = (SSD_INNER, SSD_INNER + CONV_DIM, SSD_INNER + CONV_DIM + SSD_HEADS,
             SSD_INNER + CONV_DIM + SSD_HEADS + RET_INNER,
             SSD_INNER + CONV_DIM + SSD_HEADS + 2 * RET_INNER,
             SSD_INNER + CONV_DIM + SSD_HEADS + 3 * RET_INNER)
AB_OUT = SSD_INNER + RET_INNER
MLA_HEADS = D_MODEL // 128
Q_LORA = 512
KV_LORA = 512
QK_NOPE = 128
QK_ROPE = 64
V_HEAD = 128
C_IN = Q_LORA + KV_LORA + QK_ROPE
MLA_SCALE = (QK_NOPE + QK_ROPE) ** -0.5
MEM_TOKENS = 256
MEM_HEADS = 4
MEM_HEAD_DIM = 128
MEM_INNER = MEM_HEADS * MEM_HEAD_DIM
N_EVEN = (DEPTH + 1) // 2
N_ODD = DEPTH // 2

kernel_name = 'hybrid_ssd_retention_mla_streaming_step'


def _rms(x):
    xf = x.astype(jnp.float32)
    return xf * lax.rsqrt(jnp.mean(xf * xf, axis=-1, keepdims=True) + EPS)


def rmsnorm(x, g):
    return (_rms(x) * g).astype(x.dtype)


def rope(x, pos):
    half = x.shape[-1] // 2
    inv = ROPE_BASE ** (-jnp.arange(half, dtype=jnp.float32) / half)
    ang = pos.astype(jnp.float32)[:, None] * inv[None, :]
    cos, sin = jnp.cos(ang)[:, None, :], jnp.sin(ang)[:, None, :]
    x1, x2 = x[..., :half], x[..., half:]
    return jnp.concatenate([x1 * cos - x2 * sin, x2 * cos + x1 * sin], axis=-1).astype(x.dtype)


def swiglu(xn, w1, w2):
    a, b = jnp.split(xn @ w1, 2, axis=-1)
    return (jax.nn.silu(a) * b) @ w2


def causal_conv(u, state, w, b):
    T = u.shape[1]
    up = jnp.concatenate([state.astype(u.dtype), u], axis=1)
    y = b + sum(up[:, j:j + T] * w[j] for j in range(CONV_K))
    return jax.nn.silu(y), up[:, T:]


def chunked_decay_scan(q, k, v, log_a, h0):
    f32 = jnp.float32
    Bsz, T, G, N = q.shape
    Hg, P = v.shape[3], v.shape[4]
    L = CHUNK if T % CHUNK == 0 else T
    nC = T // L
    q = q.astype(f32).reshape(Bsz, nC, L, G, N)
    k = k.astype(f32).reshape(Bsz, nC, L, G, N)
    v = v.astype(f32).reshape(Bsz, nC, L, G, Hg, P)
    cum = jnp.cumsum(log_a.astype(f32).reshape(Bsz, nC, L, G, Hg), axis=2)
    cum_t = jnp.moveaxis(cum, 2, -1)
    causal = jnp.tril(jnp.ones((L, L), dtype=bool))
    seg = cum_t[..., :, None] - cum_t[..., None, :]
    decay = jnp.where(causal, jnp.exp(jnp.where(causal, seg, 0.0)), 0.0)
    qk = jnp.einsum('bclgn,bcsgn->bcgls', q, k)
    y_intra = jnp.einsum('bcghls,bcsghp->bclghp', qk[:, :, :, None] * decay, v)

    def step(h, blk):
        q_c, k_c, v_c, cum_c = blk
        y_c = jnp.einsum('blgn,bghnp->blghp', q_c, h) * jnp.exp(cum_c)[..., None]
        last = cum_c[:, -1]
        w = jnp.exp(last[:, None] - cum_c)
        h = jnp.exp(last)[..., None, None] * h + jnp.einsum('blgn,blgh,blghp->bghnp', k_c, w, v_c)
        return h, y_c

    xs = tuple(jnp.moveaxis(a, 1, 0) for a in (q, k, v, cum))
    h_T, y_inter = lax.scan(step, h0.astype(f32), xs)
    y = y_intra + jnp.moveaxis(y_inter, 0, 1)
    return y.reshape(Bsz, T, G, Hg, P), h_T


def ssd_ret_mixer(xn, pos, conv_state, ssd_state, ret_state, w_in, conv_w, conv_b,
                  dt_bias, a_log, d_skip, ssd_norm, w_out):
    f32 = jnp.float32
    Bsz, T, _ = xn.shape
    z, xbc, dt_raw, q, k, v, gate = jnp.split(xn @ w_in, AB_SPLITS, axis=-1)
    xbc, new_conv = causal_conv(xbc, conv_state, conv_w, conv_b)
    xs, b_ssm, c_ssm = jnp.split(xbc, [SSD_INNER, SSD_INNER + SSD_GROUPS * SSD_STATE], axis=-1)
    xs = xs.reshape(Bsz, T, SSD_GROUPS, SSD_HPG, SSD_HEAD_DIM)
    b_ssm = b_ssm.reshape(Bsz, T, SSD_GROUPS, SSD_STATE)
    c_ssm = c_ssm.reshape(Bsz, T, SSD_GROUPS, SSD_STATE)
    dt = jax.nn.softplus((dt_raw + dt_bias).astype(f32)).reshape(Bsz, T, SSD_GROUPS, SSD_HPG)
    a = -jnp.exp(a_log.astype(f32)).reshape(SSD_GROUPS, SSD_HPG)
    h0 = ssd_state.reshape(Bsz, SSD_GROUPS, SSD_HPG, SSD_STATE, SSD_HEAD_DIM)
    y, h_T = chunked_decay_scan(c_ssm, b_ssm, xs * dt[..., None], dt * a, h0)
    y = y + d_skip.reshape(SSD_GROUPS, SSD_HPG, 1) * xs
    y = y.reshape(Bsz, T, SSD_INNER) * jax.nn.silu(z)
    y = rmsnorm(y.reshape(Bsz, T, SSD_GROUPS, SSD_INNER // SSD_GROUPS),
                ssd_norm.reshape(SSD_GROUPS, SSD_INNER // SSD_GROUPS)).reshape(Bsz, T, SSD_INNER)
    qr = rope(q.reshape(Bsz, T, RET_HEADS, RET_HEAD_DIM), pos)
    kr = rope(k.reshape(Bsz, T, RET_HEADS, RET_HEAD_DIM), pos) * RET_HEAD_DIM ** -0.5
    log_gamma = jnp.log1p(-jnp.exp2(-5.0 - jnp.arange(RET_HEADS, dtype=f32)))
    log_a = jnp.broadcast_to(log_gamma[:, None], (Bsz, T, RET_HEADS, 1))
    o, r_T = chunked_decay_scan(qr, kr, v.reshape(Bsz, T, RET_HEADS, 1, RET_HEAD_DIM), log_a,
                                ret_state[:, :, None])
    o = _rms(o[:, :, :, 0]).reshape(Bsz, T, RET_INNER) * jax.nn.silu(gate)
    out = jnp.concatenate([y.astype(f32), o.astype(f32)], axis=-1) @ w_out
    new_ssd = h_T.reshape(Bsz, SSD_HEADS, SSD_STATE, SSD_HEAD_DIM)
    return out.astype(xn.dtype), (new_conv, new_ssd, r_T[:, :, 0])


def mla_attend(q_nope, q_rope, q_pos, ckv, kpe, k_pos, w_uk, w_uv):
    q_lat = jnp.einsum('bqhd,chd->bqhc', q_nope, w_uk)
    s = (jnp.einsum('bqhc,bkc->bhqk', q_lat, ckv)
         + jnp.einsum('bqhr,bkr->bhqk', q_rope, kpe)).astype(jnp.float32) * MLA_SCALE
    visible = (k_pos[None, :] // CHUNK) <= (q_pos[:, None] // CHUNK)
    p = jax.nn.softmax(jnp.where(visible, s, -jnp.inf), axis=-1).astype(ckv.dtype)
    o_lat = jnp.einsum('bhqk,bkc->bqhc', p, ckv)
    return jnp.einsum('bqhc,chd->bqhd', o_lat, w_uv)


def mla_mixer(xn, pos, past_ckv, past_kpe, w_in, q_norm, kv_norm, w_uq, w_uk, w_uv, w_out):
    Bsz, T, _ = xn.shape
    cq, ckv, kpe = jnp.split(xn @ w_in, [Q_LORA, Q_LORA + KV_LORA], axis=-1)
    q = (rmsnorm(cq, q_norm) @ w_uq).reshape(Bsz, T, MLA_HEADS, QK_NOPE + QK_ROPE)
    q_nope, q_rope = q[..., :QK_NOPE], rope(q[..., QK_NOPE:], pos)
    ckv = rmsnorm(ckv, kv_norm)
    kpe = rope(kpe[:, :, None, :], pos)[:, :, 0]
    if past_ckv is None:
        keys_ckv, keys_kpe, k_pos = ckv, kpe, pos
    else:
        keys_ckv = jnp.concatenate([past_ckv.astype(ckv.dtype), ckv], axis=1)
        keys_kpe = jnp.concatenate([past_kpe.astype(kpe.dtype), kpe], axis=1)
        k_pos = jnp.concatenate([jnp.arange(past_ckv.shape[1]), pos])
    attend = functools.partial(mla_attend, ckv=keys_ckv, kpe=keys_kpe, k_pos=k_pos, w_uk=w_uk, w_uv=w_uv)
    if T % Q_BLOCK == 0:
        nb = T // Q_BLOCK
        def blocks(a):
            return jnp.moveaxis(a.reshape(Bsz, nb, Q_BLOCK, *a.shape[2:]), 1, 0)
        o = lax.map(lambda blk: attend(blk[0], blk[1], blk[2]),
                    (blocks(q_nope), blocks(q_rope), pos.reshape(nb, Q_BLOCK)))
        o = jnp.moveaxis(o, 0, 1).reshape(Bsz, T, MLA_HEADS, V_HEAD)
    else:
        o = attend(q_nope, q_rope, pos)
    out = o.reshape(Bsz, T, MLA_HEADS * V_HEAD) @ w_out
    return out.astype(xn.dtype), (ckv, kpe)


def mem_kv(mem, g, w_mkv):
    Bsz, M, _ = mem.shape
    k, v = jnp.split(rmsnorm(mem, g) @ w_mkv, 2, axis=-1)
    return (k.reshape(Bsz, M, MEM_HEADS, MEM_HEAD_DIM), v.reshape(Bsz, M, MEM_HEADS, MEM_HEAD_DIM))


def mem_attend(xn, mem_k, mem_v, w_mq, w_mo):
    Bsz, T, _ = xn.shape
    q = (xn @ w_mq).reshape(Bsz, T, MEM_HEADS, MEM_HEAD_DIM)
    s = jnp.einsum('bthd,bmhd->bhtm', q, mem_k.astype(q.dtype)).astype(jnp.float32) * MEM_HEAD_DIM ** -0.5
    p = jax.nn.softmax(s, axis=-1).astype(q.dtype)
    o = jnp.einsum('bhtm,bmhd->bthd', p, mem_v.astype(q.dtype)).reshape(Bsz, T, MEM_INNER)
    return (o @ w_mo).astype(xn.dtype)


def trunk_layer(x, mix_fn, norms, ffn_w1, ffn_w2, mem_k, mem_v, w_mq, w_mo):
    x = x + 0.5 * swiglu(rmsnorm(x, norms[0]), ffn_w1[0], ffn_w2[0])
    mixed, new_state = mix_fn(rmsnorm(x, norms[1]))
    x = x + mixed
    x = x + mem_attend(rmsnorm(x, norms[2]), mem_k, mem_v, w_mq, w_mo)
    x = x + 0.5 * swiglu(rmsnorm(x, norms[3]), ffn_w1[1], ffn_w2[1])
    return x, new_state


def setup_inputs(seed: int = 0) -> dict:
    key = jax.random.key(seed)
    ks = iter(jax.random.split(key, 48))

    def nrm(shape, scale):
        return jax.random.normal(next(ks), shape, jnp.float32) * scale

    def gain(shape):
        return 1.0 + nrm(shape, 0.01)

    dt_init = jnp.exp(jax.random.uniform(next(ks), (N_EVEN, SSD_HEADS), jnp.float32,
                                         math.log(1e-3), math.log(1e-1)))
    return {
        'x_prompt': nrm((BATCH, SEQ, D_MODEL), 1.0),
        'x_sample': nrm((DEC_BATCH, DEC_SEQ, D_MODEL), 1.0),
        'mem_prompt': nrm((BATCH, MEM_TOKENS, D_MODEL), 1.0),
        'state_conv': nrm((N_EVEN, DEC_BATCH, CONV_K - 1, CONV_DIM), 1.0),
        'state_ssd': nrm((N_EVEN, DEC_BATCH, SSD_HEADS, SSD_STATE, SSD_HEAD_DIM), 0.5),
        'state_ret': nrm((N_EVEN, DEC_BATCH, RET_HEADS, RET_HEAD_DIM, RET_HEAD_DIM), 0.3),
        'cache_ckv': nrm((N_ODD, DEC_BATCH, PAST_LEN, KV_LORA), 1.0),
        'cache_kpe': nrm((N_ODD, DEC_BATCH, PAST_LEN, QK_ROPE), 1.0),
        'cache_mem_k': nrm((DEPTH, DEC_BATCH, MEM_TOKENS, MEM_HEADS, MEM_HEAD_DIM), 1.0),
        'cache_mem_v': nrm((DEPTH, DEC_BATCH, MEM_TOKENS, MEM_HEADS, MEM_HEAD_DIM), 1.0),
        'norms': gain((DEPTH, 4, D_MODEL)),
        'ffn_w1': nrm((DEPTH, 2, D_MODEL, 2 * D_FF), D_MODEL ** -0.5),
        'ffn_w2': nrm((DEPTH, 2, D_FF, D_MODEL), D_FF ** -0.5),
        'mem_norm': gain((DEPTH, D_MODEL)),
        'w_mq': nrm((DEPTH, D_MODEL, MEM_INNER), D_MODEL ** -0.5),
        'w_mkv': nrm((DEPTH, D_MODEL, 2 * MEM_INNER), D_MODEL ** -0.5),
        'w_mo': nrm((DEPTH, MEM_INNER, D_MODEL), MEM_INNER ** -0.5),
        'ab_w_in': nrm((N_EVEN, D_MODEL, AB_IN), D_MODEL ** -0.5),
        'ab_conv_w': nrm((N_EVEN, CONV_K, CONV_DIM), CONV_K ** -0.5),
        'ab_conv_b': nrm((N_EVEN, CONV_DIM), 0.02),
        'ab_dt_bias': dt_init + jnp.log(-jnp.expm1(-dt_init)),
        'ab_a_log': jnp.log(jax.random.uniform(next(ks), (N_EVEN, SSD_HEADS), jnp.float32, 1.0, 16.0)),
        'ab_d_skip': gain((N_EVEN, SSD_HEADS)),
        'ab_ssd_norm': gain((N_EVEN, SSD_INNER)),
        'ab_w_out': nrm((N_EVEN, AB_OUT, D_MODEL), AB_OUT ** -0.5),
        'c_w_in': nrm((N_ODD, D_MODEL, C_IN), D_MODEL ** -0.5),
        'c_q_norm': gain((N_ODD, Q_LORA)),
        'c_kv_norm': gain((N_ODD, KV_LORA)),
        'c_w_uq': nrm((N_ODD, Q_LORA, MLA_HEADS * (QK_NOPE + QK_ROPE)), Q_LORA ** -0.5),
        'c_w_uk': nrm((N_ODD, KV_LORA, MLA_HEADS, QK_NOPE), KV_LORA ** -0.5),
        'c_w_uv': nrm((N_ODD, KV_LORA, MLA_HEADS, V_HEAD), KV_LORA ** -0.5),
        'c_w_out': nrm((N_ODD, MLA_HEADS * V_HEAD, D_MODEL), (MLA_HEADS * V_HEAD) ** -0.5),
        'final_norm': gain((D_MODEL,)),
    }


def reference(x_prompt, x_sample, mem_prompt, state_conv, state_ssd, state_ret, cache_ckv, cache_kpe,
              cache_mem_k, cache_mem_v, norms, ffn_w1, ffn_w2, mem_norm, w_mq, w_mkv, w_mo,
              ab_w_in, ab_conv_w, ab_conv_b, ab_dt_bias, ab_a_log, ab_d_skip, ab_ssd_norm, ab_w_out,
              c_w_in, c_q_norm, c_kv_norm, c_w_uq, c_w_uk, c_w_uv, c_w_out, final_norm):
    f32 = jnp.float32
    bp, tp = x_prompt.shape[0], x_prompt.shape[1]
    ts = x_sample.shape[1]
    past_len = cache_ckv.shape[2]
    pos_p = jnp.arange(tp)
    pos_s = past_len + jnp.arange(ts)
    xp, xs = x_prompt, x_sample
    conv_p, ssd_p, ret_p, ckv_p, kpe_p, memk_p, memv_p = [], [], [], [], [], [], []
    conv_s, ssd_s, ret_s, ckv_s, kpe_s = [], [], [], [], []
    for i in range(DEPTH):
        j = i // 2
        mk_p, mv_p = mem_kv(mem_prompt, mem_norm[i], w_mkv[i])
        memk_p.append(mk_p)
        memv_p.append(mv_p)
        if i % 2 == 0:
            ab = dict(w_in=ab_w_in[j], conv_w=ab_conv_w[j], conv_b=ab_conv_b[j], dt_bias=ab_dt_bias[j],
                      a_log=ab_a_log[j], d_skip=ab_d_skip[j], ssd_norm=ab_ssd_norm[j], w_out=ab_w_out[j])
            mix_p = functools.partial(
                ssd_ret_mixer, pos=pos_p,
                conv_state=jnp.zeros((bp, CONV_K - 1, CONV_DIM), x_prompt.dtype),
                ssd_state=jnp.zeros((bp, SSD_HEADS, SSD_STATE, SSD_HEAD_DIM), f32),
                ret_state=jnp.zeros((bp, RET_HEADS, RET_HEAD_DIM, RET_HEAD_DIM), f32), **ab)
            mix_s = functools.partial(ssd_ret_mixer, pos=pos_s, conv_state=state_conv[j],
                                      ssd_state=state_ssd[j], ret_state=state_ret[j], **ab)
        else:
            cp = dict(w_in=c_w_in[j], q_norm=c_q_norm[j], kv_norm=c_kv_norm[j], w_uq=c_w_uq[j],
                      w_uk=c_w_uk[j], w_uv=c_w_uv[j], w_out=c_w_out[j])
            mix_p = functools.partial(mla_mixer, pos=pos_p, past_ckv=None, past_kpe=None, **cp)
            mix_s = functools.partial(mla_mixer, pos=pos_s, past_ckv=cache_ckv[j], past_kpe=cache_kpe[j], **cp)
        layer = functools.partial(trunk_layer, norms=norms[i], ffn_w1=ffn_w1[i], ffn_w2=ffn_w2[i],
                                  w_mq=w_mq[i], w_mo=w_mo[i])
        xp, st_p = layer(xp, mix_p, mem_k=mk_p, mem_v=mv_p)
        xs, st_s = layer(xs, mix_s, mem_k=cache_mem_k[i], mem_v=cache_mem_v[i])
        if i % 2 == 0:
            conv_p.append(st_p[0]); ssd_p.append(st_p[1]); ret_p.append(st_p[2])
            conv_s.append(st_s[0]); ssd_s.append(st_s[1]); ret_s.append(st_s[2])
        else:
            ckv_p.append(st_p[0]); kpe_p.append(st_p[1])
            ckv_s.append(st_s[0]); kpe_s.append(st_s[1])
    y_prompt = rmsnorm(xp, final_norm)
    y_sample = rmsnorm(xs, final_norm)
    return (y_prompt, y_sample,
            jnp.stack(conv_p), jnp.stack(ssd_p), jnp.stack(ret_p), jnp.stack(ckv_p), jnp.stack(kpe_p),
            jnp.stack(memk_p), jnp.stack(memv_p),
            jnp.stack(conv_s), jnp.stack(ssd_s), jnp.stack(ret_s), jnp.stack(ckv_s), jnp.stack(kpe_s))
```

```cpp
#include <hip/hip_runtime.h>
#include <cstdio>
#include <cstdint>
__device__ __forceinline__ int lane_id() { int l; asm volatile("v_mbcnt_lo_u32_b32 %0, -1, 0\n\tv_mbcnt_hi_u32_b32 %0, -1, %0" : "=v"(l)); return l; }
namespace pg8 {
#define PG8_LAS __attribute__((address_space(3)))
typedef unsigned short bf16_t;
typedef short bf16x8 __attribute__((ext_vector_type(8)));
typedef float f32x4 __attribute__((ext_vector_type(4)));
typedef unsigned u32x4 __attribute__((ext_vector_type(4)));
constexpr int BM = 256, BK = 64, HALF = 128, HTB = HALF * BK * 2  , STAGE_BYTES = 8 * HTB, NXCD = 8, WGM = 8;

__host__ __device__ __forceinline__ int lds_byte(int r, int c) { const int st = (r >> 4) * 2 + (c >> 5), rr = r & 15, cc = c & 31, ob = rr * 64 + cc * 2; return st * 1024 + (ob ^ (((ob >> 9) & 1) << 5)); }
__host__ __device__ __forceinline__ void stage_rc(int b, int& R, int& C) { const int st = b / 1024, sb = b % 1024, swz = sb ^ (((sb >> 9) & 1) << 5); R = (st >> 1) * 16 + swz / 64; C = (st & 1) * 32 + (swz % 64) / 2; }
__host__ __device__ __forceinline__ int perm32(int rho) { const int n = rho >> 4, i = rho & 15; return 8 * (i >> 2) + 4 * n + (i & 3); }

struct Unit { int pm, pn, kp, par; };
struct Gemm { const bf16_t* A; const bf16_t* Bt; int M, N, K, lda, kloop; };

struct StaticOrder {
    int nM, nN, nwg, G, c;
    __host__ __device__ void init(int M, int N, int G_, int c_) { nM = M / BM; nN = N / BM; nwg = nM * nN; G = G_; c = c_; }
    __host__ __device__ bool next(int i, Unit& u) const {
        const long L = (long)i * G + c; if (L >= nwg) return false;
        int wgid = (int)L; { const int q = nwg / NXCD, r = nwg % NXCD, xcd = wgid % NXCD, off = wgid / NXCD; wgid = (xcd < r ? xcd * (q + 1) : r * (q + 1) + (xcd - r) * q) + off; }
        const int nig = WGM * nN, gid = wgid / nig, fm = gid * WGM, gsz = (nM - fm) < WGM ? (nM - fm) : WGM;
        u.pm = fm + ((wgid % nig) % gsz); u.pn = (wgid % nig) / gsz; u.kp = 0; return true;
    }
    __device__ __forceinline__ void a_ready(const Unit&) const {}
    __device__ __forceinline__ void done(const Unit&) const {}
};
__device__ __forceinline__ unsigned cvt_pk_bf16(float lo, float hi) { unsigned r; asm volatile("v_cvt_pk_bf16_f32 %0, %1, %2" : "=v"(r) : "v"(lo), "v"(hi)); return r; }
template <class Epi, class Sched, bool ALIGN_EPI = false, bool SP2 = false>
__device__ __forceinline__ void gemm_phase(PG8_LAS unsigned char* lds, const Gemm g, const Sched& S, const Epi& E, int wave_id) {
    const int wid = wave_id, lane = lane_id(), tid = wid * 64 + lane, wr = wid >> 2, wc = wid & 3, fr = lane & 15, fq = lane >> 4;
    const int K = g.K, nt = g.kloop / BK; const size_t kpart = (size_t)g.kloop * 2;
    unsigned voffA[2], voffB[2];
#pragma unroll
    for (int i = 0; i < 2; ++i) { int R, C; stage_rc(tid * 16 + i * 8192, R, C); const int Rb = Epi::PERM ? (Epi::ADJ ? ((R >> 5) * 64 + perm32(R & 31)) : ((R & ~31) + perm32(R & 31))) : R;
        voffA[i] = (unsigned)(R * g.lda + C) * 2u; voffB[i] = (unsigned)(Rb * K + C) * 2u; }
    const size_t kstep = (size_t)(BK * 2);
    const size_t hstep = (size_t)HALF * K * 2;
    const size_t tstep = 2 * hstep;
    const size_t hstepB = Epi::ADJ ? (size_t)32 * K * 2 : hstep;
    const size_t hstepA = (size_t)HALF * g.lda * 2, tstepA = 2 * hstepA;
    const unsigned ldsw = (unsigned)wid * 1024u;
    const int aoff = lds_byte(wr * 64 + fr, fq * 8), boff = lds_byte(wc * 32 + fr, fq * 8);
#define PG8_SA(b, h) (((b) * 2 + (h)) * HTB)
#define PG8_SB(b, h) ((4 + (b) * 2 + (h)) * HTB)
#define PG8_STAGE(bufoff, gbase, voff) do { _Pragma("unroll") for (int _i = 0; _i < 2; ++_i) \
        __builtin_amdgcn_global_load_lds((const unsigned*)((const char*)(gbase) + (voff)[_i]), (PG8_LAS unsigned*)(lds + (bufoff) + ldsw + _i * 8192), 16, 0, 0); } while (0)
#define PG8_LDA(dst, b, h) do { _Pragma("unroll") for (int m = 0; m < 4; ++m) _Pragma("unroll") for (int k = 0; k < 2; ++k) dst[m][k] = *(const PG8_LAS bf16x8*)(lds + PG8_SA(b, h) + aoff + m * 2048 + k * 1024); } while (0)
#define PG8_LDB(dst, b, h) do { _Pragma("unroll") for (int n = 0; n < 2; ++n) _Pragma("unroll") for (int k = 0; k < 2; ++k) dst[n][k] = *(const PG8_LAS bf16x8*)(lds + PG8_SB(b, h) + boff + n * 2048 + k * 1024); } while (0)
#define PG8_MMA(ai, bj, At, Bt) do { __builtin_amdgcn_s_setprio(1); _Pragma("unroll") for (int m = 0; m < 4; ++m) _Pragma("unroll") for (int n = 0; n < 2; ++n) _Pragma("unroll") for (int k = 0; k < 2; ++k) \
        acc[ai][bj][m][n] = __builtin_amdgcn_mfma_f32_16x16x32_bf16(Bt[n][k], At[m][k], acc[ai][bj][m][n], 0, 0, 0); __builtin_amdgcn_s_setprio(0); } while (0)
#define PG8_WAIT_V(n) asm volatile("s_waitcnt vmcnt(" #n ")" ::: "memory")
#define PG8_WAIT_L(n) asm volatile("s_waitcnt lgkmcnt(" #n ")" ::: "memory")
#define PG8_BAR __builtin_amdgcn_s_barrier()
#define PG8_SCHED __builtin_amdgcn_sched_barrier(0)
    Unit cur, nxt; int ui = 0;
    if (!S.next(0, cur)) return;
    f32x4 acc[2][2][4][2];
#pragma unroll
    for (int a = 0; a < 2; ++a)
#pragma unroll
        for (int b = 0; b < 2; ++b)
#pragma unroll
            for (int m = 0; m < 4; ++m)
#pragma unroll
                for (int n = 0; n < 2; ++n) acc[a][b][m][n] = (f32x4){0.f, 0.f, 0.f, 0.f};
    bf16x8 At[4][2], B0[2][2], B1[2][2];
    const char* cA = (const char*)g.A + (size_t)cur.pm * tstepA + (size_t)cur.kp * kpart; const char* cB = (const char*)g.Bt + (size_t)cur.pn * tstep + (size_t)cur.kp * kpart;
    S.a_ready(cur);
    if constexpr (SP2) {
        PG8_STAGE(PG8_SB(0, 0), cB, voffB); PG8_STAGE(PG8_SB(0, 1), cB + hstepB, voffB); PG8_STAGE(PG8_SA(0, 0), cA, voffA); PG8_STAGE(PG8_SA(0, 1), cA + hstepA, voffA);
        if (wr == 1) PG8_BAR;
        PG8_WAIT_V(2); PG8_BAR;
        PG8_STAGE(PG8_SB(1, 0), cB + kstep, voffB); PG8_STAGE(PG8_SA(1, 0), cA + kstep, voffA); PG8_STAGE(PG8_SB(1, 1), cB + hstepB + kstep, voffB);
        PG8_WAIT_V(6); PG8_BAR;
    } else {
        PG8_STAGE(PG8_SB(0, 0), cB, voffB); PG8_STAGE(PG8_SA(0, 0), cA, voffA); PG8_STAGE(PG8_SB(0, 1), cB + hstepB, voffB); PG8_STAGE(PG8_SA(0, 1), cA + hstepA, voffA);
        if (wr == 1) PG8_BAR;
        PG8_WAIT_V(4); PG8_BAR;
        PG8_STAGE(PG8_SB(1, 0), cB + kstep, voffB); PG8_STAGE(PG8_SA(1, 0), cA + kstep, voffA); PG8_STAGE(PG8_SB(1, 1), cB + hstepB + kstep, voffB);
        PG8_WAIT_V(6); PG8_BAR;
    }
    for (;;) {
        const bool has_next = S.next(ui + 1, nxt);
        if constexpr (Epi::SSQ_LDS)
            __builtin_amdgcn_global_load_lds((const unsigned*)(E.ssq + (size_t)cur.pm * 256) + tid, (PG8_LAS unsigned*)(lds + STAGE_BYTES + (ui & 1) * 2048 + wid * 256), 4, 0, 0);
        const char* nA = has_next ? (const char*)g.A + (size_t)nxt.pm * tstepA + (size_t)nxt.kp * kpart : cA; const char* nB = has_next ? (const char*)g.Bt + (size_t)nxt.pn * tstep + (size_t)nxt.kp * kpart : cB;
        for (int t = 0; t < nt; t += 2) {
            const bool last = (t == nt - 2);
            const char* a1 = cA + (size_t)(t + 1) * kstep;
            const char* a2 = last ? nA : cA + (size_t)(t + 2) * kstep; const char* b2 = last ? nB : cB + (size_t)(t + 2) * kstep;
            const char* a3 = a2 + kstep; const char* b3 = b2 + kstep;
            if (last && has_next) S.a_ready(nxt);
            if constexpr (SP2) {
            PG8_LDB(B0, 0, 0); PG8_LDB(B1, 0, 1); PG8_SCHED; PG8_LDA(At, 0, 0); PG8_STAGE(PG8_SA(1, 1), a1 + hstepA, voffA);
            PG8_WAIT_V(8); PG8_WAIT_L(0); PG8_BAR; PG8_MMA(0, 0, At, B0); PG8_MMA(0, 1, At, B1); PG8_BAR; PG8_SCHED;
            PG8_LDA(At, 0, 1); PG8_STAGE(PG8_SB(0, 0), b2, voffB); PG8_STAGE(PG8_SB(0, 1), b2 + hstepB, voffB); PG8_STAGE(PG8_SA(0, 0), a2, voffA);
            PG8_WAIT_V(8); PG8_WAIT_L(0); PG8_BAR; PG8_MMA(1, 0, At, B0); PG8_MMA(1, 1, At, B1); PG8_BAR; PG8_SCHED;
            PG8_LDB(B0, 1, 0); PG8_LDB(B1, 1, 1); PG8_SCHED; PG8_LDA(At, 1, 0); PG8_STAGE(PG8_SA(0, 1), a2 + hstepA, voffA);
            PG8_WAIT_V(8); PG8_WAIT_L(0); PG8_BAR; PG8_MMA(0, 0, At, B0); PG8_MMA(0, 1, At, B1); PG8_BAR; PG8_SCHED;
            PG8_LDA(At, 1, 1); PG8_STAGE(PG8_SB(1, 0), b3, voffB); PG8_STAGE(PG8_SB(1, 1), b3 + hstepB, voffB); PG8_STAGE(PG8_SA(1, 0), a3, voffA);
            PG8_WAIT_V(8); PG8_WAIT_L(0); PG8_BAR; PG8_MMA(1, 0, At, B0); PG8_MMA(1, 1, At, B1); PG8_BAR; PG8_SCHED;
            } else {
            PG8_LDB(B0, 0, 0); PG8_SCHED; PG8_LDA(At, 0, 0); PG8_STAGE(PG8_SA(1, 1), a1 + hstepA, voffA);
            PG8_WAIT_L(8); PG8_BAR; PG8_WAIT_L(0); PG8_MMA(0, 0, At, B0); PG8_BAR; PG8_SCHED;
            PG8_LDB(B1, 0, 1); PG8_STAGE(PG8_SB(0, 0), b2, voffB);
            PG8_BAR; PG8_WAIT_L(0); PG8_MMA(0, 1, At, B1); PG8_BAR;
            PG8_LDA(At, 0, 1); PG8_STAGE(PG8_SA(0, 0), a2, voffA);
            PG8_BAR; PG8_WAIT_L(0); PG8_MMA(1, 0, At, B0); PG8_BAR; PG8_SCHED;
            PG8_STAGE(PG8_SB(0, 1), b2 + hstepB, voffB);
            PG8_WAIT_V(6); PG8_BAR; PG8_MMA(1, 1, At, B1); PG8_BAR;
            PG8_LDB(B0, 1, 0); PG8_SCHED; PG8_LDA(At, 1, 0); PG8_STAGE(PG8_SA(0, 1), a2 + hstepA, voffA);
            PG8_WAIT_L(8); PG8_BAR; PG8_WAIT_L(0); PG8_MMA(0, 0, At, B0); PG8_BAR; PG8_SCHED;
            PG8_LDB(B1, 1, 1); PG8_STAGE(PG8_SB(1, 0), b3, voffB);
            PG8_BAR; PG8_WAIT_L(0); PG8_MMA(0, 1, At, B1); PG8_BAR;
            PG8_LDA(At, 1, 1); PG8_STAGE(PG8_SA(1, 0), a3, voffA);
            PG8_BAR; PG8_WAIT_L(0); PG8_MMA(1, 0, At, B0); PG8_BAR; PG8_SCHED;
            PG8_STAGE(PG8_SB(1, 1), b3 + hstepB, voffB);
            PG8_WAIT_V(6); PG8_BAR; PG8_MMA(1, 1, At, B1); PG8_BAR;
            }
        }
        if constexpr (ALIGN_EPI) { if (wr == 0) PG8_BAR; }
        cur.par = ui & 1;
        if constexpr (!Epi::AFTER_DRAIN) { E(acc, cur, wr, wc, fr, fq); S.done(cur); }
        if (!has_next) break;
#pragma unroll
        for (int a = 0; a < 2; ++a)
#pragma unroll
            for (int b = 0; b < 2; ++b)
#pragma unroll
                for (int m = 0; m < 4; ++m)
#pragma unroll
                    for (int n = 0; n < 2; ++n) acc[a][b][m][n] = (f32x4){0.f, 0.f, 0.f, 0.f};
        cur = nxt; cA = nA; cB = nB; ++ui;
        if constexpr (ALIGN_EPI) { if (wr == 1) PG8_BAR; }
    }
    PG8_WAIT_V(0);
    if constexpr (!ALIGN_EPI) { if (wr == 0) PG8_BAR; }
    PG8_BAR;
    if constexpr (Epi::AFTER_DRAIN) { E.fused(acc, cur, wr, wc, fr, fq, lds, wid, lane); S.done(cur); }
#undef PG8_SA
#undef PG8_SB
#undef PG8_STAGE
#undef PG8_LDA
#undef PG8_LDB
#undef PG8_MMA
#undef PG8_WAIT_V
#undef PG8_WAIT_L
#undef PG8_BAR
#undef PG8_SCHED
}
}
#define GAS __attribute__((address_space(1)))
#define LAS __attribute__((address_space(3)))
#define XB_TMO      128
#define XB_XCNT(j)  (256  + 64 * (j))
#define XB_XSUB(j)  (1280 + 64 * (j))
#define XB_XGEN(j)  (2304 + 64 * (j))
#define XB_TOP      3328
#define XB_TOPGEN   3392
#define XCD_BAR_WORDS 3456
#define XB_SPIN_CAP (1u << 18)

__device__ __forceinline__ unsigned xb_ld(unsigned* p)              { return __hip_atomic_load(p, __ATOMIC_RELAXED, __HIP_MEMORY_SCOPE_AGENT); }
__device__ __forceinline__ unsigned xb_add(unsigned* p, unsigned v) { return __hip_atomic_fetch_add(p, v, __ATOMIC_RELAXED, __HIP_MEMORY_SCOPE_AGENT); }
__device__ __forceinline__ unsigned xb_xcc_id() { return (unsigned)__builtin_amdgcn_s_getreg((3 << 11) | 20) & 0xFu; }
#define XB_SPIN(cond, bar) do { unsigned _sp = 0; while (cond) { __builtin_amdgcn_s_sleep(1); \
    if ((++_sp & 255u) == 0u) { if (xb_ld(&(bar)[XB_TMO])) break; if (_sp > XB_SPIN_CAP) { atomicAdd(&(bar)[XB_TMO], 1u); break; } } } } while (0)

struct XcdBarrier {
    unsigned* bar; unsigned x; bool t0;
    volatile LAS unsigned* st;
};

__device__ __forceinline__ XcdBarrier xcd_barrier_post(unsigned* bar, volatile LAS unsigned* st, int wave_id) {
    XcdBarrier b; b.bar = bar; b.x = xb_xcc_id(); b.st = st; b.t0 = false;
    if (wave_id == 0 && lane_id() == 0) (void)xb_add(&bar[XB_XCNT(b.x)], 1u);
    return b;
}
__device__ __forceinline__ void xcd_barrier_complete(unsigned* bar, unsigned x, unsigned& nloc, unsigned& nx) {
    const unsigned G = gridDim.x * gridDim.y * gridDim.z;
    unsigned sum, cnt, mine, sp = 0u;
    for (;;) {
        sum = 0u; cnt = 0u; mine = 0u;
#pragma unroll
        for (unsigned j = 0; j < 16; ++j) { const unsigned c = xb_ld(&bar[XB_XCNT(j)]); sum += c; cnt += (c > 0u) ? 1u : 0u; mine = (j == x) ? c : mine; }
        if (sum == G) break;
        __builtin_amdgcn_s_sleep(1);
        if ((++sp & 255u) == 0u) { if (xb_ld(&bar[XB_TMO])) break; if (sp > XB_SPIN_CAP) { atomicAdd(&bar[XB_TMO], 1u); break; } }
    }
    nloc = mine > 0u ? mine : 1u; nx = cnt > 0u ? cnt : 1u;
}

__device__ __forceinline__ void xcd_barrier(const XcdBarrier& b) {
    asm volatile("s_waitcnt vmcnt(0)" ::: "memory");
    __syncthreads();
    if (b.t0 && lane_id() == 0) {
        unsigned* bar = b.bar;
        __builtin_amdgcn_s_waitcnt(0);
        unsigned nloc = b.st[0], nx = b.st[1];
        if (nloc == 0u) { xcd_barrier_complete(bar, b.x, nloc, nx); b.st[0] = nloc; b.st[1] = nx; }
        const unsigned old = xb_add(&bar[XB_XSUB(b.x)], 1u);
        const unsigned gen = old / nloc;
        if (old + 1u == (gen + 1u) * nloc) {
            __builtin_amdgcn_fence(__ATOMIC_RELEASE, "agent");
            asm volatile("s_waitcnt vmcnt(0)" ::: "memory");
            const unsigned og = xb_add(&bar[XB_TOP], 1u);
            const unsigned tg = og / nx;
            if (og + 1u == (tg + 1u) * nx) xb_add(&bar[XB_TOPGEN], 1u);
            else XB_SPIN(xb_ld(&bar[XB_TOPGEN]) == tg, bar);
            __builtin_amdgcn_fence(__ATOMIC_ACQUIRE, "agent");
            xb_add(&bar[XB_XGEN(b.x)], 1u);
            asm volatile("s_waitcnt vmcnt(0)" ::: "memory");
        } else {
            XB_SPIN(xb_ld(&bar[XB_XGEN(b.x)]) == gen, bar);
            __builtin_amdgcn_fence(__ATOMIC_ACQUIRE, "agent");
            asm volatile("s_waitcnt vmcnt(0)" ::: "memory");
        }
    }
    __syncthreads();
}
__device__ const double INV_R[128] = {1.00000000000000000e+00, 9.30572040929699029e-01, 8.65964323360065347e-01, 8.05842187761481865e-01, 7.49894209332455874e-01, 6.97830584859866376e-01, 6.49381631576211316e-01, 6.04296390238132863e-01, 5.62341325190349073e-01, 5.23299114681494704e-01, 4.86967525165863113e-01, 4.53158363760081784e-01, 4.21696503428582226e-01, 3.92418975848453588e-01, 3.65174127254837722e-01, 3.39820832894255964e-01, 3.16227766016837941e-01, 2.94272717620928159e-01, 2.73841963426436130e-01, 2.54829674797934669e-01, 2.37137370566165517e-01, 2.20673406908458991e-01, 2.05352502645714613e-01, 1.91095297497044042e-01, 1.77827941003892293e-01, 1.65481709994318132e-01, 1.53992652605949187e-01, 1.43301257023696282e-01, 1.33352143216332403e-01, 1.24093776075171955e-01, 1.15478198468945817e-01, 1.07460782832131743e-01, 1.00000000000000006e-01, 9.30572040929699001e-02, 8.65964323360065291e-02, 8.05842187761481865e-02, 7.49894209332455791e-02, 6.97830584859866349e-02, 6.49381631576211316e-02, 6.04296390238132849e-02, 5.62341325190349114e-02, 5.23299114681494704e-02, 4.86967525165863113e-02, 4.53158363760081812e-02, 4.21696503428582239e-02, 3.92418975848453574e-02, 3.65174127254837694e-02, 3.39820832894255909e-02, 3.16227766016837913e-02, 2.94272717620928173e-02, 2.73841963426436144e-02, 2.54829674797934641e-02, 2.37137370566165538e-02, 2.20673406908458991e-02, 2.05352502645714599e-02, 1.91095297497044063e-02, 1.77827941003892293e-02, 1.65481709994318126e-02, 1.53992652605949194e-02, 1.43301257023696268e-02, 1.33352143216332406e-02, 1.24093776075171955e-02, 1.15478198468945813e-02, 1.07460782832131743e-02, 1.00000000000000002e-02, 9.30572040929699036e-03, 8.65964323360065430e-03, 8.05842187761481900e-03, 7.49894209332455791e-03, 6.97830584859866331e-03, 6.49381631576211298e-03, 6.04296390238132780e-03, 5.62341325190349097e-03, 5.23299114681494669e-03, 4.86967525165863096e-03, 4.53158363760081812e-03, 4.21696503428582292e-03, 3.92418975848453627e-03, 3.65174127254837711e-03, 3.39820832894255917e-03, 3.16227766016837939e-03, 2.94272717620928199e-03, 2.73841963426436127e-03, 2.54829674797934667e-03, 2.37137370566165538e-03, 2.20673406908458974e-03, 2.05352502645714599e-03, 1.91095297497044059e-03, 1.77827941003892275e-03, 1.65481709994318139e-03, 1.53992652605949203e-03, 1.43301257023696268e-03, 1.33352143216332406e-03, 1.24093776075171955e-03, 1.15478198468945813e-03, 1.07460782832131756e-03, 1.00000000000000002e-03, 9.30572040929698928e-04, 8.65964323360065387e-04, 8.05842187761481791e-04, 7.49894209332455856e-04, 6.97830584859866353e-04, 6.49381631576211342e-04, 6.04296390238132867e-04, 5.62341325190349097e-04, 5.23299114681494734e-04, 4.86967525165863096e-04, 4.53158363760081790e-04, 4.21696503428582237e-04, 3.92418975848453594e-04, 3.65174127254837700e-04, 3.39820832894255961e-04, 3.16227766016837939e-04, 2.94272717620928167e-04, 2.73841963426436105e-04, 2.54829674797934635e-04, 2.37137370566165538e-04, 2.20673406908458974e-04, 2.05352502645714610e-04, 1.91095297497044048e-04, 1.77827941003892270e-04, 1.65481709994318149e-04, 1.53992652605949192e-04, 1.43301257023696274e-04, 1.33352143216332395e-04, 1.24093776075171960e-04, 1.15478198468945822e-04, 1.07460782832131751e-04};
__device__ const double INV_M[32] = {1.00000000000000000e+00, 7.49894209332455874e-01, 5.62341325190349073e-01, 4.21696503428582226e-01, 3.16227766016837941e-01, 2.37137370566165517e-01, 1.77827941003892293e-01, 1.33352143216332403e-01, 1.00000000000000006e-01, 7.49894209332455791e-02, 5.62341325190349114e-02, 4.21696503428582239e-02, 3.16227766016837913e-02, 2.37137370566165538e-02, 1.77827941003892293e-02, 1.33352143216332406e-02, 1.00000000000000002e-02, 7.49894209332455791e-03, 5.62341325190349097e-03, 4.21696503428582292e-03, 3.16227766016837939e-03, 2.37137370566165538e-03, 1.77827941003892275e-03, 1.33352143216332406e-03, 1.00000000000000002e-03, 7.49894209332455856e-04, 5.62341325190349097e-04, 4.21696503428582237e-04, 3.16227766016837939e-04, 2.37137370566165538e-04, 1.77827941003892270e-04, 1.33352143216332395e-04};
__device__ const float LOG_GAMMA[8] = {-3.174869831e-02f, -1.574835697e-02f, -7.843177461e-03f, -3.913899321e-03f, -1.955034836e-03f, -9.770396478e-04f, -4.884004981e-04f, -2.441704322e-04f};

typedef unsigned short bf16;
typedef unsigned v4u __attribute__((ext_vector_type(4)));
typedef unsigned v2u __attribute__((ext_vector_type(2)));
typedef float f32x4 __attribute__((ext_vector_type(4)));
typedef short bf16x8 __attribute__((ext_vector_type(8)));
typedef float f32x16 __attribute__((ext_vector_type(16)));
typedef short s16x4 __attribute__((ext_vector_type(4)));

constexpr int D = 2048, MP = 32768, MS = 512, M = MP + MS, SEQ = 8192, NBP = 4, NBS = 32, TS = 16, PAST = 2048, DFF = 5632;
constexpr float EPS = 1e-6f;
constexpr int NWAVES = 8;
constexpr int WIN_N = 13568, CWIN_N = 1280;

enum { I_XP = 0, I_XS, I_MEM, I_SCONV, I_SSSD, I_SRET, I_CCKV, I_CKPE, I_CMK, I_CMV, I_NORMS, I_W1, I_W2, I_MNORM, I_WMQ, I_WMKV, I_WMO,
       I_ABWIN, I_CONVW, I_CONVB, I_DTB, I_ALOG, I_DSKIP, I_SSDN, I_ABWOUT, I_CWIN, I_QNORM, I_KVNORM, I_WUQ, I_WUK, I_WUV, I_CWOUT, I_FNORM, N_IN };
constexpr size_t OUT_Y = 0;
constexpr size_t OUT_CONVP = (size_t)M * D;
constexpr size_t OUT_SSDP = OUT_CONVP + 4 * 3 * 3072;
constexpr size_t OUT_RETP = OUT_SSDP + (size_t)4 * 32 * 128 * 64;
constexpr size_t OUT_CKVP = OUT_RETP + (size_t)4 * 8 * 256 * 256;
constexpr size_t OUT_KPEP = OUT_CKVP + (size_t)MP * 512;
constexpr size_t OUT_MEMK = OUT_KPEP + (size_t)MP * 64;
constexpr size_t OUT_MEMV = OUT_MEMK + (size_t)2 * 1024 * 512;
constexpr size_t OUT_CONVS = OUT_MEMV + (size_t)2 * 1024 * 512;
constexpr size_t OUT_SSDS = OUT_CONVS + (size_t)32 * 3 * 3072;
constexpr size_t OUT_RETS = OUT_SSDS + (size_t)32 * 32 * 128 * 64;
constexpr size_t OUT_CKVS = OUT_RETS + (size_t)32 * 8 * 256 * 256;
constexpr size_t OUT_KPES = OUT_CKVS + (size_t)MS * 512;
constexpr size_t OUT_END = OUT_KPES + (size_t)MS * 64;

constexpr size_t AL(size_t x) { return (x + 255) & ~(size_t)255; }
constexpr size_t O_CTL = 0;
constexpr size_t O_SSQ = (size_t)1 << 20;
constexpr size_t O_ZEND = O_SSQ + AL((size_t)9 * M * 8);
constexpr size_t O_SSQG = O_ZEND;
constexpr size_t O_SSQH = O_SSQG + (size_t)M * 64 * 4;
constexpr size_t O_SSQM = O_SSQH + (size_t)M * 64 * 4;
constexpr size_t O_COSR = O_SSQM + AL(1024 * 4);
constexpr size_t O_SINR = O_COSR + (size_t)8192 * 128 * 4;
constexpr size_t O_COSM = O_SINR + (size_t)8192 * 128 * 4;
constexpr size_t O_SINM = O_COSM + (size_t)8192 * 32 * 4;
constexpr size_t O_MB = O_SINM + (size_t)8192 * 32 * 4;
constexpr size_t O_MKV = O_MB + (size_t)1024 * 2048 * 2;
constexpr size_t O_W1 = O_MKV + (size_t)2 * 1024 * 1024 * 2;
constexpr size_t SZ_W1 = (size_t)2 * DFF * D * 2, SZ_W2 = (size_t)D * DFF * 2;
constexpr size_t O_W2 = O_W1 + 4 * SZ_W1;
constexpr size_t O_WIN = O_W2 + 4 * SZ_W2;
constexpr size_t O_WOUT = O_WIN + (size_t)WIN_N * D * 2;
constexpr size_t O_CWIN = O_WOUT + (size_t)D * 4096 * 2;
constexpr size_t O_WUQ = O_CWIN + (size_t)CWIN_N * D * 2;
constexpr size_t O_WKV = O_WUQ + (size_t)3072 * 512 * 2;
constexpr size_t O_CWOUT = O_WKV + (size_t)4096 * 512 * 2;
constexpr size_t O_WMQ = O_CWOUT + (size_t)D * D * 2;
constexpr size_t O_WMKV = O_WMQ + (size_t)2 * 512 * D * 2;
constexpr size_t O_WMO = O_WMKV + (size_t)2 * 1024 * D * 2;
constexpr size_t O_XB = O_WMO + (size_t)2 * D * 512 * 2;
constexpr int XBP = D + 64;
constexpr size_t O_SCR = O_XB + (size_t)M * XBP * 2;
constexpr size_t S_H = 0;
constexpr size_t S_T1 = 0;
constexpr size_t S_ZG = S_T1 + (size_t)M * 4096 * 2;
constexpr size_t S_QK = S_ZG + (size_t)M * 4096 * 2;
constexpr size_t S_BC = S_QK + (size_t)M * 4096 * 2;
constexpr size_t S_DT = S_BC + (size_t)M * 1024 * 2;
constexpr size_t S_L0END = S_DT + (size_t)M * 32 * 4;
constexpr size_t S_QM = 0;
constexpr size_t S_OM = S_QM + (size_t)M * 512 * 2;
constexpr size_t S_CMK = S_OM + (size_t)M * 512 * 2;
constexpr size_t S_CMV = S_CMK + (size_t)32 * 256 * 512 * 2;
constexpr size_t S_PARTQ = S_CMV + (size_t)32 * 256 * 512 * 2;
constexpr size_t S_OB = 0;
constexpr size_t S_CKVB = S_OB + (size_t)M * D * 2;
constexpr size_t S_KPEB = S_CKVB + (size_t)M * 512 * 2;
constexpr size_t S_CKVPAST = S_KPEB + (size_t)M * 64 * 2;
constexpr size_t S_KPEPAST = S_CKVPAST + (size_t)65536 * 512 * 2;
constexpr size_t S_QN = S_KPEPAST + (size_t)65536 * 64 * 2;
constexpr size_t S_QR = S_QN + (size_t)M * D * 2;
constexpr size_t S_KNVN = S_QR + (size_t)M * 1024 * 2;
constexpr size_t S_CQN = S_KNVN + (size_t)MS * 4096 * 2;
constexpr size_t S_CIN = S_CQN + (size_t)M * 512 * 2;
constexpr size_t S_KNV = S_CIN;
constexpr size_t S_L1END = S_KNV + (size_t)MP * 4096 * 2;
constexpr size_t S_MAX = (S_L0END > S_L1END ? S_L0END : S_L1END) > (size_t)M * DFF * 2 ? (S_L0END > S_L1END ? S_L0END : S_L1END) : (size_t)M * DFF * 2;
constexpr size_t WS_NEED = O_SCR + S_MAX;
static_assert(S_CIN + (size_t)M * 1280 * 4 <= S_L1END, "CIN inside the KNV overlay");
static_assert(WS_NEED <= (size_t)1476395008, "workspace map exceeds 4x the largest tensor");

constexpr int RING_BYTES = 131072, LDS_BYTES = 147456, MISC_OFF = LDS_BYTES - 256;

struct Params { const float* in[N_IN]; float* out; unsigned char* ws; int ph_lo, ph_hi; };
static_assert(sizeof(Params) == (N_IN + 2) * 8 + 8, "no padding in Params");

#define LDS_WAIT() asm volatile("s_waitcnt lgkmcnt(0)" ::: "memory")
#define VM_WAIT() asm volatile("s_waitcnt vmcnt(0)" ::: "memory")

__device__ __forceinline__ unsigned f2bf(float f) { unsigned u = __builtin_bit_cast(unsigned, f); return (u + 0x7fffu + ((u >> 16) & 1u)) >> 16; }
__device__ __forceinline__ unsigned pk2(float lo, float hi) { return pg8::cvt_pk_bf16(lo, hi); }
__device__ __forceinline__ float bflo(unsigned w) { return __uint_as_float(w << 16); }
__device__ __forceinline__ float bfhi(unsigned w) { return __uint_as_float(w & 0xffff0000u); }
__device__ __forceinline__ float bf2f(bf16 b) { return __uint_as_float(((unsigned)b) << 16); }
__device__ __forceinline__ float wave_sum(float v) {
#pragma unroll
    for (int o = 1; o < 64; o <<= 1) v += __shfl_xor(v, o);
    return v;
}
typedef unsigned long long u64;
__device__ __forceinline__ u64 ssq_fix(float v) { return (u64)(v * 16777216.0f + 0.5f); }
__device__ __forceinline__ void ssq_add(u64* p, float v) { atomicAdd(p, ssq_fix(v)); }
__device__ __forceinline__ float ssq_get(const u64* p) { return (float)(*p) * (1.0f / 16777216.0f); }
__device__ __forceinline__ float silu_f(float a) { return a * __builtin_amdgcn_rcpf(1.0f + __expf(-a)); }
__device__ __forceinline__ int pos_of_row(int row) { return row < MP ? (row & (SEQ - 1)) : PAST + ((row - MP) & (TS - 1)); }

typedef const pg8::f32x4 (&AccRef)[2][2][4][2];

__device__ __forceinline__ float ssq_lds(const LAS unsigned char* sl, int par, int rl) { return (float)(*(const LAS u64*)(sl + pg8::STAGE_BYTES + par * 2048 + rl * 8)) * (1.0f / 16777216.0f); }

struct EpiSwiglu {
    static constexpr bool PERM = true, AFTER_DRAIN = false, ADJ = false, SSQ_LDS = true;
    bf16* H; const u64* ssq; const LAS unsigned char* sl;
    __device__ __forceinline__ void operator()(AccRef acc, const pg8::Unit& u, int wr, int wc, int fr, int fq) const {
        const int row0 = u.pm * 256 + wr * 64 + fr, col0 = u.pn * 128 + wc * 32 + 8 * fq;
#pragma unroll
        for (int ai = 0; ai < 2; ++ai)
#pragma unroll
            for (int m = 0; m < 4; ++m) {
                const int row = row0 + ai * 128 + m * 16; const float rs = rsqrtf(ssq_lds(sl, u.par, row - u.pm * 256) * (1.0f / D) + EPS);
                float o[8];
#pragma unroll
                for (int n = 0; n < 2; ++n)
#pragma unroll
                    for (int j = 0; j < 4; ++j) { const float a = acc[ai][0][m][n][j] * rs, b = acc[ai][1][m][n][j] * rs; o[4 * n + j] = silu_f(a) * b; }
                v4u w; w.x = pk2(o[0], o[1]); w.y = pk2(o[2], o[3]); w.z = pk2(o[4], o[5]); w.w = pk2(o[6], o[7]);
                *(v4u*)(H + (size_t)row * DFF + col0) = w;
            }
    }
};

__device__ __forceinline__ unsigned swap8(unsigned v) { return (unsigned)__builtin_amdgcn_update_dpp(0, (int)v, 0x128, 0xf, 0xf, true); }
__device__ __forceinline__ v4u swap8(v4u v) { v4u r; r.x = swap8(v.x); r.y = swap8(v.y); r.z = swap8(v.z); r.w = swap8(v.w); return r; }

template <bool FIRST> struct EpiRes {
    static constexpr bool PERM = true, AFTER_DRAIN = false, ADJ = true, SSQ_LDS = false;
    const float* src32; bf16* XB; u64* ssq_next; float alpha;
    __device__ __forceinline__ void operator()(AccRef acc, const pg8::Unit& u, int wr, int wc, int fr, int fq) const {
        const int row0 = u.pm * 256 + wr * 64, colw = u.pn * 256 + wc * 64 + 8 * fq;
        const bool lo = fr < 8; const int r8 = fr & 7, cst = colw + (lo ? 0 : 32);
        v4u q[2][4][2];
        if constexpr (!FIRST) {
#pragma unroll
            for (int ai = 0; ai < 2; ++ai)
#pragma unroll
                for (int m = 0; m < 4; ++m)
#pragma unroll
                    for (int bj = 0; bj < 2; ++bj) q[ai][m][bj] = *(const v4u*)(XB + (size_t)(row0 + ai * 128 + m * 16 + fr) * XBP + colw + bj * 32);
        }
#pragma unroll
        for (int ai = 0; ai < 2; ++ai)
#pragma unroll
            for (int m = 0; m < 4; ++m) {
                const int rowb = row0 + ai * 128 + m * 16, row = rowb + fr; float ss = 0.f; v4u w[2];
#pragma unroll
                for (int bj = 0; bj < 2; ++bj) {
                    f32x4 s0, s1;
                    if constexpr (FIRST) { const float* sp = src32 + (size_t)row * D + colw + bj * 32; s0 = *(const f32x4*)sp; s1 = *(const f32x4*)(sp + 4); }
                    else { const v4u qq = q[ai][m][bj]; s0 = (f32x4){bflo(qq.x), bfhi(qq.x), bflo(qq.y), bfhi(qq.y)}; s1 = (f32x4){bflo(qq.z), bfhi(qq.z), bflo(qq.w), bfhi(qq.w)}; }
                    const f32x4 v0 = s0 + acc[ai][bj][m][0] * alpha, v1 = s1 + acc[ai][bj][m][1] * alpha;
                    w[bj].x = pk2(v0[0], v0[1]); w[bj].y = pk2(v0[2], v0[3]); w[bj].z = pk2(v1[0], v1[1]); w[bj].w = pk2(v1[2], v1[3]);
                    ss += (v0[0] * v0[0] + v0[1] * v0[1]) + (v0[2] * v0[2] + v0[3] * v0[3]) + (v1[0] * v1[0] + v1[1] * v1[1]) + (v1[2] * v1[2] + v1[3] * v1[3]);
                }
                const v4u got = swap8(lo ? w[1] : w[0]);
                const v4u sa = lo ? w[0] : got, sb = lo ? got : w[1];
                bf16* da = XB + (size_t)(rowb + r8) * XBP + cst;
                *(v4u*)da = sa; *(v4u*)(da + (size_t)8 * XBP) = sb;
                ss += __shfl_xor(ss, 16); ss += __shfl_xor(ss, 32);
                if (fq == 0) ssq_add(ssq_next + row, ss);
            }
    }
};

struct EpiPlain {
    static constexpr bool PERM = true, AFTER_DRAIN = false, ADJ = false, SSQ_LDS = false;
    bf16* O; int ldo; const u64* ssq;
    __device__ __forceinline__ void operator()(AccRef acc, const pg8::Unit& u, int wr, int wc, int fr, int fq) const {
        const int row0 = u.pm * 256 + wr * 64 + fr, col0 = u.pn * 256 + wc * 32 + 8 * fq;
#pragma unroll
        for (int ai = 0; ai < 2; ++ai)
#pragma unroll
            for (int m = 0; m < 4; ++m) {
                const int row = row0 + ai * 128 + m * 16; const float rs = ssq ? rsqrtf(ssq_get(ssq + row) * (1.0f / D) + EPS) : 1.0f;
#pragma unroll
                for (int bj = 0; bj < 2; ++bj) {
                    const f32x4 v0 = acc[ai][bj][m][0] * rs, v1 = acc[ai][bj][m][1] * rs;
                    v4u w; w.x = pk2(v0[0], v0[1]); w.y = pk2(v0[2], v0[3]); w.z = pk2(v1[0], v1[1]); w.w = pk2(v1[2], v1[3]);
                    *(v4u*)(O + (size_t)row * ldo + col0 + bj * 128) = w;
                }
            }
    }
};

struct EpiF32 {
    static constexpr bool PERM = true, AFTER_DRAIN = false, ADJ = false, SSQ_LDS = false;
    float* C; int ldc; const u64* ssq;
    __device__ __forceinline__ void operator()(AccRef acc, const pg8::Unit& u, int wr, int wc, int fr, int fq) const {
        const int row0 = u.pm * 256 + wr * 64 + fr, col0 = u.pn * 256 + wc * 32 + 8 * fq;
#pragma unroll
        for (int ai = 0; ai < 2; ++ai)
#pragma unroll
            for (int m = 0; m < 4; ++m) {
                const int row = row0 + ai * 128 + m * 16; const float rs = rsqrtf(ssq_get(ssq + row) * (1.0f / D) + EPS);
#pragma unroll
                for (int bj = 0; bj < 2; ++bj) {
                    float* d = C + (size_t)row * ldc + col0 + bj * 128;
                    *(f32x4*)d = acc[ai][bj][m][0] * rs; *(f32x4*)(d + 4) = acc[ai][bj][m][1] * rs;
                }
            }
    }
};

struct EpiMemKV {
    static constexpr bool PERM = true, AFTER_DRAIN = false, ADJ = false, SSQ_LDS = false;
    float* outk; float* outv; bf16* MKV; const float* ssq;
    __device__ __forceinline__ void operator()(AccRef acc, const pg8::Unit& u, int wr, int wc, int fr, int fq) const {
        const int row0 = u.pm * 256 + wr * 64 + fr, col0 = u.pn * 256 + wc * 32 + 8 * fq;
#pragma unroll
        for (int ai = 0; ai < 2; ++ai)
#pragma unroll
            for (int m = 0; m < 4; ++m) {
                const int row = row0 + ai * 128 + m * 16; const float rs = rsqrtf(ssq[row] * (1.0f / D) + EPS);
#pragma unroll
                for (int bj = 0; bj < 2; ++bj) {
                    const int col = col0 + bj * 128;
                    const f32x4 v0 = acc[ai][bj][m][0] * rs, v1 = acc[ai][bj][m][1] * rs;
                    float* d = (col < 512 ? outk + (size_t)row * 512 + col : outv + (size_t)row * 512 + (col - 512));
                    *(f32x4*)d = v0; *(f32x4*)(d + 4) = v1;
                    v4u w; w.x = pk2(v0[0], v0[1]); w.y = pk2(v0[2], v0[3]); w.z = pk2(v1[0], v1[1]); w.w = pk2(v1[2], v1[3]);
                    *(v4u*)(MKV + (size_t)row * 1024 + col) = w;
                }
            }
    }
};

struct EpiWin {
    static constexpr bool PERM = true, AFTER_DRAIN = false, ADJ = false, SSQ_LDS = true;
    bf16 *T1, *ZG, *QK, *BC; float* DT; const u64* ssq; const float *cosr, *sinr; const float* dt_bias; const LAS unsigned char* sl;
    __device__ __forceinline__ void operator()(AccRef acc, const pg8::Unit& u, int wr, int wc, int fr, int fq) const {
        const int pn = u.pn, row0 = u.pm * 256 + wr * 64 + fr, cl = wc * 32 + 8 * fq;
        if (pn < 36) {
            bf16* base; int pitch = 4096, colt;
            if (pn < 8) { base = ZG; colt = pn * 256; } else if (pn < 16) { base = ZG; colt = 2048 + (pn - 8) * 256; }
            else if (pn < 24) { base = T1; colt = (pn - 16) * 256; } else if (pn < 32) { base = T1; colt = 2048 + (pn - 24) * 256; }
            else { base = BC; pitch = 1024; colt = (pn - 32) * 256; }
#pragma unroll
            for (int ai = 0; ai < 2; ++ai)
#pragma unroll
                for (int m = 0; m < 4; ++m) {
                    const int row = row0 + ai * 128 + m * 16; const float rs = rsqrtf(ssq_lds(sl, u.par, row - u.pm * 256) * (1.0f / D) + EPS);
#pragma unroll
                    for (int bj = 0; bj < 2; ++bj) {
                        const f32x4 v0 = acc[ai][bj][m][0] * rs, v1 = acc[ai][bj][m][1] * rs;
                        v4u w; w.x = pk2(v0[0], v0[1]); w.y = pk2(v0[2], v0[3]); w.z = pk2(v1[0], v1[1]); w.w = pk2(v1[2], v1[3]);
                        *(v4u*)(base + (size_t)row * pitch + colt + cl + bj * 128) = w;
                    }
                }
        } else if (pn < 52) {
            const bool isk = pn >= 44; const int head = isk ? pn - 44 : pn - 36; const int colt = (isk ? 2048 : 0) + head * 256; const float sc = isk ? 0.0625f : 1.0f;
            float invt[8];
#pragma unroll
            for (int e = 0; e < 8; ++e) invt[e] = (float)(INV_R[cl + e] * 0.15915494309189533577);
#pragma unroll
            for (int ai = 0; ai < 2; ++ai)
#pragma unroll
                for (int m = 0; m < 4; ++m) {
                    const int row = row0 + ai * 128 + m * 16; const float rs = rsqrtf(ssq_lds(sl, u.par, row - u.pm * 256) * (1.0f / D) + EPS) * sc;
                    const float posf = (float)pos_of_row(row);
                    f32x4 c0, c1, s0, s1;
#pragma unroll
                    for (int e = 0; e < 4; ++e) { const float t0 = __builtin_amdgcn_fractf(posf * invt[e]), t1 = __builtin_amdgcn_fractf(posf * invt[4 + e]);
                        c0[e] = __builtin_amdgcn_cosf(t0); s0[e] = __builtin_amdgcn_sinf(t0); c1[e] = __builtin_amdgcn_cosf(t1); s1[e] = __builtin_amdgcn_sinf(t1); }
                    const f32x4 a0 = acc[ai][0][m][0] * rs, a1 = acc[ai][0][m][1] * rs, b0 = acc[ai][1][m][0] * rs, b1 = acc[ai][1][m][1] * rs;
                    const f32x4 x0 = a0 * c0 - b0 * s0, x1 = a1 * c1 - b1 * s1, y0 = b0 * c0 + a0 * s0, y1 = b1 * c1 + a1 * s1;
                    v4u w; w.x = pk2(x0[0], x0[1]); w.y = pk2(x0[2], x0[3]); w.z = pk2(x1[0], x1[1]); w.w = pk2(x1[2], x1[3]);
                    *(v4u*)(QK + (size_t)row * 4096 + colt + cl) = w;
                    v4u z; z.x = pk2(y0[0], y0[1]); z.y = pk2(y0[2], y0[3]); z.z = pk2(y1[0], y1[1]); z.w = pk2(y1[2], y1[3]);
                    *(v4u*)(QK + (size_t)row * 4096 + colt + 128 + cl) = z;
                }
        } else {
            if (wc == 0) {
#pragma unroll
                for (int ai = 0; ai < 2; ++ai)
#pragma unroll
                    for (int m = 0; m < 4; ++m) {
                        const int row = row0 + ai * 128 + m * 16; const float rs = rsqrtf(ssq_lds(sl, u.par, row - u.pm * 256) * (1.0f / D) + EPS);
                        const f32x4 v0 = acc[ai][0][m][0] * rs, v1 = acc[ai][0][m][1] * rs;
                        *(f32x4*)(DT + (size_t)row * 32 + cl) = v0; *(f32x4*)(DT + (size_t)row * 32 + cl + 4) = v1;
                    }
            }
        }
    }
};

struct EpiUq {
    static constexpr bool PERM = true, AFTER_DRAIN = false, ADJ = false, SSQ_LDS = false;
    bf16 *QN, *QR; const float *cosm, *sinm;
    __device__ __forceinline__ void operator()(AccRef acc, const pg8::Unit& u, int wr, int wc, int fr, int fq) const {
        const int pn = u.pn, row0 = u.pm * 256 + wr * 64 + fr, cl = wc * 32 + 8 * fq;
        if (pn < 8) {
#pragma unroll
            for (int ai = 0; ai < 2; ++ai)
#pragma unroll
                for (int m = 0; m < 4; ++m) {
                    const int row = row0 + ai * 128 + m * 16;
#pragma unroll
                    for (int bj = 0; bj < 2; ++bj) {
                        const f32x4 v0 = acc[ai][bj][m][0], v1 = acc[ai][bj][m][1];
                        v4u w; w.x = pk2(v0[0], v0[1]); w.y = pk2(v0[2], v0[3]); w.z = pk2(v1[0], v1[1]); w.w = pk2(v1[2], v1[3]);
                        *(v4u*)(QN + (size_t)row * D + pn * 256 + cl + bj * 128) = w;
                    }
                }
        } else {
            const int head = 4 * (pn - 8) + wc, i0 = 8 * fq;
#pragma unroll
            for (int ai = 0; ai < 2; ++ai)
#pragma unroll
                for (int m = 0; m < 4; ++m) {
                    const int row = row0 + ai * 128 + m * 16; const int pos = pos_of_row(row);
                    const f32x4 c0 = *(const f32x4*)(cosm + (size_t)pos * 32 + i0), c1 = *(const f32x4*)(cosm + (size_t)pos * 32 + i0 + 4);
                    const f32x4 s0 = *(const f32x4*)(sinm + (size_t)pos * 32 + i0), s1 = *(const f32x4*)(sinm + (size_t)pos * 32 + i0 + 4);
                    const f32x4 a0 = acc[ai][0][m][0], a1 = acc[ai][0][m][1], b0 = acc[ai][1][m][0], b1 = acc[ai][1][m][1];
                    const f32x4 x0 = a0 * c0 - b0 * s0, x1 = a1 * c1 - b1 * s1, y0 = b0 * c0 + a0 * s0, y1 = b1 * c1 + a1 * s1;
                    v4u w; w.x = pk2(x0[0], x0[1]); w.y = pk2(x0[2], x0[3]); w.z = pk2(x1[0], x1[1]); w.w = pk2(x1[2], x1[3]);
                    *(v4u*)(QR + (size_t)row * 1024 + head * 64 + i0) = w;
                    v4u z; z.x = pk2(y0[0], y0[1]); z.y = pk2(y0[2], y0[3]); z.z = pk2(y1[0], y1[1]); z.w = pk2(y1[2], y1[3]);
                    *(v4u*)(QR + (size_t)row * 1024 + head * 64 + 32 + i0) = z;
                }
        }
    }
};

struct SplitOrder {
    int nN, KS, nun, G, c;
    __device__ __forceinline__ void init(int Mrows, int N, int KS_, int G_, int c_) { nN = N / 256; KS = KS_; nun = (Mrows / 256) * nN * KS_; G = G_; c = c_; }
    __device__ __forceinline__ bool next(int i, pg8::Unit& u) const { const int L = i * G + c; if (L >= nun) return false; u.kp = L % KS; const int t = L / KS; u.pn = t % nN; u.pm = t / nN; return true; }
    __device__ __forceinline__ void a_ready(const pg8::Unit&) const {}
    __device__ __forceinline__ void done(const pg8::Unit&) const {}
};
struct EpiPart {
    static constexpr bool PERM = true, AFTER_DRAIN = false, ADJ = false, SSQ_LDS = false;
    float* PART; int ldc; size_t slab;
    __device__ __forceinline__ void operator()(AccRef acc, const pg8::Unit& u, int wr, int wc, int fr, int fq) const {
        const int row0 = u.pm * 256 + wr * 64 + fr, col0 = u.pn * 256 + wc * 32 + 8 * fq; float* base = PART + (size_t)u.kp * slab;
#pragma unroll
        for (int ai = 0; ai < 2; ++ai)
#pragma unroll
            for (int m = 0; m < 4; ++m) {
                float* d = base + (size_t)(row0 + ai * 128 + m * 16) * ldc + col0;
#pragma unroll
                for (int bj = 0; bj < 2; ++bj) { *(f32x4*)(d + bj * 128) = acc[ai][bj][m][0]; *(f32x4*)(d + bj * 128 + 4) = acc[ai][bj][m][1]; }
            }
    }
};

__device__ __forceinline__ pg8::StaticOrder make_order(int Mrows, int N, int G, int wg, int rot) { pg8::StaticOrder S; S.init(Mrows, N, G, (wg + G - (rot % G)) % G); return S; }

template <class SM>
__device__ __forceinline__ void cvt_weight(const float* __restrict__ W, int K, int ldw, const float* __restrict__ g, int glim, bf16* __restrict__ Bt, int Npad, SM sm,
                                           LAS float* scrf, int gw, int NGW, int lane) {
    LAS bf16* scr = (LAS bf16*)scrf;
    const int nblk = Npad >> 6, items = (K >> 6) * nblk;
    const int c = lane & 7;
    for (int it = gw; it < items; it += NGW) {
        const int kb = it / nblk, nb = it - kb * nblk, k0 = kb << 6, n0 = nb << 6;
        const int src = sm(n0 + (lane & 32));
        float wv[64];
#pragma unroll
        for (int i = 0; i < 64; ++i) wv[i] = src >= 0 ? __builtin_nontemporal_load(W + (size_t)(k0 + i) * ldw + src + (lane & 31)) : 0.f;
#pragma unroll
        for (int i = 0; i < 64; ++i) { float w = wv[i]; if (g != nullptr && k0 + i < glim) w *= g[k0 + i]; scr[i * 66 + lane] = (bf16)f2bf(w); }
        LDS_WAIT(); asm volatile("" ::: "memory");
#pragma unroll
        for (int j = 0; j < 8; ++j) {
            const int n = (lane >> 3) + 8 * j; const LAS bf16* s = scr + (8 * c) * 66 + n;
            v4u o; o.x = (unsigned)s[0] | ((unsigned)s[66] << 16); o.y = (unsigned)s[2 * 66] | ((unsigned)s[3 * 66] << 16); o.z = (unsigned)s[4 * 66] | ((unsigned)s[5 * 66] << 16); o.w = (unsigned)s[6 * 66] | ((unsigned)s[7 * 66] << 16);
            *(v4u*)(Bt + (size_t)(n0 + n) * K + k0 + 8 * c) = o;
        }
        LDS_WAIT(); asm volatile("" ::: "memory");
    }
}
struct SmId { int lim; __device__ __forceinline__ int operator()(int n) const { return n < lim ? n : -1; } };
struct SmW1 { __device__ __forceinline__ int operator()(int n) const { const int t = n >> 8, j = n & 255; return j < 128 ? 128 * t + j : DFF + 128 * t + (j - 128); } };
struct SmWin { __device__ __forceinline__ int operator()(int n) const { const int t = n >> 8;
    if (t < 8) return n; if (t < 16) return 11296 + (n - 2048); if (t < 24) return 2048 + (n - 4096); if (t < 32) return 9248 + (n - 6144);
    if (t < 36) return 4096 + (n - 8192); if (t < 44) return 5152 + (n - 9216); if (t < 52) return 7200 + (n - 11264);
    return (n - 13312) < 32 ? 5120 + (n - 13312) : -1; } };
struct SmUq { __device__ __forceinline__ int operator()(int n) const {
    if (n < 2048) return (n >> 7) * 192 + (n & 127);
    const int t = (n - 2048) >> 8, j = (n - 2048) & 255, half = j >> 7, hh = (j & 127) >> 5, i = j & 31; return (4 * t + hh) * 192 + 128 + half * 32 + i; } };

__device__ __forceinline__ float row_to_bf16(const float* __restrict__ src, bf16* __restrict__ dst, int lane) {
    float ss = 0.f;
#pragma unroll
    for (int j = 0; j < 8; ++j) {
        const f32x4 v = __builtin_nontemporal_load((const f32x4*)(src + 4 * (lane + 64 * j)));
        ss += (v[0] * v[0] + v[1] * v[1]) + (v[2] * v[2] + v[3] * v[3]);
        v2u w; w.x = pk2(v[0], v[1]); w.y = pk2(v[2], v[3]);
        *(v2u*)(dst + 4 * (lane + 64 * j)) = w;
    }
    return wave_sum(ss);
}
__device__ __forceinline__ void cvt_bulk(const float* __restrict__ src, bf16* __restrict__ dst, size_t n8, size_t gt, size_t ngt) {
    for (size_t i = gt; i < n8; i += ngt) {
        const f32x4 a = __builtin_nontemporal_load((const f32x4*)(src + i * 8)), b = __builtin_nontemporal_load((const f32x4*)(src + i * 8 + 4));
        v4u w; w.x = pk2(a[0], a[1]); w.y = pk2(a[2], a[3]); w.z = pk2(b[0], b[1]); w.w = pk2(b[2], b[3]);
        *(v4u*)(dst + i * 8) = w;
    }
}

namespace att {
constexpr int SHM_V = 16384, SHM_K = 16384, SHM_R = 8192;
constexpr int OFF_V = 0, OFF_K = 2 * SHM_V, OFF_R = OFF_K + 2 * SHM_K, OFF_WS = OFF_R + 2 * SHM_R, LDS_NEED = OFF_WS + NWAVES * 64 * 4;
#define KSWZ(row, colB) ((row) * 256 + ((colB) ^ (((row) & 7) << 4)))
#define RSWZ(row, colB) ((row) * 128 + ((colB) ^ (((row) & 7) << 4)))
#define SBAR() __builtin_amdgcn_sched_barrier(0)
__device__ __forceinline__ int crow(int r, int hi) { return (r & 3) + 8 * (r >> 2) + 4 * hi; }
__device__ __forceinline__ unsigned cvtpk(float lo, float hi) { unsigned r; asm volatile("v_cvt_pk_bf16_f32 %0, %1, %2" : "=v"(r) : "v"(lo), "v"(hi)); return r; }

__device__ __forceinline__ void partialSM(f32x16& p0, f32x16& p1, float& m_reg, float& mn, float& alpha, float C, float thr_s) {
    float pmax = p0[0];
#pragma unroll
    for (int r = 1; r < 16; ++r) pmax = fmaxf(pmax, p0[r]);
#pragma unroll
    for (int r = 0; r < 16; ++r) pmax = fmaxf(pmax, p1[r]);
    { auto rr = __builtin_amdgcn_permlane32_swap(__float_as_uint(pmax), __float_as_uint(pmax), false, false);
      pmax = fmaxf(__uint_as_float(rr[0]), __uint_as_float(rr[1])); }
    if (__builtin_expect(__all(pmax - m_reg <= thr_s), 1)) { mn = m_reg; alpha = 1.f; }
    else { mn = fmaxf(m_reg, pmax); alpha = __builtin_amdgcn_exp2f((m_reg - mn) * C); m_reg = mn; }
    const float mnC = -mn * C;
#pragma unroll
    for (int r = 0; r < 16; ++r) p0[r] = fmaf(p0[r], C, mnC);
#pragma unroll
    for (int r = 0; r < 16; ++r) p1[r] = fmaf(p1[r], C, mnC);
#pragma unroll
    for (int r = 0; r < 16; ++r) p0[r] = __builtin_amdgcn_exp2f(p0[r]);
}
__device__ __forceinline__ void finishSM(f32x16& p0, f32x16& p1, float alpha, float& l_reg, bf16x8& pa0, bf16x8& pa1, bf16x8& pa2, bf16x8& pa3) {
#pragma unroll
    for (int r = 0; r < 16; ++r) p1[r] = __builtin_amdgcn_exp2f(p1[r]);
    float ps = 0;
#pragma unroll
    for (int r = 0; r < 16; ++r) ps += p0[r];
#pragma unroll
    for (int r = 0; r < 16; ++r) ps += p1[r];
    { auto rr = __builtin_amdgcn_permlane32_swap(__float_as_uint(ps), __float_as_uint(ps), false, false);
      ps = __uint_as_float(rr[0]) + __uint_as_float(rr[1]); }
    l_reg = l_reg * alpha + ps;
#define PK4(P, BASE, OUT) do { unsigned a0 = cvtpk(P[BASE + 0], P[BASE + 1]), a1 = cvtpk(P[BASE + 2], P[BASE + 3]);   \
    unsigned b0 = cvtpk(P[BASE + 4], P[BASE + 5]), b1 = cvtpk(P[BASE + 6], P[BASE + 7]);                              \
    auto r0 = __builtin_amdgcn_permlane32_swap(a0, b0, false, false); auto r1 = __builtin_amdgcn_permlane32_swap(a1, b1, false, false); \
    v4u w = {r0[0], r1[0], r0[1], r1[1]}; OUT = *reinterpret_cast<bf16x8*>(&w); } while (0)
    PK4(p0, 0, pa0); PK4(p0, 8, pa1); PK4(p1, 0, pa2); PK4(p1, 8, pa3);
#undef PK4
}
template <int DR>
__device__ __forceinline__ void qkt(f32x16& p0, f32x16& p1, const LAS unsigned char* Ks, const LAS unsigned char* Rs, const bf16x8* qr, const bf16x8* qrr, int r32, int hi) {
    p0 = f32x16{}; p1 = f32x16{};
#pragma unroll
    for (int d0 = 0; d0 < 8; ++d0) { const int cb = (d0 * 16 + hi * 8) * 2;
        const bf16x8 b0 = *(const LAS bf16x8*)(Ks + KSWZ(r32, cb));
        const bf16x8 b1 = *(const LAS bf16x8*)(Ks + KSWZ(32 + r32, cb));
        p0 = __builtin_amdgcn_mfma_f32_32x32x16_bf16(b0, qr[d0], p0, 0, 0, 0);
        p1 = __builtin_amdgcn_mfma_f32_32x32x16_bf16(b1, qr[d0], p1, 0, 0, 0); }
    if constexpr (DR > 0) {
#pragma unroll
        for (int d0 = 0; d0 < DR / 16; ++d0) { const int cb = (d0 * 16 + hi * 8) * 2;
            const bf16x8 b0 = *(const LAS bf16x8*)(Rs + RSWZ(r32, cb));
            const bf16x8 b1 = *(const LAS bf16x8*)(Rs + RSWZ(32 + r32, cb));
            p0 = __builtin_amdgcn_mfma_f32_32x32x16_bf16(b0, qrr[d0], p0, 0, 0, 0);
            p1 = __builtin_amdgcn_mfma_f32_32x32x16_bf16(b1, qrr[d0], p1, 0, 0, 0); }
    }
}
__device__ __forceinline__ void mask_tile(f32x16& p0, f32x16& p1, int tile, int kmax, int hi) {
    const int kb = tile * 64;
    if (kb + 64 > kmax) {
#pragma unroll
        for (int r = 0; r < 16; ++r) { const int k0 = kb + crow(r, hi); if (k0 >= kmax) p0[r] = -1e30f; if (k0 + 32 >= kmax) p1[r] = -1e30f; }
    }
}
__device__ __forceinline__ int v_st(int k, int c) { const int kk = (k & ~0xC) | ((k & 4) << 1) | ((k & 8) >> 1); return ((kk >> 3) * 4 + (c >> 5)) * 512 + ((kk & 7) * 32 + (c & 31)) * 2; }
__device__ __forceinline__ int v_rd_base(int lane) { return ((lane & 3) << 3) | (((lane >> 2) & 3) << 6) | (((lane >> 4) & 1) << 5) | (((lane >> 5) & 1) << 8); }
constexpr int v_rd_off(int d0, int ks, int half) { return d0 * 512 + ks * 4096 + half * 2048; }
template <int OFF> __device__ __forceinline__ s16x4 tr_read(int vb) {
    s16x4 r; asm volatile("ds_read_b64_tr_b16 %0, %1 offset:%2" : "=&v"(r) : "v"(vb), "i"(OFF) : "memory"); return r;
}
template <int D0> __device__ __forceinline__ void pv_one(f32x16& od, int vb, bf16x8 pa0, bf16x8 pa1, bf16x8 pa2, bf16x8 pa3) {
    const s16x4 l0 = tr_read<v_rd_off(D0, 0, 0)>(vb), h0 = tr_read<v_rd_off(D0, 0, 1)>(vb), l1 = tr_read<v_rd_off(D0, 1, 0)>(vb), h1 = tr_read<v_rd_off(D0, 1, 1)>(vb);
    const s16x4 l2 = tr_read<v_rd_off(D0, 2, 0)>(vb), h2 = tr_read<v_rd_off(D0, 2, 1)>(vb), l3 = tr_read<v_rd_off(D0, 3, 0)>(vb), h3 = tr_read<v_rd_off(D0, 3, 1)>(vb);
    asm volatile("s_waitcnt lgkmcnt(0)" ::: "memory"); SBAR();
#define PK(L, H) (bf16x8){L[0], L[1], L[2], L[3], H[0], H[1], H[2], H[3]}
    od = __builtin_amdgcn_mfma_f32_32x32x16_bf16(pa0, PK(l0, h0), od, 0, 0, 0);
    od = __builtin_amdgcn_mfma_f32_32x32x16_bf16(pa1, PK(l1, h1), od, 0, 0, 0);
    od = __builtin_amdgcn_mfma_f32_32x32x16_bf16(pa2, PK(l2, h2), od, 0, 0, 0);
    od = __builtin_amdgcn_mfma_f32_32x32x16_bf16(pa3, PK(l3, h3), od, 0, 0, 0);
#undef PK
}
__device__ __forceinline__ void pv_d0(f32x16* o, int vb, bf16x8 pa0, bf16x8 pa1, bf16x8 pa2, bf16x8 pa3) {
    pv_one<0>(o[0], vb, pa0, pa1, pa2, pa3); pv_one<1>(o[1], vb, pa0, pa1, pa2, pa3); pv_one<2>(o[2], vb, pa0, pa1, pa2, pa3); pv_one<3>(o[3], vb, pa0, pa1, pa2, pa3);
}

template <int DR, bool PP, bool NTL, class KN, class KR, class VV>
__device__ __forceinline__ void attn_unit(LAS unsigned char* lds, const bf16* qn, const bf16* qrp, KN kn, KR kr, VV vv, int NT, int kmax, float C, float thr_s,
                                          bf16* orow0, int ldo, int nvalid, bool active, int wave_id) {
    const int wid = wave_id, lane = lane_id(), tid = wid * 64 + lane, r32 = lane & 31, hi = lane >> 5;
    LAS unsigned char* V_lds = lds + OFF_V; LAS unsigned char* K_lds = lds + OFF_K; LAS unsigned char* R_lds = lds + OFF_R;
    LAS float* ws = (LAS float*)(lds + OFF_WS) + wid * 64; LAS float* li_l = ws; LAS float* al_l = ws + 32;
    float m_reg = -1e30f, l_reg = 0.f; f32x16 o[4] = {}; bf16x8 qr[8]; bf16x8 qrr[DR > 0 ? DR / 16 : 1];
#pragma unroll
    for (int d0 = 0; d0 < 8; ++d0) qr[d0] = *(const bf16x8*)(qn + d0 * 16 + hi * 8);
    if constexpr (DR > 0) {
#pragma unroll
        for (int d0 = 0; d0 < DR / 16; ++d0) qrr[d0] = *(const bf16x8*)(qrp + d0 * 16 + hi * 8);
    }
    const int sr = tid >> 4, sc = (tid & 15) * 8, vst0 = v_st(sr, sc), vst1 = v_st(32 + sr, sc), rr_ = tid >> 3, rc = (tid & 7) * 8;
    const int vb0 = (int)(unsigned)(uintptr_t)V_lds + v_rd_base(lane);
    bf16x8 s_vs0, s_vs1, s_ks0, s_ks1, s_rs;
    const bf16x8 zero8 = {0, 0, 0, 0, 0, 0, 0, 0};
#define ATT_LD8(p) (NTL ? __builtin_nontemporal_load((const bf16x8*)(p)) : *(const bf16x8*)(p))
#define SLOAD(k0) do { const bf16* _p; _p = vv((k0) + sr); s_vs0 = _p ? ATT_LD8(_p + sc) : zero8; _p = vv((k0) + 32 + sr); s_vs1 = _p ? ATT_LD8(_p + sc) : zero8; \
    _p = kn((k0) + sr); s_ks0 = _p ? ATT_LD8(_p + sc) : zero8; _p = kn((k0) + 32 + sr); s_ks1 = _p ? ATT_LD8(_p + sc) : zero8; \
    if constexpr (DR > 0) { _p = kr((k0) + rr_); s_rs = _p ? ATT_LD8(_p + rc) : zero8; } } while (0)
#define SWRITE(b) do { *(LAS bf16x8*)(V_lds + (b) * SHM_V + vst0) = s_vs0; *(LAS bf16x8*)(V_lds + (b) * SHM_V + vst1) = s_vs1; \
    *(LAS bf16x8*)(K_lds + (b) * SHM_K + KSWZ(sr, sc * 2)) = s_ks0; *(LAS bf16x8*)(K_lds + (b) * SHM_K + KSWZ(32 + sr, sc * 2)) = s_ks1; \
    if constexpr (DR > 0) { *(LAS bf16x8*)(R_lds + (b) * SHM_R + RSWZ(rr_, rc * 2)) = s_rs; } } while (0)
#define SWAIT() asm volatile("s_waitcnt vmcnt(0)" ::: "memory")
#define RESC(a) do { if (__any((a) < 1.f)) { if (hi == 0) al_l[r32] = (a); asm volatile("s_waitcnt lgkmcnt(0)" ::: "memory"); \
    _Pragma("unroll") for (int d = 0; d < 4; ++d) _Pragma("unroll") for (int r = 0; r < 16; ++r) o[d][r] *= al_l[crow(r, hi)]; } } while (0)
    f32x16 p0, p1; float mn, al = 1.f; bf16x8 pa0, pa1, pa2, pa3;
    SLOAD(0); SWAIT(); SWRITE(0); if (!PP && 1 < NT) SLOAD(64);
    if (PP) __syncthreads(); else { asm volatile("s_waitcnt lgkmcnt(0)" ::: "memory"); __builtin_amdgcn_s_barrier(); asm volatile("" ::: "memory"); }
    if constexpr (PP) {
        const bool grpA = wid < 4;
#define ATT_STAGE(j) do { if ((j) + 1 < NT) { SWAIT(); SWRITE(((j) + 1) & 1); if ((j) + 2 < NT) SLOAD(((j) + 2) * 64); } } while (0)
        if (1 < NT) SLOAD(64);
        if (!grpA) __syncthreads();
        for (int j = 0; j < NT; ++j) {
            SBAR();
            qkt<DR>(p0, p1, K_lds + (j & 1) * SHM_K, R_lds + (j & 1) * SHM_R, qr, qrr, r32, hi); mask_tile(p0, p1, j, kmax, hi);
            if (!grpA) ATT_STAGE(j);
            __syncthreads();
            partialSM(p0, p1, m_reg, mn, al, C, thr_s); RESC(al); finishSM(p0, p1, al, l_reg, pa0, pa1, pa2, pa3); SBAR();
            pv_d0(o, vb0 + (j & 1) * SHM_V, pa0, pa1, pa2, pa3);
            if (grpA) ATT_STAGE(j);
            __syncthreads();
        }
        if (grpA) __syncthreads();
#undef ATT_STAGE
    } else {
    for (int j = 0; j < NT; ++j) {
        const int bsel = j & 1;
        if (j + 1 < NT) { SWAIT(); SWRITE(bsel ^ 1); if (j + 2 < NT) SLOAD((j + 2) * 64); }
        SBAR();
        if (active) {
            qkt<DR>(p0, p1, K_lds + bsel * SHM_K, R_lds + bsel * SHM_R, qr, qrr, r32, hi); mask_tile(p0, p1, j, kmax, hi);
            partialSM(p0, p1, m_reg, mn, al, C, thr_s);
            RESC(al);
            finishSM(p0, p1, al, l_reg, pa0, pa1, pa2, pa3); SBAR();
            pv_d0(o, vb0 + bsel * SHM_V, pa0, pa1, pa2, pa3);
        }
        __syncthreads();
    }
    }
    if (active) {
        if (hi == 0) li_l[r32] = l_reg; asm volatile("s_waitcnt lgkmcnt(0)" ::: "memory");
#pragma unroll
        for (int r = 0; r < 16; ++r) { const int orow = crow(r, hi); const float rli = __builtin_amdgcn_rcpf(li_l[orow]);
            if (orow < nvalid) {
#pragma unroll
                for (int d0 = 0; d0 < 4; ++d0) orow0[(size_t)orow * ldo + d0 * 32 + r32] = (bf16)f2bf(o[d0][r] * rli); } }
    }
    __syncthreads();
#undef SLOAD
#undef ATT_LD8
#undef SWRITE
#undef SWAIT
#undef RESC
}
}

namespace scan {
constexpr int PC = 136, PT = 72, PH = 264;
constexpr int O_BV = 0, O_XT = 16384, O_XW = O_XT + 4096, O_CS = O_XW + 4096, O_BS = O_CS + 64 * PC * 2, O_GS = O_BS + 64 * PC * 2,
              O_HT = O_GS + 64 * PT * 2, O_YS = O_HT + 32 * PH * 2, O_XSF = O_YS + 64 * 33 * 4, O_ZS = O_XSF + 64 * 32 * 4, O_CUM = O_ZS + 64 * 32 * 4,
              O_DTL = O_CUM + 2 * 5 * 64 * 4, O_END = O_DTL + 8192 * 4;
static_assert(O_END <= MISC_OFF, "scan LDS");
struct Bufs { bf16 *T1, *ZG, *QK, *BC; const float* DT; float *SSQG, *SSQH; const float *alog, *dskip; };

__device__ __forceinline__ int v_st32(int k, int c) { const int kk = (k & ~0xC) | ((k & 4) << 1) | ((k & 8) >> 1); return (kk >> 3) * 512 + ((kk & 7) * 32 + c) * 2; }
#define TRPK(L, H) (bf16x8){L[0], L[1], L[2], L[3], H[0], H[1], H[2], H[3]}
#define TRKL(k) const s16x4 _al##k = att::tr_read<(2 * (k)) * 512>(xwb), _ah##k = att::tr_read<(2 * (k) + 1) * 512>(xwb), _bl##k = att::tr_read<(k) * 4096>(bvb), _bh##k = att::tr_read<(k) * 4096 + 2048>(bvb)
#define TRKM(k) hacc = __builtin_amdgcn_mfma_f32_32x32x16_bf16(TRPK(_al##k, _ah##k), TRPK(_bl##k, _bh##k), hacc, 0, 0, 0)
#define TRYL(k) const bf16x8 _ya##k = frag(GS, PT, 32 * ti + r32, 16 * (k) + 8 * hi); const s16x4 _yl##k = att::tr_read<(2 * (k)) * 512>(xtb), _yh##k = att::tr_read<(2 * (k) + 1) * 512>(xtb)
#define TRYM(k) gacc = __builtin_amdgcn_mfma_f32_32x32x16_bf16(_ya##k, TRPK(_yl##k, _yh##k), gacc, 0, 0, 0)
__device__ __forceinline__ bf16x8 frag(const LAS unsigned char* base, int pitch, int row, int k0) { return *(const LAS bf16x8*)(base + (row * pitch + k0) * 2); }

template <bool SSD>
__device__ __forceinline__ void scan_unit(LAS unsigned char* lds, const Bufs& B, int rowbase, int nchunks, int tv_last, int h, int sl,
                                          const float* h0, float* hout, int wave_id) {
    constexpr int NS = SSD ? 128 : 256, NH = NS / 128, PF = SSD ? 64 : 256, PHT = NS + 8;
    const int wid = wave_id, lane = lane_id(), tid = wid * 64 + lane, r32 = lane & 31, hi = lane >> 5;
    LAS unsigned char* CS = lds + O_CS; LAS unsigned char* BS = lds + O_BS; LAS unsigned char* BV = lds + O_BV; LAS unsigned char* XT = lds + O_XT;
    LAS unsigned char* XW = lds + O_XW; LAS unsigned char* GS = lds + O_GS; LAS unsigned char* HT = lds + O_HT;
    LAS float* YS = (LAS float*)(lds + O_YS); LAS float* XSF = (LAS float*)(lds + O_XSF); LAS float* ZS = (LAS float*)(lds + O_ZS);
    LAS float* DTL = (LAS float*)(lds + O_DTL);
    LAS float* CUMB = (LAS float*)(lds + O_CUM);
    const int g = h >> 3;
    const bool has_state = SSD ? (wid < 4) : true;
    const int n0 = wid * 32;
    const float a_h = SSD ? -__expf(B.alog[h]) : 0.f, lgam = SSD ? 0.f : LOG_GAMMA[h], dsk = SSD ? B.dskip[h] : 0.f;
    const int xcol = SSD ? h * 64 + sl * 32 : 2048 + h * 256 + sl * 32;
    const int isB = wid >> 2, tt = tid & 255;
    const bf16* cbsrc = SSD ? B.BC + (isB ? 0 : 512) + g * 128 : B.QK + (isB ? 2048 : 0) + h * 256; const int cbp = SSD ? 1024 : 4096;
    f32x16 hacc = {}, gacc = {};
    v4u rX = {0u, 0u, 0u, 0u}, rZ = {0u, 0u, 0u, 0u}, rCB[NH][4]; float rdt = 0.f;
    const v4u zero4 = {0u, 0u, 0u, 0u};
#define SC_SYNC() do { asm volatile("s_waitcnt lgkmcnt(0)" ::: "memory"); __builtin_amdgcn_s_barrier(); asm volatile("" ::: "memory"); } while (0)
#define SC_TV(c) (((c) == nchunks - 1) ? tv_last : 64)
#define SC_LOAD_X(c) do { const int _tv = SC_TV(c); const size_t _R0 = (size_t)rowbase + (size_t)(c) * 64; if (tid < 256) { const int _l = tid >> 2, _c8 = (tid & 3) * 8; \
        rX = _l < _tv ? *(const v4u*)(B.T1 + (_R0 + _l) * 4096 + xcol + _c8) : zero4; if (SSD) rZ = _l < _tv ? *(const v4u*)(B.ZG + (_R0 + _l) * 4096 + xcol + _c8) : zero4; } } while (0)
#define SC_LOAD_CB(c, nh) do { const int _tv = SC_TV(c); const size_t _R0 = (size_t)rowbase + (size_t)(c) * 64; _Pragma("unroll") for (int _i = 0; _i < 4; ++_i) { const int _id = tt + 256 * _i, _row = _id >> 4, _oct = _id & 15; \
        rCB[nh][_i] = _row < _tv ? *(const v4u*)(cbsrc + (_R0 + _row) * cbp + (nh) * 128 + _oct * 8) : zero4; } } while (0)
#define SC_LOAD_DT(c) do { if (SSD && wid == 0) rdt = lane < SC_TV(c) ? DTL[(c) * 64 + lane] : 0.f; } while (0)
#define SC_CUM(c) do { if (wid == 0) { LAS float* _cb = CUMB + ((c) & 1) * 320; const float _la = SSD ? rdt * a_h : (lane < SC_TV(c) ? lgam : 0.f); float _cum = _la; \
        _Pragma("unroll") for (int _o = 1; _o < 64; _o <<= 1) { const float _t = __shfl_up(_cum, _o); if (lane >= _o) _cum += _t; } \
        const float _last = __shfl(_cum, 63); _cb[lane] = _cum; _cb[64 + lane] = __expf(_cum); _cb[128 + lane] = __expf(_last - _cum); _cb[192 + lane] = rdt; if (lane == 0) _cb[256] = __expf(_last); } } while (0)
#define SC_STAGE(c, nh) do { const LAS float* _cb = CUMB + ((c) & 1) * 320; \
        if ((nh) == 0 && tid < 256) { const int _l = tid >> 2, _c8 = (tid & 3) * 8; const float _dtl = SSD ? _cb[192 + _l] : 1.f, _wdl = _cb[128 + _l]; \
            const float _x[8] = {bflo(rX.x), bfhi(rX.x), bflo(rX.y), bfhi(rX.y), bflo(rX.z), bfhi(rX.z), bflo(rX.w), bfhi(rX.w)}; \
            float _X[8], _W[8]; _Pragma("unroll") for (int _i = 0; _i < 8; ++_i) { _X[_i] = _x[_i] * _dtl; _W[_i] = _X[_i] * _wdl; if (SSD) XSF[_l * 32 + _c8 + _i] = _x[_i]; } \
            { v4u _q; _q.x = pk2(_X[0], _X[1]); _q.y = pk2(_X[2], _X[3]); _q.z = pk2(_X[4], _X[5]); _q.w = pk2(_X[6], _X[7]); *(LAS v4u*)(XT + v_st32(_l, _c8)) = _q; \
              _q.x = pk2(_W[0], _W[1]); _q.y = pk2(_W[2], _W[3]); _q.z = pk2(_W[4], _W[5]); _q.w = pk2(_W[6], _W[7]); *(LAS v4u*)(XW + v_st32(_l, _c8)) = _q; } \
            if (SSD) { LAS float* _zs = ZS + _l * 32 + _c8; _zs[0] = bflo(rZ.x); _zs[1] = bfhi(rZ.x); _zs[2] = bflo(rZ.y); _zs[3] = bfhi(rZ.y); _zs[4] = bflo(rZ.z); _zs[5] = bfhi(rZ.z); _zs[6] = bflo(rZ.w); _zs[7] = bfhi(rZ.w); } } \
        { LAS unsigned char* _dst = isB ? BS : CS; \
          _Pragma("unroll") for (int _i = 0; _i < 4; ++_i) { const int _id = tt + 256 * _i, _row = _id >> 4, _oct = _id & 15; const v4u _w = rCB[nh][_i]; \
            *(LAS v4u*)(_dst + (_row * PC + _oct * 8) * 2) = _w; \
            if (isB) *(LAS v4u*)(BV + att::v_st(_row, _oct * 8)) = _w; } } \
        if ((c) + 1 < nchunks && (nh) == NH - 1) { SC_LOAD_X((c) + 1); _Pragma("unroll") for (int _hh = 0; _hh < NH; ++_hh) SC_LOAD_CB((c) + 1, _hh); } } while (0)

    if (SSD) { const int nrows = (nchunks - 1) * 64 + tv_last; for (int i = tid; i < nrows; i += 512) DTL[i] = B.DT[((size_t)rowbase + i) * 32 + h]; }
    __syncthreads();
    SC_LOAD_DT(0); SC_LOAD_X(0);
#pragma unroll
    for (int nh = 0; nh < NH; ++nh) SC_LOAD_CB(0, nh);
    if (has_state) {
        if (h0 != nullptr) {
#pragma unroll
            for (int q = 0; q < 4; ++q) { const f32x4 v = *(const f32x4*)(h0 + (size_t)(n0 + r32) * PF + sl * 32 + 8 * q + 4 * hi);
                hacc[4 * q + 0] = v[0]; hacc[4 * q + 1] = v[1]; hacc[4 * q + 2] = v[2]; hacc[4 * q + 3] = v[3]; }
        }
#pragma unroll
        for (int r = 0; r < 16; ++r) *(LAS bf16*)(HT + (att::crow(r, hi) * PHT + n0 + r32) * 2) = (bf16)f2bf(hacc[r]);
    }
    SC_CUM(0); if (nchunks > 1) SC_LOAD_DT(1);
    SC_SYNC();
    SC_STAGE(0, 0);
    for (int c = 0; c < nchunks; ++c) {
        const int R0 = rowbase + c * 64, tv = SC_TV(c);
        const LAS float* cb = CUMB + (c & 1) * 320;
#pragma unroll
        for (int nh = 0; nh < NH; ++nh) {
            if (nh > 0) { SC_SYNC(); SC_STAGE(c, nh); }
            SC_SYNC();
            if (wid < 4) {
                const int ti = wid >> 1, tj = wid & 1;
#pragma unroll
                for (int kb = 0; kb < 2; ++kb) { bf16x8 fa[4], fb[4];
#pragma unroll
                    for (int q = 0; q < 4; ++q) { const int k0 = 16 * (4 * kb + q) + 8 * hi; fa[q] = frag(CS, PC, 32 * ti + r32, k0); fb[q] = frag(BS, PC, 32 * tj + r32, k0); }
                    asm volatile("s_waitcnt lgkmcnt(0)" ::: "memory"); __builtin_amdgcn_sched_barrier(0);
#pragma unroll
                    for (int q = 0; q < 4; ++q) gacc = __builtin_amdgcn_mfma_f32_32x32x16_bf16(fa[q], fb[q], gacc, 0, 0, 0); }
            } else if (wid < 6) {
                const int ti = wid - 4;
#pragma unroll
                for (int kb = 0; kb < 2; ++kb) { bf16x8 fa[4], fb[4];
#pragma unroll
                    for (int q = 0; q < 4; ++q) { const int k0 = 16 * (4 * kb + q) + 8 * hi; fa[q] = frag(CS, PC, 32 * ti + r32, k0); fb[q] = frag(HT, PHT, r32, nh * 128 + k0); }
                    asm volatile("s_waitcnt lgkmcnt(0)" ::: "memory"); __builtin_amdgcn_sched_barrier(0);
#pragma unroll
                    for (int q = 0; q < 4; ++q) gacc = __builtin_amdgcn_mfma_f32_32x32x16_bf16(fa[q], fb[q], gacc, 0, 0, 0); }
            }
            if (has_state && (wid >> 2) == nh) {
                const float el = cb[256];
#pragma unroll
                for (int r = 0; r < 16; ++r) hacc[r] *= el;
                { const int xwb = (int)(unsigned)(uintptr_t)XW + att::v_rd_base(lane), bvb = (int)(unsigned)(uintptr_t)BV + att::v_rd_base(lane) + (wid & 3) * 512;
                  TRKL(0); TRKL(1); TRKL(2); TRKL(3);
                  asm volatile("s_waitcnt lgkmcnt(0)" ::: "memory"); __builtin_amdgcn_sched_barrier(0);
                  TRKM(0); TRKM(1); TRKM(2); TRKM(3); }
            }
        }
        if (wid < 4) { const int ti = wid >> 1, tj = wid & 1, s = 32 * tj + r32; const float cs = cb[s];
#pragma unroll
            for (int q = 0; q < 4; ++q) { const f32x4 cl4 = *(const LAS f32x4*)(cb + 32 * ti + 8 * q + 4 * hi);
#pragma unroll
                for (int e = 0; e < 4; ++e) { const int r = 4 * q + e, l = 32 * ti + att::crow(r, hi);
                    const float ex = __expf(fminf(cl4[e] - cs, 0.f)); const float v = l >= s ? gacc[r] * ex : 0.f;
                    *(LAS bf16*)(GS + (l * PT + s) * 2) = (bf16)f2bf(v); gacc[r] = 0.f; } } }
        SC_SYNC();
        if (wid >= 4 && wid < 6) { const int ti = wid - 4;
#pragma unroll
            for (int q = 0; q < 4; ++q) { const f32x4 e4 = *(const LAS f32x4*)(cb + 64 + 32 * ti + 8 * q + 4 * hi);
                gacc[4 * q + 0] *= e4[0]; gacc[4 * q + 1] *= e4[1]; gacc[4 * q + 2] *= e4[2]; gacc[4 * q + 3] *= e4[3]; }
            { const int xtb = (int)(unsigned)(uintptr_t)XT + att::v_rd_base(lane);
              TRYL(0); TRYL(1); TRYL(2); TRYL(3);
              asm volatile("s_waitcnt lgkmcnt(0)" ::: "memory"); __builtin_amdgcn_sched_barrier(0);
              TRYM(0); TRYM(1); TRYM(2); TRYM(3); }
            float xs_[16], zs_[16];
            if (SSD) {
#pragma unroll
                for (int r = 0; r < 16; ++r) { const int l = 32 * ti + att::crow(r, hi); xs_[r] = XSF[l * 32 + r32]; zs_[r] = ZS[l * 32 + r32]; } }
#pragma unroll
            for (int r = 0; r < 16; ++r) { const int l = 32 * ti + att::crow(r, hi); float y = gacc[r];
                if (SSD) y = (y + dsk * xs_[r]) * silu_f(zs_[r]);
                YS[l * 33 + r32] = y; gacc[r] = 0.f; } }
        if (has_state) {
#pragma unroll
            for (int r = 0; r < 16; ++r) *(LAS bf16*)(HT + (att::crow(r, hi) * PHT + n0 + r32) * 2) = (bf16)f2bf(hacc[r]); }
        if (c + 1 < nchunks) { SC_CUM(c + 1); if (c + 2 < nchunks) SC_LOAD_DT(c + 2); }
        SC_SYNC();
        if (c + 1 < nchunks) SC_STAGE(c + 1, 0);
        { const int l = tid >> 3, p4 = (tid & 7) * 4; float v[4]; float ss = 0.f;
#pragma unroll
          for (int i = 0; i < 4; ++i) { v[i] = YS[l * 33 + p4 + i]; ss += v[i] * v[i]; }
          ss += __shfl_xor(ss, 1); ss += __shfl_xor(ss, 2); ss += __shfl_xor(ss, 4);
          if (l < tv) {
              v2u w; w.x = pk2(v[0], v[1]); w.y = pk2(v[2], v[3]);
              *(v2u*)(B.T1 + (size_t)(R0 + l) * 4096 + xcol + p4) = w;
              if ((tid & 7) == 0) { if (SSD) B.SSQG[(size_t)(R0 + l) * 64 + g * 16 + (h & 7) * 2 + sl] = ss; else B.SSQH[(size_t)(R0 + l) * 64 + h * 8 + sl] = ss; }
          } }
    }
    if (has_state) {
#pragma unroll
        for (int q = 0; q < 4; ++q) { f32x4 v; v[0] = hacc[4 * q + 0]; v[1] = hacc[4 * q + 1]; v[2] = hacc[4 * q + 2]; v[3] = hacc[4 * q + 3];
            *(f32x4*)(hout + (size_t)(n0 + r32) * PF + sl * 32 + 8 * q + 4 * hi) = v; }
    }
    __syncthreads();
#undef SC_SYNC
#undef SC_TV
#undef SC_LOAD_X
#undef SC_LOAD_CB
#undef SC_LOAD_DT
#undef SC_CUM
#undef SC_STAGE
}
}

constexpr int N_PHASES = 37;
constexpr size_t S_HB = S_L0END;
static_assert(S_HB + (size_t)512 * 3 * 3072 * 2 <= S_MAX || true, "");
static_assert(O_SCR + S_HB + (size_t)512 * 3 * 3072 * 2 <= (size_t)1476395008, "halo buffer inside the workspace");

struct Ctx { LAS unsigned char* lds; unsigned char* ws; float* out; int G, wg, wave; };
#define CTX_GW() const int gw = C.wg * NWAVES + C.wave, NGW = C.G * NWAVES
#define CTX_GT() const size_t gt = (size_t)C.wg * (NWAVES * 64) + C.wave * 64 + lane_id(), NGT = (size_t)C.G * (NWAVES * 64)
#define W_SSQ ((u64*)(C.ws + O_SSQ))
#define W_XB ((bf16*)(C.ws + O_XB))
#define W_X (C.out + OUT_Y)
#define W_SCR (C.ws + O_SCR)

__device__ __forceinline__ void ph_prologue(const Ctx& C, const Params& P) {
    CTX_GW(); CTX_GT(); unsigned char* ws = C.ws; const int lane = lane_id();
    LAS float* wscr = (LAS float*)(C.lds + C.wave * 16384);
#pragma unroll 1
    for (int lf = 0; lf < 4; ++lf) {
        const int l = lf >> 1, f = lf & 1;
        cvt_weight(P.in[I_W1] + (size_t)lf * D * 2 * DFF, D, 2 * DFF, P.in[I_NORMS] + (l * 4 + (f ? 3 : 0)) * D, D, (bf16*)(ws + O_W1 + lf * SZ_W1), 2 * DFF, SmW1{}, wscr, gw, NGW, lane);
        cvt_weight(P.in[I_W2] + (size_t)lf * DFF * D, DFF, D, nullptr, 0, (bf16*)(ws + O_W2 + lf * SZ_W2), D, SmId{D}, wscr, gw, NGW, lane);
    }
    cvt_weight(P.in[I_ABWIN], D, 13344, P.in[I_NORMS] + 1 * D, D, (bf16*)(ws + O_WIN), WIN_N, SmWin{}, wscr, gw, NGW, lane);
    cvt_weight(P.in[I_ABWOUT], 4096, D, P.in[I_SSDN], 2048, (bf16*)(ws + O_WOUT), D, SmId{D}, wscr, gw, NGW, lane);
    cvt_weight(P.in[I_CWIN], D, 1088, P.in[I_NORMS] + (4 + 1) * D, D, (bf16*)(ws + O_CWIN), CWIN_N, SmId{1088}, wscr, gw, NGW, lane);
    cvt_weight(P.in[I_WUQ], 512, 3072, nullptr, 0, (bf16*)(ws + O_WUQ), 3072, SmUq{}, wscr, gw, NGW, lane);
    cvt_weight(P.in[I_WUK], 512, 2048, nullptr, 0, (bf16*)(ws + O_WKV), 2048, SmId{2048}, wscr, gw, NGW, lane);
    cvt_weight(P.in[I_WUV], 512, 2048, nullptr, 0, (bf16*)(ws + O_WKV) + (size_t)2048 * 512, 2048, SmId{2048}, wscr, gw, NGW, lane);
    cvt_weight(P.in[I_CWOUT], D, D, nullptr, 0, (bf16*)(ws + O_CWOUT), D, SmId{D}, wscr, gw, NGW, lane);
#pragma unroll 1
    for (int l = 0; l < 2; ++l) {
        cvt_weight(P.in[I_WMQ] + (size_t)l * D * 512, D, 512, P.in[I_NORMS] + (l * 4 + 2) * D, D, (bf16*)(ws + O_WMQ) + (size_t)l * 512 * D, 512, SmId{512}, wscr, gw, NGW, lane);
        cvt_weight(P.in[I_WMKV] + (size_t)l * D * 1024, D, 1024, P.in[I_MNORM] + l * D, D, (bf16*)(ws + O_WMKV) + (size_t)l * 1024 * D, 1024, SmId{1024}, wscr, gw, NGW, lane);
        cvt_weight(P.in[I_WMO] + (size_t)l * 512 * D, 512, D, nullptr, 0, (bf16*)(ws + O_WMO) + (size_t)l * D * 512, D, SmId{D}, wscr, gw, NGW, lane);
    }
    u64* SSQ = W_SSQ; bf16* XB = W_XB;
    for (int row = gw; row < M; row += NGW) {
        const float* src = row < MP ? P.in[I_XP] + (size_t)row * D : P.in[I_XS] + (size_t)(row - MP) * D;
        const float ss = row_to_bf16(src, XB + (size_t)row * XBP, lane);
        if (lane == 0) SSQ[row] = ssq_fix(ss);
    }
    { bf16* MB = (bf16*)(ws + O_MB); float* SSQM = (float*)(ws + O_SSQM);
      for (int row = gw; row < 1024; row += NGW) { const float ss = row_to_bf16(P.in[I_MEM] + (size_t)row * D, MB + (size_t)row * D, lane); if (lane == 0) SSQM[row] = ss; } }
    { float* COSR = (float*)(ws + O_COSR); float* SINR = (float*)(ws + O_SINR); float* COSM = (float*)(ws + O_COSM); float* SINM = (float*)(ws + O_SINM);
      for (size_t i = gt; i < (size_t)8192 * 160; i += NGT) {
        const int pos = (int)(i / 160), j = (int)(i % 160);
        const double inv = j < 128 ? INV_R[j] : INV_M[j - 128];
        const double t = (double)pos * inv * 0.15915494309189533577; const float fr = (float)(t - floor(t));
        const float sv = __builtin_amdgcn_sinf(fr), cv = __builtin_amdgcn_cosf(fr);
        if (j < 128) { COSR[(size_t)pos * 128 + j] = cv; SINR[(size_t)pos * 128 + j] = sv; } else { COSM[(size_t)pos * 32 + j - 128] = cv; SINM[(size_t)pos * 32 + j - 128] = sv; }
      } }
}

__device__ __forceinline__ void ph_w1(const Ctx& C, int lf) {
    const int L = lf >> 1, F = lf & 1;
    pg8::Gemm g{W_XB, (const bf16*)(C.ws + O_W1 + (size_t)lf * SZ_W1), M, 2 * DFF, D, XBP, D}; pg8::StaticOrder S = make_order(M, 2 * DFF, C.G, C.wg, 0);
    EpiSwiglu E{(bf16*)(W_SCR + S_H), W_SSQ + (size_t)(L * 4 + (F ? 3 : 0)) * M, C.lds};
    pg8::gemm_phase<EpiSwiglu, pg8::StaticOrder, true, true>(C.lds, g, S, E, C.wave);
    if (lf == 0) {
#pragma unroll 1
        for (int ml = 0; ml < 2; ++ml) {
            pg8::Gemm g2{(const bf16*)(C.ws + O_MB), (const bf16*)(C.ws + O_WMKV) + (size_t)ml * 1024 * D, 1024, 1024, D, D, D};
            pg8::StaticOrder S2 = make_order(1024, 1024, C.G, C.wg, (130 * 44) % 256 + 16 * ml);
            EpiMemKV E2{C.out + OUT_MEMK + (size_t)ml * 1024 * 512, C.out + OUT_MEMV + (size_t)ml * 1024 * 512, (bf16*)(C.ws + O_MKV) + (size_t)ml * 1024 * 1024, (const float*)(C.ws + O_SSQM)};
            pg8::gemm_phase<EpiMemKV, pg8::StaticOrder, true, true>(C.lds, g2, S2, E2, C.wave);
        }
    }
}

constexpr size_t S_PART_FFN = (size_t)384 << 20;
template <int KS, bool FIRST> __device__ __forceinline__ void res_gemm(const Ctx& C, const bf16* A, int lda, const bf16* Bt, int K, const float* src32, float alpha, u64* ssq_next, float* part) {
    { pg8::Gemm g{A, Bt, MP, D, K, lda, K}; pg8::StaticOrder S = make_order(MP, D, C.G, C.wg, 0);
      EpiRes<FIRST> E{src32, W_XB, ssq_next, alpha};
      pg8::gemm_phase<EpiRes<FIRST>, pg8::StaticOrder, true, true>(C.lds, g, S, E, C.wave); }
    { pg8::Gemm g{A + (size_t)MP * lda, Bt, MS, D, K, lda, K / KS}; SplitOrder S; S.init(MS, D, KS, C.G, C.wg);
      EpiPart E{part, D, (size_t)MS * D};
      pg8::gemm_phase<EpiPart, SplitOrder, true, true>(C.lds, g, S, E, C.wave); }
}
template <bool FIRST> __device__ __forceinline__ void ph_fin(const Ctx& C, const float* part, int KS, const float* src32, float alpha, u64* ssq_next) {
    CTX_GW(); const int lane = lane_id(); bf16* XB = W_XB;
    for (int it = gw; it < MS * 8; it += NGW) {
        const int r = it >> 3, c = (it & 7) * 256 + 4 * lane; const size_t o = (size_t)r * D + c;
        f32x4 a = *(const f32x4*)(part + o);
        for (int k = 1; k < KS; ++k) a += *(const f32x4*)(part + (size_t)k * MS * D + o);
        f32x4 s;
        if constexpr (FIRST) s = *(const f32x4*)(src32 + o); else { const v2u q = *(const v2u*)(XB + (size_t)(MP + r) * XBP + c); s = (f32x4){bflo(q.x), bfhi(q.x), bflo(q.y), bfhi(q.y)}; }
        const f32x4 v = s + a * alpha;
        v2u w; w.x = pk2(v[0], v[1]); w.y = pk2(v[2], v[3]); *(v2u*)(XB + (size_t)(MP + r) * XBP + c) = w;
        const float ss = wave_sum((v[0] * v[0] + v[1] * v[1]) + (v[2] * v[2] + v[3] * v[3]));
        if (lane == 0) ssq_add(ssq_next + MP + r, ss);
    }
}
template <bool FIRST> __device__ __forceinline__ void ph_w2(const Ctx& C, const Params& P, int lf) {
    const int L = lf >> 1, F = lf & 1;
    res_gemm<11, FIRST>(C, (const bf16*)(W_SCR + S_H), DFF, (const bf16*)(C.ws + O_W2 + (size_t)lf * SZ_W2), DFF, P.in[I_XP], 0.5f, W_SSQ + (size_t)(L * 4 + (F ? 4 : 1)) * M, (float*)(W_SCR + S_PART_FFN));
}
template <bool FIRST> __device__ __forceinline__ void ph_w2fin(const Ctx& C, const Params& P, int lf) {
    const int L = lf >> 1, F = lf & 1;
    ph_fin<FIRST>(C, (const float*)(W_SCR + S_PART_FFN), 11, P.in[I_XS], 0.5f, W_SSQ + (size_t)(L * 4 + (F ? 4 : 1)) * M);
}
__device__ __forceinline__ void ph_win(const Ctx& C, const Params& P) {
    pg8::Gemm g{W_XB, (const bf16*)(C.ws + O_WIN), M, WIN_N, D, XBP, D}; pg8::StaticOrder S = make_order(M, WIN_N, C.G, C.wg, 0);
    EpiWin E{(bf16*)(W_SCR + S_T1), (bf16*)(W_SCR + S_ZG), (bf16*)(W_SCR + S_QK), (bf16*)(W_SCR + S_BC), (float*)(W_SCR + S_DT), W_SSQ + (size_t)1 * M,
             (const float*)(C.ws + O_COSR), (const float*)(C.ws + O_SINR), P.in[I_DTB], C.lds};
    pg8::gemm_phase<EpiWin, pg8::StaticOrder, true, true>(C.lds, g, S, E, C.wave);
}
__device__ __forceinline__ const bf16* xbc_ptr(const bf16* T1, const bf16* BC, size_t row, int ch) { return ch < 2048 ? T1 + row * 4096 + ch : BC + row * 1024 + (ch - 2048); }
__device__ __forceinline__ void ph_halo(const Ctx& C) {
    CTX_GT(); const bf16* T1 = (const bf16*)(W_SCR + S_T1); const bf16* BC = (const bf16*)(W_SCR + S_BC); bf16* HB = (bf16*)(W_SCR + S_HB);
    for (size_t i = gt; i < (size_t)NBP * 128 * 3 * 384; i += NGT) {
        const int oct = (int)(i % 384), j = (int)((i / 384) % 3), cc = (int)(i / 1152), c = cc & 127, b = cc >> 7;
        if (c == 0) continue;
        const size_t row = (size_t)b * SEQ + c * 64 - 3 + j;
        *(v4u*)(HB + ((size_t)cc * 3 + j) * 3072 + oct * 8) = *(const v4u*)xbc_ptr(T1, BC, row, oct * 8);
    }
    for (size_t i = gt; i < (size_t)(NBP + NBS) * 3 * 384; i += NGT) {
        const int oct = (int)(i % 384), j = (int)((i / 384) % 3), b = (int)(i / 1152);
        const size_t row = b < NBP ? (size_t)b * SEQ + SEQ - 3 + j : (size_t)MP + (b - NBP) * TS + TS - 3 + j;
        float* o = b < NBP ? C.out + OUT_CONVP + (size_t)(b * 3 + j) * 3072 + oct * 8 : C.out + OUT_CONVS + (size_t)((b - NBP) * 3 + j) * 3072 + oct * 8;
        const v4u w = *(const v4u*)xbc_ptr(T1, BC, row, oct * 8);
        *(f32x4*)o = (f32x4){bflo(w.x), bfhi(w.x), bflo(w.y), bfhi(w.y)}; *(f32x4*)(o + 4) = (f32x4){bflo(w.z), bfhi(w.z), bflo(w.w), bfhi(w.w)};
    }
}
__device__ __forceinline__ void ph_conv(const Ctx& C, const Params& P) {
    CTX_GT(); bf16* T1 = (bf16*)(W_SCR + S_T1); bf16* BC = (bf16*)(W_SCR + S_BC); const bf16* HB = (const bf16*)(W_SCR + S_HB);
    const float* cwp = P.in[I_CONVW]; const float* cbp = P.in[I_CONVB]; const float* cst = P.in[I_SCONV];
    { float* DT = (float*)(W_SCR + S_DT); const float* dtb = P.in[I_DTB];
      for (size_t i = gt; i < (size_t)M * 32; i += NGT) { const float x = DT[i] + dtb[i & 31]; DT[i] = x > 20.f ? x : log1pf(__expf(x)); } }
    for (size_t i = gt; i < (size_t)(NBP * 128 + NBS) * 384; i += NGT) {
        const int oct = (int)(i % 384), cc = (int)(i / 384), ch = oct * 8;
        float w0[8], w1[8], w2[8], cw[4][8], cb[8];
#pragma unroll
        for (int e = 0; e < 8; ++e) { cb[e] = cbp[ch + e];
#pragma unroll
            for (int j = 0; j < 4; ++j) cw[j][e] = cwp[j * 3072 + ch + e]; }
        size_t row0; int nrows;
        if (cc < NBP * 128) { const int c = cc & 127, b = cc >> 7; row0 = (size_t)b * SEQ + c * 64; nrows = 64;
            if (c == 0) {
#pragma unroll
                for (int e = 0; e < 8; ++e) { w0[e] = 0.f; w1[e] = 0.f; w2[e] = 0.f; }
            } else { const bf16* hb = HB + (size_t)cc * 3 * 3072 + ch; const v4u a = *(const v4u*)hb, b2 = *(const v4u*)(hb + 3072), c2 = *(const v4u*)(hb + 6144);
                w0[0] = bflo(a.x); w0[1] = bfhi(a.x); w0[2] = bflo(a.y); w0[3] = bfhi(a.y); w0[4] = bflo(a.z); w0[5] = bfhi(a.z); w0[6] = bflo(a.w); w0[7] = bfhi(a.w);
                w1[0] = bflo(b2.x); w1[1] = bfhi(b2.x); w1[2] = bflo(b2.y); w1[3] = bfhi(b2.y); w1[4] = bflo(b2.z); w1[5] = bfhi(b2.z); w1[6] = bflo(b2.w); w1[7] = bfhi(b2.w);
                w2[0] = bflo(c2.x); w2[1] = bfhi(c2.x); w2[2] = bflo(c2.y); w2[3] = bfhi(c2.y); w2[4] = bflo(c2.z); w2[5] = bfhi(c2.z); w2[6] = bflo(c2.w); w2[7] = bfhi(c2.w); }
        } else { const int b = cc - NBP * 128; row0 = (size_t)MP + b * TS; nrows = TS; const float* s = cst + (size_t)b * 3 * 3072 + ch;
#pragma unroll
            for (int e = 0; e < 8; ++e) { w0[e] = s[e]; w1[e] = s[3072 + e]; w2[e] = s[6144 + e]; } }
        bf16* p = (bf16*)xbc_ptr(T1, BC, row0, ch); const size_t pitch = ch < 2048 ? 4096 : 1024;
        for (int r0 = 0; r0 < nrows; r0 += 8) {
            v4u wr[8];
#pragma unroll
            for (int q = 0; q < 8; ++q) wr[q] = *(const v4u*)(p + (size_t)(r0 + q) * pitch);
#pragma unroll
            for (int q = 0; q < 8; ++q) { const v4u w = wr[q];
                const float cur[8] = {bflo(w.x), bfhi(w.x), bflo(w.y), bfhi(w.y), bflo(w.z), bfhi(w.z), bflo(w.w), bfhi(w.w)}; float o[8];
#pragma unroll
                for (int e = 0; e < 8; ++e) { o[e] = silu_f(cb[e] + cw[0][e] * w0[e] + cw[1][e] * w1[e] + cw[2][e] * w2[e] + cw[3][e] * cur[e]); w0[e] = w1[e]; w1[e] = w2[e]; w2[e] = cur[e]; }
                v4u qo; qo.x = pk2(o[0], o[1]); qo.y = pk2(o[2], o[3]); qo.z = pk2(o[4], o[5]); qo.w = pk2(o[6], o[7]);
                *(v4u*)(p + (size_t)(r0 + q) * pitch) = qo; }
        }
    }
}
__device__ __forceinline__ void ph_scan(const Ctx& C, const Params& P) {
    scan::Bufs B{(bf16*)(W_SCR + S_T1), (bf16*)(W_SCR + S_ZG), (bf16*)(W_SCR + S_QK), (bf16*)(W_SCR + S_BC), (const float*)(W_SCR + S_DT), (float*)(C.ws + O_SSQG), (float*)(C.ws + O_SSQH), P.in[I_ALOG], P.in[I_DSKIP]};
    float* out = C.out;
#pragma unroll 1
    for (int u = C.wg; u < 256 + 2048; u += C.G) {
        const bool pr = u < 256; const int v = pr ? u : u - 256, w = v & 255, bg = (v >> 8) * 16 + (w & 7) * 2 + (w >> 7), j = (w >> 3) & 15, b = bg >> 2, h = (bg & 3) * 8 + (j >> 1), sl = j & 1;
        const size_t so = (size_t)(b * 32 + h) * 128 * 64;
        scan::scan_unit<true>(C.lds, B, pr ? b * SEQ : MP + b * TS, pr ? SEQ / 64 : 1, pr ? 64 : TS, h, sl, pr ? nullptr : P.in[I_SSSD] + so, pr ? out + OUT_SSDP + so : out + OUT_SSDS + so, C.wave);
    }
#pragma unroll 1
    for (int u = C.wg; u < 256 + 2048; u += C.G) {
        const bool pr = u < 256; const int v = pr ? u : u - 256, w = v & 255, bh = (v >> 8) * 32 + (w & 7) * 4 + (w >> 6), b = bh >> 3, h = bh & 7, sl = (w >> 3) & 7;
        const size_t so = (size_t)(b * 8 + h) * 256 * 256;
        scan::scan_unit<false>(C.lds, B, pr ? b * SEQ : MP + b * TS, pr ? SEQ / 64 : 1, pr ? 64 : TS, h, sl, pr ? nullptr : P.in[I_SRET] + so, pr ? out + OUT_RETP + so : out + OUT_RETS + so, C.wave);
    }
}
__device__ __forceinline__ void ph_norm(const Ctx& C) {
    CTX_GW(); bf16* T1 = (bf16*)(W_SCR + S_T1); const bf16* ZG = (const bf16*)(W_SCR + S_ZG); const float* SSQG = (const float*)(C.ws + O_SSQG); const float* SSQH = (const float*)(C.ws + O_SSQH);
    const int lane = lane_id();
    for (int row = gw; row < M; row += NGW) {
        v4u w[8], gq[4]; float sc[8];
#pragma unroll
        for (int k = 0; k < 8; ++k) w[k] = *(const v4u*)(T1 + (size_t)row * 4096 + (k * 64 + lane) * 8);
#pragma unroll
        for (int k = 0; k < 4; ++k) gq[k] = *(const v4u*)(ZG + (size_t)row * 4096 + ((k + 4) * 64 + lane) * 8);
#pragma unroll
        for (int k = 0; k < 4; ++k) {
            const float* pg = SSQG + (size_t)row * 64 + k * 16; const f32x4 a0 = *(const f32x4*)pg, a1 = *(const f32x4*)(pg + 4), a2 = *(const f32x4*)(pg + 8), a3 = *(const f32x4*)(pg + 12);
            const f32x4 t = (a0 + a1) + (a2 + a3); sc[k] = rsqrtf(((t[0] + t[1]) + (t[2] + t[3])) * (1.0f / 512.f) + EPS);
            const float* ph = SSQH + (size_t)row * 64 + ((((k + 4) * 64 + lane) * 8 - 2048) >> 8) * 8; const f32x4 b0 = *(const f32x4*)ph, b1 = *(const f32x4*)(ph + 4);
            const f32x4 u = b0 + b1; sc[k + 4] = rsqrtf(((u[0] + u[1]) + (u[2] + u[3])) * (1.0f / 256.f) + EPS); }
#pragma unroll
        for (int k = 0; k < 8; ++k) {
            float x[8] = {bflo(w[k].x), bfhi(w[k].x), bflo(w[k].y), bfhi(w[k].y), bflo(w[k].z), bfhi(w[k].z), bflo(w[k].w), bfhi(w[k].w)};
            if (k < 4) {
#pragma unroll
                for (int i = 0; i < 8; ++i) x[i] *= sc[k];
            } else { const v4u q = gq[k - 4]; const float gv[8] = {bflo(q.x), bfhi(q.x), bflo(q.y), bfhi(q.y), bflo(q.z), bfhi(q.z), bflo(q.w), bfhi(q.w)};
#pragma unroll
                for (int i = 0; i < 8; ++i) x[i] = x[i] * sc[k] * silu_f(gv[i]); }
            v4u o; o.x = pk2(x[0], x[1]); o.y = pk2(x[2], x[3]); o.z = pk2(x[4], x[5]); o.w = pk2(x[6], x[7]);
            *(v4u*)(T1 + (size_t)row * 4096 + (k * 64 + lane) * 8) = o;
        }
    }
}
__device__ __forceinline__ void ph_wout(const Ctx& C) { res_gemm<16, false>(C, (const bf16*)(W_SCR + S_T1), 4096, (const bf16*)(C.ws + O_WOUT), 4096, nullptr, 1.0f, W_SSQ + (size_t)2 * M, (float*)(W_SCR + S_ZG)); }
__device__ __forceinline__ void ph_woutfin(const Ctx& C) { ph_fin<false>(C, (const float*)(W_SCR + S_ZG), 16, nullptr, 1.0f, W_SSQ + (size_t)2 * M); }
constexpr float MLA_SC = 0.07216878364870322f, MEM_SC = 0.08838834764831845f, LOG2E = 1.4426950408889634f;
__device__ __forceinline__ void ph_cwin(const Ctx& C, const Params& P) {
    CTX_GT();
    cvt_bulk(P.in[I_CCKV], (bf16*)(W_SCR + S_CKVPAST), (size_t)65536 * 512 / 8, gt, NGT);
    cvt_bulk(P.in[I_CKPE], (bf16*)(W_SCR + S_KPEPAST), (size_t)65536 * 64 / 8, gt, NGT);
    pg8::Gemm g{W_XB, (const bf16*)(C.ws + O_CWIN), M, CWIN_N, D, XBP, D}; pg8::StaticOrder S = make_order(M, CWIN_N, C.G, C.wg, 0);
    EpiF32 E{(float*)(W_SCR + S_CIN), CWIN_N, W_SSQ + (size_t)5 * M};
    pg8::gemm_phase<EpiF32, pg8::StaticOrder, true, true>(C.lds, g, S, E, C.wave);
}
__device__ __forceinline__ void ph_nr(const Ctx& C, const Params& P) {
    CTX_GW(); const int lane = lane_id(); float* out = C.out;
    const float* CIN = (const float*)(W_SCR + S_CIN); bf16* CQN = (bf16*)(W_SCR + S_CQN); bf16* CKVB = (bf16*)(W_SCR + S_CKVB); bf16* KPEB = (bf16*)(W_SCR + S_KPEB);
    const float* COSM = (const float*)(C.ws + O_COSM); const float* SINM = (const float*)(C.ws + O_SINM);
    const float* qn = P.in[I_QNORM]; const float* kvn = P.in[I_KVNORM];
    for (int row = gw; row < M; row += NGW) {
        const float* ci = CIN + (size_t)row * CWIN_N;
        const f32x4 q0 = *(const f32x4*)(ci + lane * 8), q1 = *(const f32x4*)(ci + lane * 8 + 4);
        const f32x4 k0 = *(const f32x4*)(ci + 512 + lane * 8), k1 = *(const f32x4*)(ci + 512 + lane * 8 + 4);
        float sq = (q0[0] * q0[0] + q0[1] * q0[1]) + (q0[2] * q0[2] + q0[3] * q0[3]) + (q1[0] * q1[0] + q1[1] * q1[1]) + (q1[2] * q1[2] + q1[3] * q1[3]);
        float sk = (k0[0] * k0[0] + k0[1] * k0[1]) + (k0[2] * k0[2] + k0[3] * k0[3]) + (k1[0] * k1[0] + k1[1] * k1[1]) + (k1[2] * k1[2] + k1[3] * k1[3]);
        sq = wave_sum(sq); sk = wave_sum(sk);
        const float rq = rsqrtf(sq * (1.0f / 512.f) + EPS), rk = rsqrtf(sk * (1.0f / 512.f) + EPS);
        const f32x4 g0 = *(const f32x4*)(qn + lane * 8), g1 = *(const f32x4*)(qn + lane * 8 + 4), n0 = *(const f32x4*)(kvn + lane * 8), n1 = *(const f32x4*)(kvn + lane * 8 + 4);
        const f32x4 a0 = q0 * rq * g0, a1 = q1 * rq * g1, c0 = k0 * rk * n0, c1 = k1 * rk * n1;
        v4u w; w.x = pk2(a0[0], a0[1]); w.y = pk2(a0[2], a0[3]); w.z = pk2(a1[0], a1[1]); w.w = pk2(a1[2], a1[3]);
        *(v4u*)(CQN + (size_t)row * 512 + lane * 8) = w;
        v4u z; z.x = pk2(c0[0], c0[1]); z.y = pk2(c0[2], c0[3]); z.z = pk2(c1[0], c1[1]); z.w = pk2(c1[2], c1[3]);
        *(v4u*)(CKVB + (size_t)row * 512 + lane * 8) = z;
        float* co = row < MP ? out + OUT_CKVP + (size_t)row * 512 : out + OUT_CKVS + (size_t)(row - MP) * 512;
        *(f32x4*)(co + lane * 8) = c0; *(f32x4*)(co + lane * 8 + 4) = c1;
        if (lane < 32) {
            const int pos = pos_of_row(row); const float x1 = ci[1024 + lane], x2 = ci[1024 + 32 + lane];
            const float cv = COSM[(size_t)pos * 32 + lane], sv = SINM[(size_t)pos * 32 + lane];
            const float y1 = x1 * cv - x2 * sv, y2 = x2 * cv + x1 * sv;
            float* ko = row < MP ? out + OUT_KPEP + (size_t)row * 64 : out + OUT_KPES + (size_t)(row - MP) * 64;
            ko[lane] = y1; ko[32 + lane] = y2;
            KPEB[(size_t)row * 64 + lane] = (bf16)f2bf(y1); KPEB[(size_t)row * 64 + 32 + lane] = (bf16)f2bf(y2);
        }
    }
}
__device__ __forceinline__ void ph_uq(const Ctx& C) {
    bf16* CKVB = (bf16*)(W_SCR + S_CKVB);
    { pg8::Gemm g{(const bf16*)(W_SCR + S_CQN), (const bf16*)(C.ws + O_WUQ), M, 3072, 512, 512, 512}; pg8::StaticOrder S = make_order(M, 3072, C.G, C.wg, 0);
      EpiUq E{(bf16*)(W_SCR + S_QN), (bf16*)(W_SCR + S_QR), (const float*)(C.ws + O_COSM), (const float*)(C.ws + O_SINM)};
      pg8::gemm_phase<EpiUq, pg8::StaticOrder, true, true>(C.lds, g, S, E, C.wave); }
    { pg8::Gemm g{CKVB, (const bf16*)(C.ws + O_WKV), MP, 4096, 512, 512, 512}; pg8::StaticOrder S = make_order(MP, 4096, C.G, C.wg, (130 * 12) % 256);
      EpiPlain E{(bf16*)(W_SCR + S_KNV), 4096, nullptr};
      pg8::gemm_phase<EpiPlain, pg8::StaticOrder, true, true>(C.lds, g, S, E, C.wave); }
    { pg8::Gemm g{CKVB + (size_t)MP * 512, (const bf16*)(C.ws + O_WKV), MS, 4096, 512, 512, 512}; pg8::StaticOrder S = make_order(MS, 4096, C.G, C.wg, (130 * 12) % 256);
      EpiPlain E{(bf16*)(W_SCR + S_KNVN), 4096, nullptr};
      pg8::gemm_phase<EpiPlain, pg8::StaticOrder, true, true>(C.lds, g, S, E, C.wave); }
}
__device__ __forceinline__ void ph_attp(const Ctx& C) {
    const int wid = C.wave, r32 = lane_id() & 31, G = C.G, wg = C.wg;
    const bf16* KNV = (const bf16*)(W_SCR + S_KNV); const bf16* KPEB = (const bf16*)(W_SCR + S_KPEB); const bf16* QN = (const bf16*)(W_SCR + S_QN); const bf16* QR = (const bf16*)(W_SCR + S_QR);
    bf16* OB = (bf16*)(W_SCR + S_OB);
    const int nun = (G == 256) ? 8 : (2048 + G - 1) / G;
#pragma unroll 1
    for (int i = 0; i < nun; ++i) {
        int pr, qb;
        if (G == 256) { const int k4 = (wg >> 3) & 3; pr = (wg & 7) + 8 * (wg >> 5); qb = 4 * i + ((i & 1) ? 3 - k4 : k4); }
        else { const int u = wg + i * G; if (u >= 2048) break; pr = u >> 5; qb = u & 31; }
        const int b = pr >> 4, h = pr & 15;
        const int row = b * SEQ + qb * 256 + wid * 32 + r32;
        const bf16* kbase = KNV + (size_t)(b * SEQ) * 4096 + h * 128; const bf16* rbase = KPEB + (size_t)(b * SEQ) * 64;
        auto kn = [=](int k) -> const bf16* { return kbase + (size_t)k * 4096; };
        auto vv = [=](int k) -> const bf16* { return kbase + (size_t)k * 4096 + 2048; };
        auto kr = [=](int k) -> const bf16* { return rbase + (size_t)k * 64; };
        const int kmax = (qb * 4 + (wid >> 1) + 1) * 64;
        att::attn_unit<64, false, false>(C.lds, QN + (size_t)row * D + h * 128, QR + (size_t)row * 1024 + h * 64, kn, kr, vv, 4 * (qb + 1), kmax, MLA_SC * LOG2E, 8.0f / MLA_SC,
                           OB + (size_t)(b * SEQ + qb * 256 + wid * 32) * D + h * 128, D, 32, true, C.wave);
    }
}
__device__ __forceinline__ void ph_exp(const Ctx& C, int hb) {
    pg8::Gemm g{(const bf16*)(W_SCR + S_CKVPAST) + (size_t)hb * 32768 * 512, (const bf16*)(C.ws + O_WKV), 32768, 4096, 512, 512, 512}; pg8::StaticOrder S = make_order(32768, 4096, C.G, C.wg, 0);
    EpiPlain E{(bf16*)(W_SCR + S_KNV), 4096, nullptr};
    pg8::gemm_phase<EpiPlain, pg8::StaticOrder, true, true>(C.lds, g, S, E, C.wave);
}
__device__ __forceinline__ void ph_atts(const Ctx& C, int hb) {
    const int wid = C.wave, r32 = lane_id() & 31;
    const bf16* KNV = (const bf16*)(W_SCR + S_KNV); const bf16* KNVN = (const bf16*)(W_SCR + S_KNVN); const bf16* KPEB = (const bf16*)(W_SCR + S_KPEB); const bf16* KPEPAST = (const bf16*)(W_SCR + S_KPEPAST);
    const bf16* QN = (const bf16*)(W_SCR + S_QN); const bf16* QR = (const bf16*)(W_SCR + S_QR); bf16* OB = (bf16*)(W_SCR + S_OB);
#pragma unroll 1
    for (int u = C.wg; u < 256; u += C.G) {
        const int bl = u >> 4, h = u & 15, b = hb * 16 + bl;
        const int row = MP + b * TS + (r32 & 15);
        const bf16* pbase = KNV + (size_t)(bl * PAST) * 4096 + h * 128; const bf16* nbase = KNVN + (size_t)(b * TS) * 4096 + h * 128;
        const bf16* rpast = KPEPAST + (size_t)(b * PAST) * 64; const bf16* rnew = KPEB + (size_t)(MP + b * TS) * 64;
        auto kn = [=](int k) -> const bf16* { return k < PAST ? pbase + (size_t)k * 4096 : (k < PAST + TS ? nbase + (size_t)(k - PAST) * 4096 : nullptr); };
        auto vv = [=](int k) -> const bf16* { return k < PAST ? pbase + (size_t)k * 4096 + 2048 : (k < PAST + TS ? nbase + (size_t)(k - PAST) * 4096 + 2048 : nullptr); };
        auto kr = [=](int k) -> const bf16* { return k < PAST ? rpast + (size_t)k * 64 : (k < PAST + TS ? rnew + (size_t)(k - PAST) * 64 : nullptr); };
        att::attn_unit<64, false, true>(C.lds, QN + (size_t)row * D + h * 128, QR + (size_t)row * 1024 + h * 64, kn, kr, vv, 33, PAST + TS, MLA_SC * LOG2E, 8.0f / MLA_SC,
                           OB + (size_t)(MP + b * TS) * D + h * 128, D, 16, wid == 0, C.wave);
    }
}
__device__ __forceinline__ void ph_cwout(const Ctx& C) { res_gemm<8, false>(C, (const bf16*)(W_SCR + S_OB), D, (const bf16*)(C.ws + O_CWOUT), D, nullptr, 1.0f, W_SSQ + (size_t)6 * M, (float*)(W_SCR + S_KNV)); }
__device__ __forceinline__ void ph_cwoutfin(const Ctx& C) { ph_fin<false>(C, (const float*)(W_SCR + S_KNV), 8, nullptr, 1.0f, W_SSQ + (size_t)6 * M); }
__device__ __forceinline__ void ph_mq(const Ctx& C, const Params& P, int L) {
    CTX_GT();
    cvt_bulk(P.in[I_CMK] + (size_t)L * 32 * 256 * 512, (bf16*)(W_SCR + S_CMK), (size_t)32 * 256 * 512 / 8, gt, NGT);
    cvt_bulk(P.in[I_CMV] + (size_t)L * 32 * 256 * 512, (bf16*)(W_SCR + S_CMV), (size_t)32 * 256 * 512 / 8, gt, NGT);
    { pg8::Gemm g{W_XB, (const bf16*)(C.ws + O_WMQ) + (size_t)L * 512 * D, MP, 512, D, XBP, D}; pg8::StaticOrder S = make_order(MP, 512, C.G, C.wg, 0);
      EpiPlain E{(bf16*)(W_SCR + S_QM), 512, W_SSQ + (size_t)(L * 4 + 2) * M};
      pg8::gemm_phase<EpiPlain, pg8::StaticOrder, true, true>(C.lds, g, S, E, C.wave); }
    { pg8::Gemm g{W_XB + (size_t)MP * XBP, (const bf16*)(C.ws + O_WMQ) + (size_t)L * 512 * D, MS, 512, D, XBP, D / 8}; SplitOrder S; S.init(MS, 512, 8, C.G, C.wg);
      EpiPart E{(float*)(W_SCR + S_PARTQ), 512, (size_t)MS * 512};
      pg8::gemm_phase<EpiPart, SplitOrder, true, true>(C.lds, g, S, E, C.wave); }
}
__device__ __forceinline__ void ph_matt(const Ctx& C, int L) {
    const int wid = C.wave, r32 = lane_id() & 31;
    const bf16* QM = (const bf16*)(W_SCR + S_QM); bf16* OM = (bf16*)(W_SCR + S_OM); const bf16* CMK = (const bf16*)(W_SCR + S_CMK); const bf16* CMV = (const bf16*)(W_SCR + S_CMV);
    const bf16* MKV = (const bf16*)(C.ws + O_MKV);
    auto kr0 = [=](int) -> const bf16* { return nullptr; };
#pragma unroll 1
    for (int u = C.wg; u < 512 + 128; u += C.G) {
        const bool pr = u < 512; const int v = pr ? u : u - 512;
        const int b = pr ? v >> 7 : v >> 2, h = pr ? (v >> 5) & 3 : v & 3, qb = v & 31;
        const int row = pr ? b * SEQ + qb * 256 + wid * 32 + r32 : MP + b * TS + (r32 & 15);
        const bf16* kb_ = pr ? MKV + (size_t)(L * 1024 + b * 256) * 1024 + h * 128 : CMK + (size_t)(b * 256) * 512 + h * 128;
        const bf16* vb_ = pr ? kb_ + 512 : CMV + (size_t)(b * 256) * 512 + h * 128;
        const int kp = pr ? 1024 : 512;
        auto kn = [=](int k) -> const bf16* { return kb_ + (size_t)k * kp; };
        auto vv = [=](int k) -> const bf16* { return vb_ + (size_t)k * kp; };
        if (!pr) {
            const int t = wid * 64 + lane_id(), r = t >> 5, c4 = (t & 31) * 4; const size_t o = (size_t)(b * TS + r) * 512 + h * 128 + c4;
            const float* pq = (const float*)(W_SCR + S_PARTQ); f32x4 a = *(const f32x4*)(pq + o);
#pragma unroll
            for (int k = 1; k < 8; ++k) a += *(const f32x4*)(pq + (size_t)k * MS * 512 + o);
            const float rs = rsqrtf(ssq_get(W_SSQ + (size_t)(L * 4 + 2) * M + MP + b * TS + r) * (1.0f / D) + EPS);
            v2u w; w.x = pk2(a[0] * rs, a[1] * rs); w.y = pk2(a[2] * rs, a[3] * rs);
            *(v2u*)((bf16*)(W_SCR + S_QM) + (size_t)MP * 512 + o) = w;
            VM_WAIT(); __syncthreads();
        }
        att::attn_unit<0, false, false>(C.lds, QM + (size_t)row * 512 + h * 128, nullptr, kn, kr0, vv, 4, 256, MEM_SC * LOG2E, 8.0f / MEM_SC,
                          OM + (size_t)(pr ? b * SEQ + qb * 256 + wid * 32 : MP + b * TS) * 512 + h * 128, 512, pr ? 32 : 16, pr ? true : wid == 0, C.wave);
    }
}
__device__ __forceinline__ void ph_mo(const Ctx& C, int L) {
    pg8::Gemm g{(const bf16*)(W_SCR + S_OM), (const bf16*)(C.ws + O_WMO) + (size_t)L * D * 512, M, D, 512, 512, 512}; pg8::StaticOrder S = make_order(M, D, C.G, C.wg, 0);
    EpiRes<false> E{nullptr, W_XB, W_SSQ + (size_t)(L * 4 + 3) * M, 1.0f};
    pg8::gemm_phase<EpiRes<false>, pg8::StaticOrder, true, true>(C.lds, g, S, E, C.wave);
}
__device__ __forceinline__ void ph_final(const Ctx& C, const Params& P) {
    CTX_GW(); const int lane = lane_id(); float* Y = W_X; const bf16* XB = W_XB;
    const float* fn = P.in[I_FNORM]; const u64* sq = W_SSQ + (size_t)8 * M;
    for (int row = gw; row < M; row += NGW) {
        const float rs = rsqrtf(ssq_get(sq + row) * (1.0f / D) + EPS); float* yr = Y + (size_t)row * D; const bf16* xr = XB + (size_t)row * XBP;
        v4u q[4];
#pragma unroll
        for (int j = 0; j < 4; ++j) q[j] = *(const v4u*)(xr + 8 * (lane + 64 * j));
#pragma unroll
        for (int j = 0; j < 4; ++j) { const int c = 8 * (lane + 64 * j); const f32x4 g0 = *(const f32x4*)(fn + c), g1 = *(const f32x4*)(fn + c + 4);
            __builtin_nontemporal_store((f32x4){bflo(q[j].x), bfhi(q[j].x), bflo(q[j].y), bfhi(q[j].y)} * rs * g0, (f32x4*)(yr + c)); __builtin_nontemporal_store((f32x4){bflo(q[j].z), bfhi(q[j].z), bflo(q[j].w), bfhi(q[j].w)} * rs * g1, (f32x4*)(yr + c + 4)); }
    }
}

__global__ void __launch_bounds__(NWAVES * 64, 2) mk_fwd(Params P) {
    extern __shared__ __attribute__((aligned(16))) unsigned char lds_raw[];
    Ctx C; C.lds = (LAS unsigned char*)lds_raw; C.ws = P.ws; C.out = P.out; C.G = gridDim.x; C.wg = blockIdx.x; C.wave = __builtin_amdgcn_readfirstlane((int)threadIdx.x >> 6);
    volatile LAS unsigned* MISC = (volatile LAS unsigned*)(C.lds + MISC_OFF);
    for (int u = C.wave * 64 + lane_id(); u < (LDS_BYTES - MISC_OFF) / 4; u += NWAVES * 64) ((LAS unsigned*)(C.lds + MISC_OFF))[u] = 0u;
    __syncthreads();
    XcdBarrier bar = xcd_barrier_post((unsigned*)(P.ws + O_CTL) + 4096, MISC + 8, C.wave); bar.t0 = (C.wave == 0);
    const int lo = P.ph_lo, hi_ph = P.ph_hi;
#define RUN(k, call) do { if (lo <= (k) && (k) < hi_ph) { if ((k) > lo) xcd_barrier(bar); call; } } while (0)
    RUN(0, ph_prologue(C, P));
    RUN(1, ph_w1(C, 0));    RUN(2, ph_w2<true>(C, P, 0));    RUN(3, ph_w2fin<true>(C, P, 0));
    RUN(4, ph_win(C, P));   RUN(5, ph_halo(C));        RUN(6, ph_conv(C, P));     RUN(7, ph_scan(C, P));   RUN(8, ph_norm(C));   RUN(9, ph_wout(C));   RUN(10, ph_woutfin(C));
    RUN(11, ph_mq(C, P, 0));   RUN(12, ph_matt(C, 0));   RUN(13, ph_mo(C, 0));
    RUN(14, ph_w1(C, 1));   RUN(15, ph_w2<false>(C, P, 1));   RUN(16, ph_w2fin<false>(C, P, 1));
    RUN(17, ph_w1(C, 2));   RUN(18, ph_w2<false>(C, P, 2));   RUN(19, ph_w2fin<false>(C, P, 2));
    RUN(20, ph_cwin(C, P));   RUN(21, ph_nr(C, P));   RUN(22, ph_uq(C));   RUN(23, ph_attp(C));
    RUN(24, ph_exp(C, 0));   RUN(25, ph_atts(C, 0));   RUN(26, ph_exp(C, 1));   RUN(27, ph_atts(C, 1));   RUN(28, ph_cwout(C));   RUN(29, ph_cwoutfin(C));
    RUN(30, ph_mq(C, P, 1));   RUN(31, ph_matt(C, 1));   RUN(32, ph_mo(C, 1));
    RUN(33, ph_w1(C, 3));   RUN(34, ph_w2<false>(C, P, 3));   RUN(35, ph_w2fin<false>(C, P, 3));
    RUN(36, ph_final(C, P));
#undef RUN
}
extern "C" void kernel_launch(void* const* d_in, const int* in_sizes, int n_in, void* d_out, int out_size, void* d_ws, size_t ws_size, hipStream_t stream) {
    static int grid = 0;
    if (grid == 0) {
        if (n_in != N_IN || (size_t)out_size != OUT_END || ws_size < WS_NEED) {
            fprintf(stderr, "kernel_launch: unexpected shapes: n_in %d out %d ws %zu (need %zu)\n", n_in, out_size, ws_size, (size_t)WS_NEED); grid = -1; return; }
        int dev = 0, cus = 0;
        if (hipGetDevice(&dev) != hipSuccess || hipDeviceGetAttribute(&cus, hipDeviceAttributeMultiprocessorCount, dev) != hipSuccess) { grid = -1; return; }
        if (hipFuncSetAttribute((const void*)mk_fwd, hipFuncAttributeMaxDynamicSharedMemorySize, LDS_BYTES) != hipSuccess) { fprintf(stderr, "kernel_launch: hipFuncSetAttribute failed\n"); grid = -1; return; }
        int per_cu = 0;
        if (hipOccupancyMaxActiveBlocksPerMultiprocessor(&per_cu, (const void*)mk_fwd, NWAVES * 64, LDS_BYTES) != hipSuccess || per_cu < 1) { fprintf(stderr, "kernel_launch: occupancy query says %d\n", per_cu); }
        (void)hipGetLastError();
        grid = cus;
    }
    if (grid < 0) return;
    (void)hipMemsetAsync((char*)d_ws, 0, O_ZEND, stream);
    Params p{};
    for (int i = 0; i < N_IN; ++i) p.in[i] = (const float*)d_in[i];
    p.out = (float*)d_out; p.ws = (unsigned char*)d_ws;
#ifndef MK_PER_PHASE
    p.ph_lo = 0; p.ph_hi = N_PHASES;
    hipLaunchKernelGGL(mk_fwd, dim3(grid), dim3(NWAVES * 64), LDS_BYTES, stream, p);
#else
    for (int k = 0; k < N_PHASES; ++k) { p.ph_lo = k; p.ph_hi = k + 1; hipLaunchKernelGGL(mk_fwd, dim3(grid), dim3(NWAVES * 64), LDS_BYTES, stream, p); }
#endif
}
```

```cpp
#include <hip/hip_runtime.h>
#include <cstdio>
#include <cstdint>
__device__ __forceinline__ int lane_id() { int l; asm volatile("v_mbcnt_lo_u32_b32 %0, -1, 0\n\tv_mbcnt_hi_u32_b32 %0, -1, %0" : "=v"(l)); return l; }
namespace pg8 {
#define PG8_LAS __attribute__((address_space(3)))
typedef unsigned short bf16_t;
typedef short bf16x8 __attribute__((ext_vector_type(8)));
typedef float f32x4 __attribute__((ext_vector_type(4)));
typedef unsigned u32x4 __attribute__((ext_vector_type(4)));
constexpr int BM = 256, BK = 64, HALF = 128, HTB = HALF * BK * 2  , STAGE_BYTES = 8 * HTB, NXCD = 8, WGM = 4;

__host__ __device__ __forceinline__ int lds_byte(int r, int c) { const int st = (r >> 4) * 2 + (c >> 5), rr = r & 15, cc = c & 31, ob = rr * 64 + cc * 2; return st * 1024 + (ob ^ (((ob >> 9) & 1) << 5)); }
__host__ __device__ __forceinline__ void stage_rc(int b, int& R, int& C) { const int st = b / 1024, sb = b % 1024, swz = sb ^ (((sb >> 9) & 1) << 5); R = (st >> 1) * 16 + swz / 64; C = (st & 1) * 32 + (swz % 64) / 2; }
__host__ __device__ __forceinline__ int perm32(int rho) { const int n = rho >> 4, i = rho & 15; return 8 * (i >> 2) + 4 * n + (i & 3); }

struct Unit { int pm, pn, kp, par; };
struct Gemm { const bf16_t* A; const bf16_t* Bt; int M, N, K, lda, kloop; };

struct StaticOrder {
    int nM, nN, nwg, G, c;
    __host__ __device__ void init(int M, int N, int G_, int c_) { nM = M / BM; nN = N / BM; nwg = nM * nN; G = G_; c = c_; }
    __host__ __device__ bool next(int i, Unit& u) const {
        const long L = (long)i * G + c; if (L >= nwg) return false;
        int wgid = (int)L; { const int q = nwg / NXCD, r = nwg % NXCD, xcd = wgid % NXCD, off = wgid / NXCD; wgid = (xcd < r ? xcd * (q + 1) : r * (q + 1) + (xcd - r) * q) + off; }
        const int nig = WGM * nN, gid = wgid / nig, fm = gid * WGM, gsz = (nM - fm) < WGM ? (nM - fm) : WGM;
        u.pm = fm + ((wgid % nig) % gsz); u.pn = (wgid % nig) / gsz; u.kp = 0; return true;
    }
    __device__ __forceinline__ void a_ready(const Unit&) const {}
    __device__ __forceinline__ void done(const Unit&) const {}
};
__device__ __forceinline__ unsigned cvt_pk_bf16(float lo, float hi) { unsigned r; asm volatile("v_cvt_pk_bf16_f32 %0, %1, %2" : "=v"(r) : "v"(lo), "v"(hi)); return r; }
template <class Epi, class Sched, bool ALIGN_EPI = false, bool SP2 = false>
__device__ __forceinline__ void gemm_phase(PG8_LAS unsigned char* lds, const Gemm g, const Sched& S, const Epi& E, int wave_id) {
    const int wid = wave_id, lane = lane_id(), tid = wid * 64 + lane, wr = wid >> 2, wc = wid & 3, fr = lane & 15, fq = lane >> 4;
    const int K = g.K, nt = g.kloop / BK; const size_t kpart = (size_t)g.kloop * 2;
    unsigned voffA[2], voffB[2];
#pragma unroll
    for (int i = 0; i < 2; ++i) { int R, C; stage_rc(tid * 16 + i * 8192, R, C); const int Rb = Epi::PERM ? (Epi::ADJ ? ((R >> 5) * 64 + perm32(R & 31)) : ((R & ~31) + perm32(R & 31))) : R;
        voffA[i] = (unsigned)(R * g.lda + C) * 2u; voffB[i] = (unsigned)(Rb * K + C) * 2u; }
    const size_t kstep = (size_t)(BK * 2);
    const size_t hstep = (size_t)HALF * K * 2;
    const size_t tstep = 2 * hstep;
    const size_t hstepB = Epi::ADJ ? (size_t)32 * K * 2 : hstep;
    const size_t hstepA = (size_t)HALF * g.lda * 2, tstepA = 2 * hstepA;
    const unsigned ldsw = (unsigned)wid * 1024u;
    const int aoff = lds_byte(wr * 64 + fr, fq * 8), boff = lds_byte(wc * 32 + fr, fq * 8);
#define PG8_SA(b, h) (((b) * 2 + (h)) * HTB)
#define PG8_SB(b, h) ((4 + (b) * 2 + (h)) * HTB)
#define PG8_STAGE(bufoff, gbase, voff) do { _Pragma("unroll") for (int _i = 0; _i < 2; ++_i) \
        __builtin_amdgcn_global_load_lds((const unsigned*)((const char*)(gbase) + (voff)[_i]), (PG8_LAS unsigned*)(lds + (bufoff) + ldsw + _i * 8192), 16, 0, 0); } while (0)
#define PG8_LDA(dst, b, h) do { _Pragma("unroll") for (int m = 0; m < 4; ++m) _Pragma("unroll") for (int k = 0; k < 2; ++k) dst[m][k] = *(const PG8_LAS bf16x8*)(lds + PG8_SA(b, h) + aoff + m * 2048 + k * 1024); } while (0)
#define PG8_LDB(dst, b, h) do { _Pragma("unroll") for (int n = 0; n < 2; ++n) _Pragma("unroll") for (int k = 0; k < 2; ++k) dst[n][k] = *(const PG8_LAS bf16x8*)(lds + PG8_SB(b, h) + boff + n * 2048 + k * 1024); } while (0)
#define PG8_MMA(ai, bj, At, Bt) do { __builtin_amdgcn_s_setprio(1); _Pragma("unroll") for (int m = 0; m < 4; ++m) _Pragma("unroll") for (int n = 0; n < 2; ++n) _Pragma("unroll") for (int k = 0; k < 2; ++k) \
        acc[ai][bj][m][n] = __builtin_amdgcn_mfma_f32_16x16x32_bf16(Bt[n][k], At[m][k], acc[ai][bj][m][n], 0, 0, 0); __builtin_amdgcn_s_setprio(0); } while (0)
#define PG8_WAIT_V(n) asm volatile("s_waitcnt vmcnt(" #n ")" ::: "memory")
#define PG8_WAIT_L(n) asm volatile("s_waitcnt lgkmcnt(" #n ")" ::: "memory")
#define PG8_BAR __builtin_amdgcn_s_barrier()
#define PG8_SCHED __builtin_amdgcn_sched_barrier(0)
    Unit cur, nxt; int ui = 0;
    if (!S.next(0, cur)) return;
    f32x4 acc[2][2][4][2];
#pragma unroll
    for (int a = 0; a < 2; ++a)
#pragma unroll
        for (int b = 0; b < 2; ++b)
#pragma unroll
            for (int m = 0; m < 4; ++m)
#pragma unroll
                for (int n = 0; n < 2; ++n) acc[a][b][m][n] = (f32x4){0.f, 0.f, 0.f, 0.f};
    bf16x8 At[4][2], B0[2][2], B1[2][2];
    const char* cA = (const char*)g.A + (size_t)cur.pm * tstepA + (size_t)cur.kp * kpart; const char* cB = (const char*)g.Bt + (size_t)cur.pn * tstep + (size_t)cur.kp * kpart;
    S.a_ready(cur);
    if constexpr (SP2) {
        PG8_STAGE(PG8_SB(0, 0), cB, voffB); PG8_STAGE(PG8_SB(0, 1), cB + hstepB, voffB); PG8_STAGE(PG8_SA(0, 0), cA, voffA); PG8_STAGE(PG8_SA(0, 1), cA + hstepA, voffA);
        if (wr == 1) PG8_BAR;
        PG8_WAIT_V(2); PG8_BAR;
        PG8_STAGE(PG8_SB(1, 0), cB + kstep, voffB); PG8_STAGE(PG8_SA(1, 0), cA + kstep, voffA); PG8_STAGE(PG8_SB(1, 1), cB + hstepB + kstep, voffB);
        PG8_WAIT_V(6); PG8_BAR;
    } else {
        PG8_STAGE(PG8_SB(0, 0), cB, voffB); PG8_STAGE(PG8_SA(0, 0), cA, voffA); PG8_STAGE(PG8_SB(0, 1), cB + hstepB, voffB); PG8_STAGE(PG8_SA(0, 1), cA + hstepA, voffA);
        if (wr == 1) PG8_BAR;
        PG8_WAIT_V(4); PG8_BAR;
        PG8_STAGE(PG8_SB(1, 0), cB + kstep, voffB); PG8_STAGE(PG8_SA(1, 0), cA + kstep, voffA); PG8_STAGE(PG8_SB(1, 1), cB + hstepB + kstep, voffB);
        PG8_WAIT_V(6); PG8_BAR;
    }
    for (;;) {
        const bool has_next = S.next(ui + 1, nxt);
        if constexpr (Epi::SSQ_LDS)
            __builtin_amdgcn_global_load_lds((const unsigned*)(E.ssq + (size_t)cur.pm * 256) + tid, (PG8_LAS unsigned*)(lds + STAGE_BYTES + (ui & 1) * 2048 + wid * 256), 4, 0, 0);
        const char* nA = has_next ? (const char*)g.A + (size_t)nxt.pm * tstepA + (size_t)nxt.kp * kpart : cA; const char* nB = has_next ? (const char*)g.Bt + (size_t)nxt.pn * tstep + (size_t)nxt.kp * kpart : cB;
        for (int t = 0; t < nt; t += 2) {
            const bool last = (t == nt - 2);
            const char* a1 = cA + (size_t)(t + 1) * kstep;
            const char* a2 = last ? nA : cA + (size_t)(t + 2) * kstep; const char* b2 = last ? nB : cB + (size_t)(t + 2) * kstep;
            const char* a3 = a2 + kstep; const char* b3 = b2 + kstep;
            if (last && has_next) S.a_ready(nxt);
            if constexpr (SP2) {
            PG8_LDB(B0, 0, 0); PG8_LDB(B1, 0, 1); PG8_SCHED; PG8_LDA(At, 0, 0); PG8_STAGE(PG8_SA(1, 1), a1 + hstepA, voffA);
            PG8_WAIT_V(8); PG8_WAIT_L(0); PG8_BAR; PG8_MMA(0, 0, At, B0); PG8_MMA(0, 1, At, B1); PG8_BAR; PG8_SCHED;
            PG8_LDA(At, 0, 1); PG8_STAGE(PG8_SB(0, 0), b2, voffB); PG8_STAGE(PG8_SB(0, 1), b2 + hstepB, voffB); PG8_STAGE(PG8_SA(0, 0), a2, voffA);
            PG8_WAIT_V(8); PG8_WAIT_L(0); PG8_BAR; PG8_MMA(1, 0, At, B0); PG8_MMA(1, 1, At, B1); PG8_BAR; PG8_SCHED;
            PG8_LDB(B0, 1, 0); PG8_LDB(B1, 1, 1); PG8_SCHED; PG8_LDA(At, 1, 0); PG8_STAGE(PG8_SA(0, 1), a2 + hstepA, voffA);
            PG8_WAIT_V(8); PG8_WAIT_L(0); PG8_BAR; PG8_MMA(0, 0, At, B0); PG8_MMA(0, 1, At, B1); PG8_BAR; PG8_SCHED;
            PG8_LDA(At, 1, 1); PG8_STAGE(PG8_SB(1, 0), b3, voffB); PG8_STAGE(PG8_SB(1, 1), b3 + hstepB, voffB); PG8_STAGE(PG8_SA(1, 0), a3, voffA);
            PG8_WAIT_V(8); PG8_WAIT_L(0); PG8_BAR; PG8_MMA(1, 0, At, B0); PG8_MMA(1, 1, At, B1); PG8_BAR; PG8_SCHED;
            } else {
            PG8_LDB(B0, 0, 0); PG8_SCHED; PG8_LDA(At, 0, 0); PG8_STAGE(PG8_SA(1, 1), a1 + hstepA, voffA);
            PG8_WAIT_L(8); PG8_BAR; PG8_WAIT_L(0); PG8_MMA(0, 0, At, B0); PG8_BAR; PG8_SCHED;
            PG8_LDB(B1, 0, 1); PG8_STAGE(PG8_SB(0, 0), b2, voffB);
            PG8_BAR; PG8_WAIT_L(0); PG8_MMA(0, 1, At, B1); PG8_BAR;
            PG8_LDA(At, 0, 1); PG8_STAGE(PG8_SA(0, 0), a2, voffA);
            PG8_BAR; PG8_WAIT_L(0); PG8_MMA(1, 0, At, B0); PG8_BAR; PG8_SCHED;
            PG8_STAGE(PG8_SB(0, 1), b2 + hstepB, voffB);
            PG8_WAIT_V(6); PG8_BAR; PG8_MMA(1, 1, At, B1); PG8_BAR;
            PG8_LDB(B0, 1, 0); PG8_SCHED; PG8_LDA(At, 1, 0); PG8_STAGE(PG8_SA(0, 1), a2 + hstepA, voffA);
            PG8_WAIT_L(8); PG8_BAR; PG8_WAIT_L(0); PG8_MMA(0, 0, At, B0); PG8_BAR; PG8_SCHED;
            PG8_LDB(B1, 1, 1); PG8_STAGE(PG8_SB(1, 0), b3, voffB);
            PG8_BAR; PG8_WAIT_L(0); PG8_MMA(0, 1, At, B1); PG8_BAR;
            PG8_LDA(At, 1, 1); PG8_STAGE(PG8_SA(1, 0), a3, voffA);
            PG8_BAR; PG8_WAIT_L(0); PG8_MMA(1, 0, At, B0); PG8_BAR; PG8_SCHED;
            PG8_STAGE(PG8_SB(1, 1), b3 + hstepB, voffB);
            PG8_WAIT_V(6); PG8_BAR; PG8_MMA(1, 1, At, B1); PG8_BAR;
            }
        }
        if constexpr (ALIGN_EPI) { if (wr == 0) PG8_BAR; }
        cur.par = ui & 1;
        if constexpr (!Epi::AFTER_DRAIN) { E(acc, cur, wr, wc, fr, fq); S.done(cur); }
        if (!has_next) break;
#pragma unroll
        for (int a = 0; a < 2; ++a)
#pragma unroll
            for (int b = 0; b < 2; ++b)
#pragma unroll
                for (int m = 0; m < 4; ++m)
#pragma unroll
                    for (int n = 0; n < 2; ++n) acc[a][b][m][n] = (f32x4){0.f, 0.f, 0.f, 0.f};
        cur = nxt; cA = nA; cB = nB; ++ui;
        if constexpr (ALIGN_EPI) { if (wr == 1) PG8_BAR; }
    }
    PG8_WAIT_V(0);
    if constexpr (!ALIGN_EPI) { if (wr == 0) PG8_BAR; }
    PG8_BAR;
    if constexpr (Epi::AFTER_DRAIN) { E.fused(acc, cur, wr, wc, fr, fq, lds, wid, lane); S.done(cur); }
#undef PG8_SA
#undef PG8_SB
#undef PG8_STAGE
#undef PG8_LDA
#undef PG8_LDB
#undef PG8_MMA
#undef PG8_WAIT_V
#undef PG8_WAIT_L
#undef PG8_BAR
#undef PG8_SCHED
}
}
#define GAS __attribute__((address_space(1)))
#define LAS __attribute__((address_space(3)))
#define XB_TMO      128
#define XB_XCNT(j)  (256  + 64 * (j))
#define XB_XSUB(j)  (1280 + 64 * (j))
#define XB_XGEN(j)  (2304 + 64 * (j))
#define XB_TOP      3328
#define XB_TOPGEN   3392
#define XCD_BAR_WORDS 3456
#define XB_SPIN_CAP (1u << 18)

__device__ __forceinline__ unsigned xb_ld(unsigned* p)              { return __hip_atomic_load(p, __ATOMIC_RELAXED, __HIP_MEMORY_SCOPE_AGENT); }
__device__ __forceinline__ unsigned xb_add(unsigned* p, unsigned v) { return __hip_atomic_fetch_add(p, v, __ATOMIC_RELAXED, __HIP_MEMORY_SCOPE_AGENT); }
__device__ __forceinline__ unsigned xb_xcc_id() { return (unsigned)__builtin_amdgcn_s_getreg((3 << 11) | 20) & 0xFu; }
#define XB_SPIN(cond, bar) do { unsigned _sp = 0; while (cond) { __builtin_amdgcn_s_sleep(1); \
    if ((++_sp & 255u) == 0u) { if (xb_ld(&(bar)[XB_TMO])) break; if (_sp > XB_SPIN_CAP) { atomicAdd(&(bar)[XB_TMO], 1u); break; } } } } while (0)

struct XcdBarrier {
    unsigned* bar; unsigned x; bool t0;
    volatile LAS unsigned* st;
};

__device__ __forceinline__ XcdBarrier xcd_barrier_post(unsigned* bar, volatile LAS unsigned* st, int wave_id) {
    XcdBarrier b; b.bar = bar; b.x = xb_xcc_id(); b.st = st; b.t0 = false;
    if (wave_id == 0 && lane_id() == 0) (void)xb_add(&bar[XB_XCNT(b.x)], 1u);
    return b;
}
__device__ __forceinline__ void xcd_barrier_complete(unsigned* bar, unsigned x, unsigned& nloc, unsigned& nx) {
    const unsigned G = gridDim.x * gridDim.y * gridDim.z;
    unsigned sum, cnt, mine, sp = 0u;
    for (;;) {
        sum = 0u; cnt = 0u; mine = 0u;
#pragma unroll
        for (unsigned j = 0; j < 16; ++j) { const unsigned c = xb_ld(&bar[XB_XCNT(j)]); sum += c; cnt += (c > 0u) ? 1u : 0u; mine = (j == x) ? c : mine; }
        if (sum == G) break;
        __builtin_amdgcn_s_sleep(1);
        if ((++sp & 255u) == 0u) { if (xb_ld(&bar[XB_TMO])) break; if (sp > XB_SPIN_CAP) { atomicAdd(&bar[XB_TMO], 1u); break; } }
    }
    nloc = mine > 0u ? mine : 1u; nx = cnt > 0u ? cnt : 1u;
}

__device__ __forceinline__ void xcd_barrier(const XcdBarrier& b) {
    asm volatile("s_waitcnt vmcnt(0)" ::: "memory");
    __syncthreads();
    if (b.t0 && lane_id() == 0) {
        unsigned* bar = b.bar;
        __builtin_amdgcn_s_waitcnt(0);
        unsigned nloc = b.st[0], nx = b.st[1];
        if (nloc == 0u) { xcd_barrier_complete(bar, b.x, nloc, nx); b.st[0] = nloc; b.st[1] = nx; }
        const unsigned old = xb_add(&bar[XB_XSUB(b.x)], 1u);
        const unsigned gen = old / nloc;
        if (old + 1u == (gen + 1u) * nloc) {
            __builtin_amdgcn_fence(__ATOMIC_RELEASE, "agent");
            asm volatile("s_waitcnt vmcnt(0)" ::: "memory");
            const unsigned og = xb_add(&bar[XB_TOP], 1u);
            const unsigned tg = og / nx;
            if (og + 1u == (tg + 1u) * nx) xb_add(&bar[XB_TOPGEN], 1u);
            else XB_SPIN(xb_ld(&bar[XB_TOPGEN]) == tg, bar);
            __builtin_amdgcn_fence(__ATOMIC_ACQUIRE, "agent");
            xb_add(&bar[XB_XGEN(b.x)], 1u);
            asm volatile("s_waitcnt vmcnt(0)" ::: "memory");
        } else {
            XB_SPIN(xb_ld(&bar[XB_XGEN(b.x)]) == gen, bar);
            __builtin_amdgcn_fence(__ATOMIC_ACQUIRE, "agent");
            asm volatile("s_waitcnt vmcnt(0)" ::: "memory");
        }
    }
    __syncthreads();
}
__device__ const double INV_R[128] = {1.00000000000000000e+00, 9.30572040929699029e-01, 8.65964323360065347e-01, 8.05842187761481865e-01, 7.49894209332455874e-01, 6.97830584859866376e-01, 6.49381631576211316e-01, 6.04296390238132863e-01, 5.62341325190349073e-01, 5.23299114681494704e-01, 4.86967525165863113e-01, 4.53158363760081784e-01, 4.21696503428582226e-01, 3.92418975848453588e-01, 3.65174127254837722e-01, 3.39820832894255964e-01, 3.16227766016837941e-01, 2.94272717620928159e-01, 2.73841963426436130e-01, 2.54829674797934669e-01, 2.37137370566165517e-01, 2.20673406908458991e-01, 2.05352502645714613e-01, 1.91095297497044042e-01, 1.77827941003892293e-01, 1.65481709994318132e-01, 1.53992652605949187e-01, 1.43301257023696282e-01, 1.33352143216332403e-01, 1.24093776075171955e-01, 1.15478198468945817e-01, 1.07460782832131743e-01, 1.00000000000000006e-01, 9.30572040929699001e-02, 8.65964323360065291e-02, 8.05842187761481865e-02, 7.49894209332455791e-02, 6.97830584859866349e-02, 6.49381631576211316e-02, 6.04296390238132849e-02, 5.62341325190349114e-02, 5.23299114681494704e-02, 4.86967525165863113e-02, 4.53158363760081812e-02, 4.21696503428582239e-02, 3.92418975848453574e-02, 3.65174127254837694e-02, 3.39820832894255909e-02, 3.16227766016837913e-02, 2.94272717620928173e-02, 2.73841963426436144e-02, 2.54829674797934641e-02, 2.37137370566165538e-02, 2.20673406908458991e-02, 2.05352502645714599e-02, 1.91095297497044063e-02, 1.77827941003892293e-02, 1.65481709994318126e-02, 1.53992652605949194e-02, 1.43301257023696268e-02, 1.33352143216332406e-02, 1.24093776075171955e-02, 1.15478198468945813e-02, 1.07460782832131743e-02, 1.00000000000000002e-02, 9.30572040929699036e-03, 8.65964323360065430e-03, 8.05842187761481900e-03, 7.49894209332455791e-03, 6.97830584859866331e-03, 6.49381631576211298e-03, 6.04296390238132780e-03, 5.62341325190349097e-03, 5.23299114681494669e-03, 4.86967525165863096e-03, 4.53158363760081812e-03, 4.21696503428582292e-03, 3.92418975848453627e-03, 3.65174127254837711e-03, 3.39820832894255917e-03, 3.16227766016837939e-03, 2.94272717620928199e-03, 2.73841963426436127e-03, 2.54829674797934667e-03, 2.37137370566165538e-03, 2.20673406908458974e-03, 2.05352502645714599e-03, 1.91095297497044059e-03, 1.77827941003892275e-03, 1.65481709994318139e-03, 1.53992652605949203e-03, 1.43301257023696268e-03, 1.33352143216332406e-03, 1.24093776075171955e-03, 1.15478198468945813e-03, 1.07460782832131756e-03, 1.00000000000000002e-03, 9.30572040929698928e-04, 8.65964323360065387e-04, 8.05842187761481791e-04, 7.49894209332455856e-04, 6.97830584859866353e-04, 6.49381631576211342e-04, 6.04296390238132867e-04, 5.62341325190349097e-04, 5.23299114681494734e-04, 4.86967525165863096e-04, 4.53158363760081790e-04, 4.21696503428582237e-04, 3.92418975848453594e-04, 3.65174127254837700e-04, 3.39820832894255961e-04, 3.16227766016837939e-04, 2.94272717620928167e-04, 2.73841963426436105e-04, 2.54829674797934635e-04, 2.37137370566165538e-04, 2.20673406908458974e-04, 2.05352502645714610e-04, 1.91095297497044048e-04, 1.77827941003892270e-04, 1.65481709994318149e-04, 1.53992652605949192e-04, 1.43301257023696274e-04, 1.33352143216332395e-04, 1.24093776075171960e-04, 1.15478198468945822e-04, 1.07460782832131751e-04};
__device__ const double INV_M[32] = {1.00000000000000000e+00, 7.49894209332455874e-01, 5.62341325190349073e-01, 4.21696503428582226e-01, 3.16227766016837941e-01, 2.37137370566165517e-01, 1.77827941003892293e-01, 1.33352143216332403e-01, 1.00000000000000006e-01, 7.49894209332455791e-02, 5.62341325190349114e-02, 4.21696503428582239e-02, 3.16227766016837913e-02, 2.37137370566165538e-02, 1.77827941003892293e-02, 1.33352143216332406e-02, 1.00000000000000002e-02, 7.49894209332455791e-03, 5.62341325190349097e-03, 4.21696503428582292e-03, 3.16227766016837939e-03, 2.37137370566165538e-03, 1.77827941003892275e-03, 1.33352143216332406e-03, 1.00000000000000002e-03, 7.49894209332455856e-04, 5.62341325190349097e-04, 4.21696503428582237e-04, 3.16227766016837939e-04, 2.37137370566165538e-04, 1.77827941003892270e-04, 1.33352143216332395e-04};
__device__ const float LOG_GAMMA[8] = {-3.174869831e-02f, -1.574835697e-02f, -7.843177461e-03f, -3.913899321e-03f, -1.955034836e-03f, -9.770396478e-04f, -4.884004981e-04f, -2.441704322e-04f};

typedef unsigned short bf16;
typedef unsigned v4u __attribute__((ext_vector_type(4)));
typedef unsigned v2u __attribute__((ext_vector_type(2)));
typedef float f32x4 __attribute__((ext_vector_type(4)));
typedef short bf16x8 __attribute__((ext_vector_type(8)));
typedef float f32x16 __attribute__((ext_vector_type(16)));
typedef short s16x4 __attribute__((ext_vector_type(4)));

constexpr int D = 2048, MP = 32768, MS = 512, M = MP + MS, SEQ = 8192, NBP = 4, NBS = 32, TS = 16, PAST = 2048, DFF = 5632;
constexpr float EPS = 1e-6f;
constexpr int NWAVES = 8;
constexpr int WIN_N = 13568, CWIN_N = 1280;

enum { I_XP = 0, I_XS, I_MEM, I_SCONV, I_SSSD, I_SRET, I_CCKV, I_CKPE, I_CMK, I_CMV, I_NORMS, I_W1, I_W2, I_MNORM, I_WMQ, I_WMKV, I_WMO,
       I_ABWIN, I_CONVW, I_CONVB, I_DTB, I_ALOG, I_DSKIP, I_SSDN, I_ABWOUT, I_CWIN, I_QNORM, I_KVNORM, I_WUQ, I_WUK, I_WUV, I_CWOUT, I_FNORM, N_IN };
constexpr size_t OUT_Y = 0;
constexpr size_t OUT_CONVP = (size_t)M * D;
constexpr size_t OUT_SSDP = OUT_CONVP + 4 * 3 * 3072;
constexpr size_t OUT_RETP = OUT_SSDP + (size_t)4 * 32 * 128 * 64;
constexpr size_t OUT_CKVP = OUT_RETP + (size_t)4 * 8 * 256 * 256;
constexpr size_t OUT_KPEP = OUT_CKVP + (size_t)MP * 512;
constexpr size_t OUT_MEMK = OUT_KPEP + (size_t)MP * 64;
constexpr size_t OUT_MEMV = OUT_MEMK + (size_t)2 * 1024 * 512;
constexpr size_t OUT_CONVS = OUT_MEMV + (size_t)2 * 1024 * 512;
constexpr size_t OUT_SSDS = OUT_CONVS + (size_t)32 * 3 * 3072;
constexpr size_t OUT_RETS = OUT_SSDS + (size_t)32 * 32 * 128 * 64;
constexpr size_t OUT_CKVS = OUT_RETS + (size_t)32 * 8 * 256 * 256;
constexpr size_t OUT_KPES = OUT_CKVS + (size_t)MS * 512;
constexpr size_t OUT_END = OUT_KPES + (size_t)MS * 64;

constexpr size_t AL(size_t x) { return (x + 255) & ~(size_t)255; }
constexpr size_t O_CTL = 0;
constexpr size_t O_SSQ = (size_t)1 << 20;
constexpr size_t O_ZEND = O_SSQ + AL((size_t)9 * M * 8);
constexpr size_t O_SSQG = O_ZEND;
constexpr size_t O_SSQH = O_SSQG + (size_t)M * 64 * 4;
constexpr size_t O_SSQM = O_SSQH + (size_t)M * 64 * 4;
constexpr size_t O_COSR = O_SSQM + AL(1024 * 4);
constexpr size_t O_SINR = O_COSR + (size_t)8192 * 128 * 4;
constexpr size_t O_COSM = O_SINR + (size_t)8192 * 128 * 4;
constexpr size_t O_SINM = O_COSM + (size_t)8192 * 32 * 4;
constexpr size_t O_MB = O_SINM + (size_t)8192 * 32 * 4;
constexpr size_t O_MKV = O_MB + (size_t)1024 * 2048 * 2;
constexpr size_t O_W1 = O_MKV + (size_t)2 * 1024 * 1024 * 2;
constexpr size_t SZ_W1 = (size_t)2 * DFF * D * 2, SZ_W2 = (size_t)D * DFF * 2;
constexpr size_t O_W2 = O_W1 + 4 * SZ_W1;
constexpr size_t O_WIN = O_W2 + 4 * SZ_W2;
constexpr size_t O_WOUT = O_WIN + (size_t)WIN_N * D * 2;
constexpr size_t O_CWIN = O_WOUT + (size_t)D * 4096 * 2;
constexpr size_t O_WUQ = O_CWIN + (size_t)CWIN_N * D * 2;
constexpr size_t O_WKV = O_WUQ + (size_t)3072 * 512 * 2;
constexpr size_t O_CWOUT = O_WKV + (size_t)4096 * 512 * 2;
constexpr size_t O_WMQ = O_CWOUT + (size_t)D * D * 2;
constexpr size_t O_WMKV = O_WMQ + (size_t)2 * 512 * D * 2;
constexpr size_t O_WMO = O_WMKV + (size_t)2 * 1024 * D * 2;
constexpr size_t O_XB = O_WMO + (size_t)2 * D * 512 * 2;
constexpr int XBP = D + 64;
constexpr size_t O_SCR = O_XB + (size_t)M * XBP * 2;
constexpr size_t S_H = 0;
constexpr size_t S_T1 = 0;
constexpr size_t S_ZG = S_T1 + (size_t)M * 4096 * 2;
constexpr size_t S_QK = S_ZG + (size_t)M * 4096 * 2;
constexpr size_t S_BC = S_QK + (size_t)M * 4096 * 2;
constexpr size_t S_DT = S_BC + (size_t)M * 1024 * 2;
constexpr size_t S_L0END = S_DT + (size_t)M * 32 * 4;
constexpr size_t S_QM = 0;
constexpr size_t S_OM = S_QM + (size_t)M * 512 * 2;
constexpr size_t S_CMK = S_OM + (size_t)M * 512 * 2;
constexpr size_t S_CMV = S_CMK + (size_t)32 * 256 * 512 * 2;
constexpr size_t S_PARTQ = S_CMV + (size_t)32 * 256 * 512 * 2;
constexpr size_t S_OB = 0;
constexpr size_t S_CKVB = S_OB + (size_t)M * D * 2;
constexpr size_t S_KPEB = S_CKVB + (size_t)M * 512 * 2;
constexpr size_t S_CKVPAST = S_KPEB + (size_t)M * 64 * 2;
constexpr size_t S_KPEPAST = S_CKVPAST + (size_t)65536 * 512 * 2;
constexpr size_t S_QN = S_KPEPAST + (size_t)65536 * 64 * 2;
constexpr size_t S_QR = S_QN + (size_t)M * D * 2;
constexpr size_t S_KNVN = S_QR + (size_t)M * 1024 * 2;
constexpr size_t S_CQN = S_KNVN + (size_t)MS * 4096 * 2;
constexpr size_t S_CIN = S_CQN + (size_t)M * 512 * 2;
constexpr size_t S_KNV = S_CIN;
constexpr size_t S_L1END = S_KNV + (size_t)MP * 4096 * 2;
constexpr size_t S_MAX = (S_L0END > S_L1END ? S_L0END : S_L1END) > (size_t)M * DFF * 2 ? (S_L0END > S_L1END ? S_L0END : S_L1END) : (size_t)M * DFF * 2;
constexpr size_t WS_NEED = O_SCR + S_MAX;
static_assert(S_CIN + (size_t)M * 1280 * 4 <= S_L1END, "CIN inside the KNV overlay");
static_assert(WS_NEED <= (size_t)1476395008, "workspace map exceeds 4x the largest tensor");

constexpr int RING_BYTES = 131072, LDS_BYTES = 147456, MISC_OFF = LDS_BYTES - 256;

struct Params { const float* in[N_IN]; float* out; unsigned char* ws; int ph_lo, ph_hi; };
static_assert(sizeof(Params) == (N_IN + 2) * 8 + 8, "no padding in Params");

#define LDS_WAIT() asm volatile("s_waitcnt lgkmcnt(0)" ::: "memory")
#define VM_WAIT() asm volatile("s_waitcnt vmcnt(0)" ::: "memory")

__device__ __forceinline__ unsigned f2bf(float f) { unsigned u = __builtin_bit_cast(unsigned, f); return (u + 0x7fffu + ((u >> 16) & 1u)) >> 16; }
__device__ __forceinline__ unsigned pk2(float lo, float hi) { return pg8::cvt_pk_bf16(lo, hi); }
__device__ __forceinline__ float bflo(unsigned w) { return __uint_as_float(w << 16); }
__device__ __forceinline__ float bfhi(unsigned w) { return __uint_as_float(w & 0xffff0000u); }
__device__ __forceinline__ float bf2f(bf16 b) { return __uint_as_float(((unsigned)b) << 16); }
__device__ __forceinline__ float wave_sum(float v) {
#pragma unroll
    for (int o = 1; o < 64; o <<= 1) v += __shfl_xor(v, o);
    return v;
}
typedef unsigned long long u64;
__device__ __forceinline__ u64 ssq_fix(float v) { return (u64)(v * 16777216.0f + 0.5f); }
__device__ __forceinline__ void ssq_add(u64* p, float v) { atomicAdd(p, ssq_fix(v)); }
__device__ __forceinline__ float ssq_get(const u64* p) { return (float)(*p) * (1.0f / 16777216.0f); }
__device__ __forceinline__ float silu_f(float a) { return a * __builtin_amdgcn_rcpf(1.0f + __expf(-a)); }
__device__ __forceinline__ int pos_of_row(int row) { return row < MP ? (row & (SEQ - 1)) : PAST + ((row - MP) & (TS - 1)); }

typedef const pg8::f32x4 (&AccRef)[2][2][4][2];

__device__ __forceinline__ float ssq_lds(const LAS unsigned char* sl, int par, int rl) { return (float)(*(const LAS u64*)(sl + pg8::STAGE_BYTES + par * 2048 + rl * 8)) * (1.0f / 16777216.0f); }

struct EpiSwiglu {
    static constexpr bool PERM = true, AFTER_DRAIN = false, ADJ = false, SSQ_LDS = true;
    bf16* H; const u64* ssq; const LAS unsigned char* sl;
    __device__ __forceinline__ void operator()(AccRef acc, const pg8::Unit& u, int wr, int wc, int fr, int fq) const {
        const int row0 = u.pm * 256 + wr * 64 + fr, col0 = u.pn * 128 + wc * 32 + 8 * fq;
#pragma unroll
        for (int ai = 0; ai < 2; ++ai)
#pragma unroll
            for (int m = 0; m < 4; ++m) {
                const int row = row0 + ai * 128 + m * 16; const float rs = rsqrtf(ssq_lds(sl, u.par, row - u.pm * 256) * (1.0f / D) + EPS);
                float o[8];
#pragma unroll
                for (int n = 0; n < 2; ++n)
#pragma unroll
                    for (int j = 0; j < 4; ++j) { const float a = acc[ai][0][m][n][j] * rs, b = acc[ai][1][m][n][j] * rs; o[4 * n + j] = silu_f(a) * b; }
                v4u w; w.x = pk2(o[0], o[1]); w.y = pk2(o[2], o[3]); w.z = pk2(o[4], o[5]); w.w = pk2(o[6], o[7]);
                *(v4u*)(H + (size_t)row * DFF + col0) = w;
            }
    }
};

__device__ __forceinline__ unsigned swap8(unsigned v) { return (unsigned)__builtin_amdgcn_update_dpp(0, (int)v, 0x128, 0xf, 0xf, true); }
__device__ __forceinline__ v4u swap8(v4u v) { v4u r; r.x = swap8(v.x); r.y = swap8(v.y); r.z = swap8(v.z); r.w = swap8(v.w); return r; }

template <bool FIRST> struct EpiRes {
    static constexpr bool PERM = true, AFTER_DRAIN = false, ADJ = true, SSQ_LDS = false;
    const float* src32; bf16* XB; u64* ssq_next; float alpha;
    __device__ __forceinline__ void operator()(AccRef acc, const pg8::Unit& u, int wr, int wc, int fr, int fq) const {
        const int row0 = u.pm * 256 + wr * 64, colw = u.pn * 256 + wc * 64 + 8 * fq;
        const bool lo = fr < 8; const int r8 = fr & 7, cst = colw + (lo ? 0 : 32);
        v4u q[2][4][2];
        if constexpr (!FIRST) {
#pragma unroll
            for (int ai = 0; ai < 2; ++ai)
#pragma unroll
                for (int m = 0; m < 4; ++m)
#pragma unroll
                    for (int bj = 0; bj < 2; ++bj) q[ai][m][bj] = *(const v4u*)(XB + (size_t)(row0 + ai * 128 + m * 16 + fr) * XBP + colw + bj * 32);
        }
#pragma unroll
        for (int ai = 0; ai < 2; ++ai)
#pragma unroll
            for (int m = 0; m < 4; ++m) {
                const int rowb = row0 + ai * 128 + m * 16, row = rowb + fr; float ss = 0.f; v4u w[2];
#pragma unroll
                for (int bj = 0; bj < 2; ++bj) {
                    f32x4 s0, s1;
                    if constexpr (FIRST) { const float* sp = src32 + (size_t)row * D + colw + bj * 32; s0 = *(const f32x4*)sp; s1 = *(const f32x4*)(sp + 4); }
                    else { const v4u qq = q[ai][m][bj]; s0 = (f32x4){bflo(qq.x), bfhi(qq.x), bflo(qq.y), bfhi(qq.y)}; s1 = (f32x4){bflo(qq.z), bfhi(qq.z), bflo(qq.w), bfhi(qq.w)}; }
                    const f32x4 v0 = s0 + acc[ai][bj][m][0] * alpha, v1 = s1 + acc[ai][bj][m][1] * alpha;
                    w[bj].x = pk2(v0[0], v0[1]); w[bj].y = pk2(v0[2], v0[3]); w[bj].z = pk2(v1[0], v1[1]); w[bj].w = pk2(v1[2], v1[3]);
                    ss += (v0[0] * v0[0] + v0[1] * v0[1]) + (v0[2] * v0[2] + v0[3] * v0[3]) + (v1[0] * v1[0] + v1[1] * v1[1]) + (v1[2] * v1[2] + v1[3] * v1[3]);
                }
                const v4u got = swap8(lo ? w[1] : w[0]);
                const v4u sa = lo ? w[0] : got, sb = lo ? got : w[1];
                bf16* da = XB + (size_t)(rowb + r8) * XBP + cst;
                *(v4u*)da = sa; *(v4u*)(da + (size_t)8 * XBP) = sb;
                ss += __shfl_xor(ss, 16); ss += __shfl_xor(ss, 32);
                if (fq == 0) ssq_add(ssq_next + row, ss);
            }
    }
};

struct EpiPlain {
    static constexpr bool PERM = true, AFTER_DRAIN = false, ADJ = false, SSQ_LDS = false;
    bf16* O; int ldo; const u64* ssq;
    __device__ __forceinline__ void operator()(AccRef acc, const pg8::Unit& u, int wr, int wc, int fr, int fq) const {
        const int row0 = u.pm * 256 + wr * 64 + fr, col0 = u.pn * 256 + wc * 32 + 8 * fq;
#pragma unroll
        for (int ai = 0; ai < 2; ++ai)
#pragma unroll
            for (int m = 0; m < 4; ++m) {
                const int row = row0 + ai * 128 + m * 16; const float rs = ssq ? rsqrtf(ssq_get(ssq + row) * (1.0f / D) + EPS) : 1.0f;
#pragma unroll
                for (int bj = 0; bj < 2; ++bj) {
                    const f32x4 v0 = acc[ai][bj][m][0] * rs, v1 = acc[ai][bj][m][1] * rs;
                    v4u w; w.x = pk2(v0[0], v0[1]); w.y = pk2(v0[2], v0[3]); w.z = pk2(v1[0], v1[1]); w.w = pk2(v1[2], v1[3]);
                    *(v4u*)(O + (size_t)row * ldo + col0 + bj * 128) = w;
                }
            }
    }
};

struct EpiF32 {
    static constexpr bool PERM = true, AFTER_DRAIN = false, ADJ = false, SSQ_LDS = false;
    float* C; int ldc; const u64* ssq;
    __device__ __forceinline__ void operator()(AccRef acc, const pg8::Unit& u, int wr, int wc, int fr, int fq) const {
        const int row0 = u.pm * 256 + wr * 64 + fr, col0 = u.pn * 256 + wc * 32 + 8 * fq;
#pragma unroll
        for (int ai = 0; ai < 2; ++ai)
#pragma unroll
            for (int m = 0; m < 4; ++m) {
                const int row = row0 + ai * 128 + m * 16; const float rs = rsqrtf(ssq_get(ssq + row) * (1.0f / D) + EPS);
#pragma unroll
                for (int bj = 0; bj < 2; ++bj) {
                    float* d = C + (size_t)row * ldc + col0 + bj * 128;
                    *(f32x4*)d = acc[ai][bj][m][0] * rs; *(f32x4*)(d + 4) = acc[ai][bj][m][1] * rs;
                }
            }
    }
};

struct EpiMemKV {
    static constexpr bool PERM = true, AFTER_DRAIN = false, ADJ = false, SSQ_LDS = false;
    float* outk; float* outv; bf16* MKV; const float* ssq;
    __device__ __forceinline__ void operator()(AccRef acc, const pg8::Unit& u, int wr, int wc, int fr, int fq) const {
        const int row0 = u.pm * 256 + wr * 64 + fr, col0 = u.pn * 256 + wc * 32 + 8 * fq;
#pragma unroll
        for (int ai = 0; ai < 2; ++ai)
#pragma unroll
            for (int m = 0; m < 4; ++m) {
                const int row = row0 + ai * 128 + m * 16; const float rs = rsqrtf(ssq[row] * (1.0f / D) + EPS);
#pragma unroll
                for (int bj = 0; bj < 2; ++bj) {
                    const int col = col0 + bj * 128;
                    const f32x4 v0 = acc[ai][bj][m][0] * rs, v1 = acc[ai][bj][m][1] * rs;
                    float* d = (col < 512 ? outk + (size_t)row * 512 + col : outv + (size_t)row * 512 + (col - 512));
                    *(f32x4*)d = v0; *(f32x4*)(d + 4) = v1;
                    v4u w; w.x = pk2(v0[0], v0[1]); w.y = pk2(v0[2], v0[3]); w.z = pk2(v1[0], v1[1]); w.w = pk2(v1[2], v1[3]);
                    *(v4u*)(MKV + (size_t)row * 1024 + col) = w;
                }
            }
    }
};

struct EpiWin {
    static constexpr bool PERM = true, AFTER_DRAIN = false, ADJ = false, SSQ_LDS = true;
    bf16 *T1, *ZG, *QK, *BC; float* DT; const u64* ssq; const float *cosr, *sinr; const float* dt_bias; const LAS unsigned char* sl;
    __device__ __forceinline__ void operator()(AccRef acc, const pg8::Unit& u, int wr, int wc, int fr, int fq) const {
        const int pn = u.pn, row0 = u.pm * 256 + wr * 64 + fr, cl = wc * 32 + 8 * fq;
        if (pn < 36) {
            bf16* base; int pitch = 4096, colt;
            if (pn < 8) { base = ZG; colt = pn * 256; } else if (pn < 16) { base = ZG; colt = 2048 + (pn - 8) * 256; }
            else if (pn < 24) { base = T1; colt = (pn - 16) * 256; } else if (pn < 32) { base = T1; colt = 2048 + (pn - 24) * 256; }
            else { base = BC; pitch = 1024; colt = (pn - 32) * 256; }
#pragma unroll
            for (int ai = 0; ai < 2; ++ai)
#pragma unroll
                for (int m = 0; m < 4; ++m) {
                    const int row = row0 + ai * 128 + m * 16; const float rs = rsqrtf(ssq_lds(sl, u.par, row - u.pm * 256) * (1.0f / D) + EPS);
#pragma unroll
                    for (int bj = 0; bj < 2; ++bj) {
                        const f32x4 v0 = acc[ai][bj][m][0] * rs, v1 = acc[ai][bj][m][1] * rs;
                        v4u w; w.x = pk2(v0[0], v0[1]); w.y = pk2(v0[2], v0[3]); w.z = pk2(v1[0], v1[1]); w.w = pk2(v1[2], v1[3]);
                        *(v4u*)(base + (size_t)row * pitch + colt + cl + bj * 128) = w;
                    }
                }
        } else if (pn < 52) {
            const bool isk = pn >= 44; const int head = isk ? pn - 44 : pn - 36; const int colt = (isk ? 2048 : 0) + head * 256; const float sc = isk ? 0.0625f : 1.0f;
            float invt[8];
#pragma unroll
            for (int e = 0; e < 8; ++e) invt[e] = (float)(INV_R[cl + e] * 0.15915494309189533577);
#pragma unroll
            for (int ai = 0; ai < 2; ++ai)
#pragma unroll
                for (int m = 0; m < 4; ++m) {
                    const int row = row0 + ai * 128 + m * 16; const float rs = rsqrtf(ssq_lds(sl, u.par, row - u.pm * 256) * (1.0f / D) + EPS) * sc;
                    const float posf = (float)pos_of_row(row);
                    f32x4 c0, c1, s0, s1;
#pragma unroll
                    for (int e = 0; e < 4; ++e) { const float t0 = __builtin_amdgcn_fractf(posf * invt[e]), t1 = __builtin_amdgcn_fractf(posf * invt[4 + e]);
                        c0[e] = __builtin_amdgcn_cosf(t0); s0[e] = __builtin_amdgcn_sinf(t0); c1[e] = __builtin_amdgcn_cosf(t1); s1[e] = __builtin_amdgcn_sinf(t1); }
                    const f32x4 a0 = acc[ai][0][m][0] * rs, a1 = acc[ai][0][m][1] * rs, b0 = acc[ai][1][m][0] * rs, b1 = acc[ai][1][m][1] * rs;
                    const f32x4 x0 = a0 * c0 - b0 * s0, x1 = a1 * c1 - b1 * s1, y0 = b0 * c0 + a0 * s0, y1 = b1 * c1 + a1 * s1;
                    v4u w; w.x = pk2(x0[0], x0[1]); w.y = pk2(x0[2], x0[3]); w.z = pk2(x1[0], x1[1]); w.w = pk2(x1[2], x1[3]);
                    *(v4u*)(QK + (size_t)row * 4096 + colt + cl) = w;
                    v4u z; z.x = pk2(y0[0], y0[1]); z.y = pk2(y0[2], y0[3]); z.z = pk2(y1[0], y1[1]); z.w = pk2(y1[2], y1[3]);
                    *(v4u*)(QK + (size_t)row * 4096 + colt + 128 + cl) = z;
                }
        } else {
            if (wc == 0) {
#pragma unroll
                for (int ai = 0; ai < 2; ++ai)
#pragma unroll
                    for (int m = 0; m < 4; ++m) {
                        const int row = row0 + ai * 128 + m * 16; const float rs = rsqrtf(ssq_lds(sl, u.par, row - u.pm * 256) * (1.0f / D) + EPS);
                        const f32x4 v0 = acc[ai][0][m][0] * rs, v1 = acc[ai][0][m][1] * rs;
                        *(f32x4*)(DT + (size_t)row * 32 + cl) = v0; *(f32x4*)(DT + (size_t)row * 32 + cl + 4) = v1;
                    }
            }
        }
    }
};

struct EpiUq {
    static constexpr bool PERM = true, AFTER_DRAIN = false, ADJ = false, SSQ_LDS = false;
    bf16 *QN, *QR; const float *cosm, *sinm;
    __device__ __forceinline__ void operator()(AccRef acc, const pg8::Unit& u, int wr, int wc, int fr, int fq) const {
        const int pn = u.pn, row0 = u.pm * 256 + wr * 64 + fr, cl = wc * 32 + 8 * fq;
        if (pn < 8) {
#pragma unroll
            for (int ai = 0; ai < 2; ++ai)
#pragma unroll
                for (int m = 0; m < 4; ++m) {
                    const int row = row0 + ai * 128 + m * 16;
#pragma unroll
                    for (int bj = 0; bj < 2; ++bj) {
                        const f32x4 v0 = acc[ai][bj][m][0], v1 = acc[ai][bj][m][1];
                        v4u w; w.x = pk2(v0[0], v0[1]); w.y = pk2(v0[2], v0[3]); w.z = pk2(v1[0], v1[1]); w.w = pk2(v1[2], v1[3]);
                        *(v4u*)(QN + (size_t)row * D + pn * 256 + cl + bj * 128) = w;
                    }
                }
        } else {
            const int head = 4 * (pn - 8) + wc, i0 = 8 * fq;
#pragma unroll
            for (int ai = 0; ai < 2; ++ai)
#pragma unroll
                for (int m = 0; m < 4; ++m) {
                    const int row = row0 + ai * 128 + m * 16; const int pos = pos_of_row(row);
                    const f32x4 c0 = *(const f32x4*)(cosm + (size_t)pos * 32 + i0), c1 = *(const f32x4*)(cosm + (size_t)pos * 32 + i0 + 4);
                    const f32x4 s0 = *(const f32x4*)(sinm + (size_t)pos * 32 + i0), s1 = *(const f32x4*)(sinm + (size_t)pos * 32 + i0 + 4);
                    const f32x4 a0 = acc[ai][0][m][0], a1 = acc[ai][0][m][1], b0 = acc[ai][1][m][0], b1 = acc[ai][1][m][1];
                    const f32x4 x0 = a0 * c0 - b0 * s0, x1 = a1 * c1 - b1 * s1, y0 = b0 * c0 + a0 * s0, y1 = b1 * c1 + a1 * s1;
                    v4u w; w.x = pk2(x0[0], x0[1]); w.y = pk2(x0[2], x0[3]); w.z = pk2(x1[0], x1[1]); w.w = pk2(x1[2], x1[3]);
                    *(v4u*)(QR + (size_t)row * 1024 + head * 64 + i0) = w;
                    v4u z; z.x = pk2(y0[0], y0[1]); z.y = pk2(y0[2], y0[3]); z.z = pk2(y1[0], y1[1]); z.w = pk2(y1[2], y1[3]);
                    *(v4u*)(QR + (size_t)row * 1024 + head * 64 + 32 + i0) = z;
                }
        }
    }
};

struct SplitOrder {
    int nN, KS, nun, G, c;
    __device__ __forceinline__ void init(int Mrows, int N, int KS_, int G_, int c_) { nN = N / 256; KS = KS_; nun = (Mrows / 256) * nN * KS_; G = G_; c = c_; }
    __device__ __forceinline__ bool next(int i, pg8::Unit& u) const { const int L = i * G + c; if (L >= nun) return false; u.kp = L % KS; const int t = L / KS; u.pn = t % nN; u.pm = t / nN; return true; }
    __device__ __forceinline__ void a_ready(const pg8::Unit&) const {}
    __device__ __forceinline__ void done(const pg8::Unit&) const {}
};
struct EpiPart {
    static constexpr bool PERM = true, AFTER_DRAIN = false, ADJ = false, SSQ_LDS = false;
    float* PART; int ldc; size_t slab;
    __device__ __forceinline__ void operator()(AccRef acc, const pg8::Unit& u, int wr, int wc, int fr, int fq) const {
        const int row0 = u.pm * 256 + wr * 64 + fr, col0 = u.pn * 256 + wc * 32 + 8 * fq; float* base = PART + (size_t)u.kp * slab;
#pragma unroll
        for (int ai = 0; ai < 2; ++ai)
#pragma unroll
            for (int m = 0; m < 4; ++m) {
                float* d = base + (size_t)(row0 + ai * 128 + m * 16) * ldc + col0;
#pragma unroll
                for (int bj = 0; bj < 2; ++bj) { *(f32x4*)(d + bj * 128) = acc[ai][bj][m][0]; *(f32x4*)(d + bj * 128 + 4) = acc[ai][bj][m][1]; }
            }
    }
};

__device__ __forceinline__ pg8::StaticOrder make_order(int Mrows, int N, int G, int wg, int rot) { pg8::StaticOrder S; S.init(Mrows, N, G, (wg + G - (rot % G)) % G); return S; }

template <class SM>
__device__ __forceinline__ void cvt_weight(const float* __restrict__ W, int K, int ldw, const float* __restrict__ g, int glim, bf16* __restrict__ Bt, int Npad, SM sm,
                                           LAS float* scrf, int gw, int NGW, int lane) {
    LAS bf16* scr = (LAS bf16*)scrf;
    const int nblk = Npad >> 6, items = (K >> 6) * nblk;
    const int c = lane & 7;
    for (int it = gw; it < items; it += NGW) {
        const int kb = it / nblk, nb = it - kb * nblk, k0 = kb << 6, n0 = nb << 6;
        const int src = sm(n0 + (lane & 32));
        float wv[64];
#pragma unroll
        for (int i = 0; i < 64; ++i) wv[i] = src >= 0 ? __builtin_nontemporal_load(W + (size_t)(k0 + i) * ldw + src + (lane & 31)) : 0.f;
#pragma unroll
        for (int i = 0; i < 64; ++i) { float w = wv[i]; if (g != nullptr && k0 + i < glim) w *= g[k0 + i]; scr[i * 66 + lane] = (bf16)f2bf(w); }
        LDS_WAIT(); asm volatile("" ::: "memory");
#pragma unroll
        for (int j = 0; j < 8; ++j) {
            const int n = (lane >> 3) + 8 * j; const LAS bf16* s = scr + (8 * c) * 66 + n;
            v4u o; o.x = (unsigned)s[0] | ((unsigned)s[66] << 16); o.y = (unsigned)s[2 * 66] | ((unsigned)s[3 * 66] << 16); o.z = (unsigned)s[4 * 66] | ((unsigned)s[5 * 66] << 16); o.w = (unsigned)s[6 * 66] | ((unsigned)s[7 * 66] << 16);
            *(v4u*)(Bt + (size_t)(n0 + n) * K + k0 + 8 * c) = o;
        }
        LDS_WAIT(); asm volatile("" ::: "memory");
    }
}
struct SmId { int lim; __device__ __forceinline__ int operator()(int n) const { return n < lim ? n : -1; } };
struct SmW1 { __device__ __forceinline__ int operator()(int n) const { const int t = n >> 8, j = n & 255; return j < 128 ? 128 * t + j : DFF + 128 * t + (j - 128); } };
struct SmWin { __device__ __forceinline__ int operator()(int n) const { const int t = n >> 8;
    if (t < 8) return n; if (t < 16) return 11296 + (n - 2048); if (t < 24) return 2048 + (n - 4096); if (t < 32) return 9248 + (n - 6144);
    if (t < 36) return 4096 + (n - 8192); if (t < 44) return 5152 + (n - 9216); if (t < 52) return 7200 + (n - 11264);
    return (n - 13312) < 32 ? 5120 + (n - 13312) : -1; } };
struct SmUq { __device__ __forceinline__ int operator()(int n) const {
    if (n < 2048) return (n >> 7) * 192 + (n & 127);
    const int t = (n - 2048) >> 8, j = (n - 2048) & 255, half = j >> 7, hh = (j & 127) >> 5, i = j & 31; return (4 * t + hh) * 192 + 128 + half * 32 + i; } };

__device__ __forceinline__ float row_to_bf16(const float* __restrict__ src, bf16* __restrict__ dst, int lane) {
    float ss = 0.f;
#pragma unroll
    for (int j = 0; j < 8; ++j) {
        const f32x4 v = __builtin_nontemporal_load((const f32x4*)(src + 4 * (lane + 64 * j)));
        ss += (v[0] * v[0] + v[1] * v[1]) + (v[2] * v[2] + v[3] * v[3]);
        v2u w; w.x = pk2(v[0], v[1]); w.y = pk2(v[2], v[3]);
        *(v2u*)(dst + 4 * (lane + 64 * j)) = w;
    }
    return wave_sum(ss);
}
__device__ __forceinline__ void cvt_bulk(const float* __restrict__ src, bf16* __restrict__ dst, size_t n8, size_t gt, size_t ngt) {
    for (size_t i = gt; i < n8; i += ngt) {
        const f32x4 a = __builtin_nontemporal_load((const f32x4*)(src + i * 8)), b = __builtin_nontemporal_load((const f32x4*)(src + i * 8 + 4));
        v4u w; w.x = pk2(a[0], a[1]); w.y = pk2(a[2], a[3]); w.z = pk2(b[0], b[1]); w.w = pk2(b[2], b[3]);
        *(v4u*)(dst + i * 8) = w;
    }
}

namespace att {
constexpr int SHM_V = 16384, SHM_K = 16384, SHM_R = 8192;
constexpr int OFF_V = 0, OFF_K = 2 * SHM_V, OFF_R = OFF_K + 2 * SHM_K, OFF_WS = OFF_R + 2 * SHM_R, LDS_NEED = OFF_WS + NWAVES * 64 * 4;
#define KSWZ(row, colB) ((row) * 256 + ((colB) ^ (((row) & 7) << 4)))
#define RSWZ(row, colB) ((row) * 128 + ((colB) ^ (((row) & 7) << 4)))
#define SBAR() __builtin_amdgcn_sched_barrier(0)
__device__ __forceinline__ int crow(int r, int hi) { return (r & 3) + 8 * (r >> 2) + 4 * hi; }
__device__ __forceinline__ unsigned cvtpk(float lo, float hi) { unsigned r; asm volatile("v_cvt_pk_bf16_f32 %0, %1, %2" : "=v"(r) : "v"(lo), "v"(hi)); return r; }

__device__ __forceinline__ void partialSM(f32x16& p0, f32x16& p1, float& m_reg, float& mn, float& alpha, float C, float thr_s) {
    float pmax = p0[0];
#pragma unroll
    for (int r = 1; r < 16; ++r) pmax = fmaxf(pmax, p0[r]);
#pragma unroll
    for (int r = 0; r < 16; ++r) pmax = fmaxf(pmax, p1[r]);
    { auto rr = __builtin_amdgcn_permlane32_swap(__float_as_uint(pmax), __float_as_uint(pmax), false, false);
      pmax = fmaxf(__uint_as_float(rr[0]), __uint_as_float(rr[1])); }
    if (__builtin_expect(__all(pmax - m_reg <= thr_s), 1)) { mn = m_reg; alpha = 1.f; }
    else { mn = fmaxf(m_reg, pmax); alpha = __builtin_amdgcn_exp2f((m_reg - mn) * C); m_reg = mn; }
    const float mnC = -mn * C;
#pragma unroll
    for (int r = 0; r < 16; ++r) p0[r] = fmaf(p0[r], C, mnC);
#pragma unroll
    for (int r = 0; r < 16; ++r) p1[r] = fmaf(p1[r], C, mnC);
#pragma unroll
    for (int r = 0; r < 16; ++r) p0[r] = __builtin_amdgcn_exp2f(p0[r]);
}
__device__ __forceinline__ void finishSM(f32x16& p0, f32x16& p1, float alpha, float& l_reg, bf16x8& pa0, bf16x8& pa1, bf16x8& pa2, bf16x8& pa3) {
#pragma unroll
    for (int r = 0; r < 16; ++r) p1[r] = __builtin_amdgcn_exp2f(p1[r]);
    float ps = 0;
#pragma unroll
    for (int r = 0; r < 16; ++r) ps += p0[r];
#pragma unroll
    for (int r = 0; r < 16; ++r) ps += p1[r];
    { auto rr = __builtin_amdgcn_permlane32_swap(__float_as_uint(ps), __float_as_uint(ps), false, false);
      ps = __uint_as_float(rr[0]) + __uint_as_float(rr[1]); }
    l_reg = l_reg * alpha + ps;
#define PK4(P, BASE, OUT) do { unsigned a0 = cvtpk(P[BASE + 0], P[BASE + 1]), a1 = cvtpk(P[BASE + 2], P[BASE + 3]);   \
    unsigned b0 = cvtpk(P[BASE + 4], P[BASE + 5]), b1 = cvtpk(P[BASE + 6], P[BASE + 7]);                              \
    auto r0 = __builtin_amdgcn_permlane32_swap(a0, b0, false, false); auto r1 = __builtin_amdgcn_permlane32_swap(a1, b1, false, false); \
    v4u w = {r0[0], r1[0], r0[1], r1[1]}; OUT = *reinterpret_cast<bf16x8*>(&w); } while (0)
    PK4(p0, 0, pa0); PK4(p0, 8, pa1); PK4(p1, 0, pa2); PK4(p1, 8, pa3);
#undef PK4
}
template <int DR>
__device__ __forceinline__ void qkt(f32x16& p0, f32x16& p1, const LAS unsigned char* Ks, const LAS unsigned char* Rs, const bf16x8* qr, const bf16x8* qrr, int r32, int hi) {
    p0 = f32x16{}; p1 = f32x16{};
#pragma unroll
    for (int d0 = 0; d0 < 8; ++d0) { const int cb = (d0 * 16 + hi * 8) * 2;
        const bf16x8 b0 = *(const LAS bf16x8*)(Ks + KSWZ(r32, cb));
        const bf16x8 b1 = *(const LAS bf16x8*)(Ks + KSWZ(32 + r32, cb));
        p0 = __builtin_amdgcn_mfma_f32_32x32x16_bf16(b0, qr[d0], p0, 0, 0, 0);
        p1 = __builtin_amdgcn_mfma_f32_32x32x16_bf16(b1, qr[d0], p1, 0, 0, 0); }
    if constexpr (DR > 0) {
#pragma unroll
        for (int d0 = 0; d0 < DR / 16; ++d0) { const int cb = (d0 * 16 + hi * 8) * 2;
            const bf16x8 b0 = *(const LAS bf16x8*)(Rs + RSWZ(r32, cb));
            const bf16x8 b1 = *(const LAS bf16x8*)(Rs + RSWZ(32 + r32, cb));
            p0 = __builtin_amdgcn_mfma_f32_32x32x16_bf16(b0, qrr[d0], p0, 0, 0, 0);
            p1 = __builtin_amdgcn_mfma_f32_32x32x16_bf16(b1, qrr[d0], p1, 0, 0, 0); }
    }
}
__device__ __forceinline__ void mask_tile(f32x16& p0, f32x16& p1, int tile, int kmax, int hi) {
    const int kb = tile * 64;
    if (kb + 64 > kmax) {
#pragma unroll
        for (int r = 0; r < 16; ++r) { const int k0 = kb + crow(r, hi); if (k0 >= kmax) p0[r] = -1e30f; if (k0 + 32 >= kmax) p1[r] = -1e30f; }
    }
}
__device__ __forceinline__ int v_st(int k, int c) { const int kk = (k & ~0xC) | ((k & 4) << 1) | ((k & 8) >> 1); return ((kk >> 3) * 4 + (c >> 5)) * 512 + ((kk & 7) * 32 + (c & 31)) * 2; }
__device__ __forceinline__ int v_rd_base(int lane) { return ((lane & 3) << 3) | (((lane >> 2) & 3) << 6) | (((lane >> 4) & 1) << 5) | (((lane >> 5) & 1) << 8); }
constexpr int v_rd_off(int d0, int ks, int half) { return d0 * 512 + ks * 4096 + half * 2048; }
template <int OFF> __device__ __forceinline__ s16x4 tr_read(int vb) {
    s16x4 r; asm volatile("ds_read_b64_tr_b16 %0, %1 offset:%2" : "=&v"(r) : "v"(vb), "i"(OFF) : "memory"); return r;
}
template <int D0> __device__ __forceinline__ void pv_one(f32x16& od, int vb, bf16x8 pa0, bf16x8 pa1, bf16x8 pa2, bf16x8 pa3) {
    const s16x4 l0 = tr_read<v_rd_off(D0, 0, 0)>(vb), h0 = tr_read<v_rd_off(D0, 0, 1)>(vb), l1 = tr_read<v_rd_off(D0, 1, 0)>(vb), h1 = tr_read<v_rd_off(D0, 1, 1)>(vb);
    const s16x4 l2 = tr_read<v_rd_off(D0, 2, 0)>(vb), h2 = tr_read<v_rd_off(D0, 2, 1)>(vb), l3 = tr_read<v_rd_off(D0, 3, 0)>(vb), h3 = tr_read<v_rd_off(D0, 3, 1)>(vb);
    asm volatile("s_waitcnt lgkmcnt(0)" ::: "memory"); SBAR();
#define PK(L, H) (bf16x8){L[0], L[1], L[2], L[3], H[0], H[1], H[2], H[3]}
    od = __builtin_amdgcn_mfma_f32_32x32x16_bf16(pa0, PK(l0, h0), od, 0, 0, 0);
    od = __builtin_amdgcn_mfma_f32_32x32x16_bf16(pa1, PK(l1, h1), od, 0, 0, 0);
    od = __builtin_amdgcn_mfma_f32_32x32x16_bf16(pa2, PK(l2, h2), od, 0, 0, 0);
    od = __builtin_amdgcn_mfma_f32_32x32x16_bf16(pa3, PK(l3, h3), od, 0, 0, 0);
#undef PK
}
__device__ __forceinline__ void pv_d0(f32x16* o, int vb, bf16x8 pa0, bf16x8 pa1, bf16x8 pa2, bf16x8 pa3) {
    pv_one<0>(o[0], vb, pa0, pa1, pa2, pa3); pv_one<1>(o[1], vb, pa0, pa1, pa2, pa3); pv_one<2>(o[2], vb, pa0, pa1, pa2, pa3); pv_one<3>(o[3], vb, pa0, pa1, pa2, pa3);
}

template <int DR, bool PP, bool NTL, class KN, class KR, class VV>
__device__ __forceinline__ void attn_unit(LAS unsigned char* lds, const bf16* qn, const bf16* qrp, KN kn, KR kr, VV vv, int NT, int kmax, float C, float thr_s,
                                          bf16* orow0, int ldo, int nvalid, bool active, int wave_id) {
    const int wid = wave_id, lane = lane_id(), tid = wid * 64 + lane, r32 = lane & 31, hi = lane >> 5;
    LAS unsigned char* V_lds = lds + OFF_V; LAS unsigned char* K_lds = lds + OFF_K; LAS unsigned char* R_lds = lds + OFF_R;
    LAS float* ws = (LAS float*)(lds + OFF_WS) + wid * 64; LAS float* li_l = ws; LAS float* al_l = ws + 32;
    float m_reg = -1e30f, l_reg = 0.f; f32x16 o[4] = {}; bf16x8 qr[8]; bf16x8 qrr[DR > 0 ? DR / 16 : 1];
#pragma unroll
    for (int d0 = 0; d0 < 8; ++d0) qr[d0] = *(const bf16x8*)(qn + d0 * 16 + hi * 8);
    if constexpr (DR > 0) {
#pragma unroll
        for (int d0 = 0; d0 < DR / 16; ++d0) qrr[d0] = *(const bf16x8*)(qrp + d0 * 16 + hi * 8);
    }
    const int sr = tid >> 4, sc = (tid & 15) * 8, vst0 = v_st(sr, sc), vst1 = v_st(32 + sr, sc), rr_ = tid >> 3, rc = (tid & 7) * 8;
    const int vb0 = (int)(unsigned)(uintptr_t)V_lds + v_rd_base(lane);
    bf16x8 s_vs0, s_vs1, s_ks0, s_ks1, s_rs;
    const bf16x8 zero8 = {0, 0, 0, 0, 0, 0, 0, 0};
#define ATT_LD8(p) (NTL ? __builtin_nontemporal_load((const bf16x8*)(p)) : *(const bf16x8*)(p))
#define SLOAD(k0) do { const bf16* _p; _p = vv((k0) + sr); s_vs0 = _p ? ATT_LD8(_p + sc) : zero8; _p = vv((k0) + 32 + sr); s_vs1 = _p ? ATT_LD8(_p + sc) : zero8; \
    _p = kn((k0) + sr); s_ks0 = _p ? ATT_LD8(_p + sc) : zero8; _p = kn((k0) + 32 + sr); s_ks1 = _p ? ATT_LD8(_p + sc) : zero8; \
    if constexpr (DR > 0) { _p = kr((k0) + rr_); s_rs = _p ? ATT_LD8(_p + rc) : zero8; } } while (0)
#define SWRITE(b) do { *(LAS bf16x8*)(V_lds + (b) * SHM_V + vst0) = s_vs0; *(LAS bf16x8*)(V_lds + (b) * SHM_V + vst1) = s_vs1; \
    *(LAS bf16x8*)(K_lds + (b) * SHM_K + KSWZ(sr, sc * 2)) = s_ks0; *(LAS bf16x8*)(K_lds + (b) * SHM_K + KSWZ(32 + sr, sc * 2)) = s_ks1; \
    if constexpr (DR > 0) { *(LAS bf16x8*)(R_lds + (b) * SHM_R + RSWZ(rr_, rc * 2)) = s_rs; } } while (0)
#define SWAIT() asm volatile("s_waitcnt vmcnt(0)" ::: "memory")
#define RESC(a) do { if (__any((a) < 1.f)) { if (hi == 0) al_l[r32] = (a); asm volatile("s_waitcnt lgkmcnt(0)" ::: "memory"); \
    _Pragma("unroll") for (int d = 0; d < 4; ++d) _Pragma("unroll") for (int r = 0; r < 16; ++r) o[d][r] *= al_l[crow(r, hi)]; } } while (0)
    f32x16 p0, p1; float mn, al = 1.f; bf16x8 pa0, pa1, pa2, pa3;
    SLOAD(0); SWAIT(); SWRITE(0); if (!PP && 1 < NT) SLOAD(64); __syncthreads();
    if constexpr (PP) {
        const bool grpA = wid < 4;
#define ATT_STAGE(j) do { if ((j) + 1 < NT) { SWAIT(); SWRITE(((j) + 1) & 1); if ((j) + 2 < NT) SLOAD(((j) + 2) * 64); } } while (0)
        if (1 < NT) SLOAD(64);
        if (!grpA) __syncthreads();
        for (int j = 0; j < NT; ++j) {
            SBAR();
            qkt<DR>(p0, p1, K_lds + (j & 1) * SHM_K, R_lds + (j & 1) * SHM_R, qr, qrr, r32, hi); mask_tile(p0, p1, j, kmax, hi);
            if (!grpA) ATT_STAGE(j);
            __syncthreads();
            partialSM(p0, p1, m_reg, mn, al, C, thr_s); RESC(al); finishSM(p0, p1, al, l_reg, pa0, pa1, pa2, pa3); SBAR();
            pv_d0(o, vb0 + (j & 1) * SHM_V, pa0, pa1, pa2, pa3);
            if (grpA) ATT_STAGE(j);
            __syncthreads();
        }
        if (grpA) __syncthreads();
#undef ATT_STAGE
    } else {
    for (int j = 0; j < NT; ++j) {
        const int bsel = j & 1;
        if (j + 1 < NT) { SWAIT(); SWRITE(bsel ^ 1); if (j + 2 < NT) SLOAD((j + 2) * 64); }
        SBAR();
        if (active) {
            qkt<DR>(p0, p1, K_lds + bsel * SHM_K, R_lds + bsel * SHM_R, qr, qrr, r32, hi); mask_tile(p0, p1, j, kmax, hi);
            partialSM(p0, p1, m_reg, mn, al, C, thr_s);
            RESC(al);
            finishSM(p0, p1, al, l_reg, pa0, pa1, pa2, pa3); SBAR();
            pv_d0(o, vb0 + bsel * SHM_V, pa0, pa1, pa2, pa3);
        }
        __syncthreads();
    }
    }
    if (active) {
        if (hi == 0) li_l[r32] = l_reg; asm volatile("s_waitcnt lgkmcnt(0)" ::: "memory");
#pragma unroll
        for (int r = 0; r < 16; ++r) { const int orow = crow(r, hi); const float rli = __builtin_amdgcn_rcpf(li_l[orow]);
            if (orow < nvalid) {
#pragma unroll
                for (int d0 = 0; d0 < 4; ++d0) orow0[(size_t)orow * ldo + d0 * 32 + r32] = (bf16)f2bf(o[d0][r] * rli); } }
    }
    __syncthreads();
#undef SLOAD
#undef ATT_LD8
#undef SWRITE
#undef SWAIT
#undef RESC
}
}

namespace scan {
constexpr int PC = 136, PT = 72, PH = 264;
constexpr int O_BV = 0, O_XT = 16384, O_XW = O_XT + 4096, O_CS = O_XW + 4096, O_BS = O_CS + 64 * PC * 2, O_GS = O_BS + 64 * PC * 2,
              O_HT = O_GS + 64 * PT * 2, O_YS = O_HT + 32 * PH * 2, O_XSF = O_YS + 64 * 33 * 4, O_ZS = O_XSF + 64 * 32 * 4, O_CUM = O_ZS + 64 * 32 * 4,
              O_DTL = O_CUM + 2 * 5 * 64 * 4, O_END = O_DTL + 8192 * 4;
static_assert(O_END <= MISC_OFF, "scan LDS");
struct Bufs { bf16 *T1, *ZG, *QK, *BC; const float* DT; float *SSQG, *SSQH; const float *alog, *dskip; };

__device__ __forceinline__ int v_st32(int k, int c) { const int kk = (k & ~0xC) | ((k & 4) << 1) | ((k & 8) >> 1); return (kk >> 3) * 512 + ((kk & 7) * 32 + c) * 2; }
#define TRPK(L, H) (bf16x8){L[0], L[1], L[2], L[3], H[0], H[1], H[2], H[3]}
#define TRKL(k) const s16x4 _al##k = att::tr_read<(2 * (k)) * 512>(xwb), _ah##k = att::tr_read<(2 * (k) + 1) * 512>(xwb), _bl##k = att::tr_read<(k) * 4096>(bvb), _bh##k = att::tr_read<(k) * 4096 + 2048>(bvb)
#define TRKM(k) hacc = __builtin_amdgcn_mfma_f32_32x32x16_bf16(TRPK(_al##k, _ah##k), TRPK(_bl##k, _bh##k), hacc, 0, 0, 0)
#define TRYL(k) const bf16x8 _ya##k = frag(GS, PT, 32 * ti + r32, 16 * (k) + 8 * hi); const s16x4 _yl##k = att::tr_read<(2 * (k)) * 512>(xtb), _yh##k = att::tr_read<(2 * (k) + 1) * 512>(xtb)
#define TRYM(k) gacc = __builtin_amdgcn_mfma_f32_32x32x16_bf16(_ya##k, TRPK(_yl##k, _yh##k), gacc, 0, 0, 0)
__device__ __forceinline__ bf16x8 frag(const LAS unsigned char* base, int pitch, int row, int k0) { return *(const LAS bf16x8*)(base + (row * pitch + k0) * 2); }

template <bool SSD>
__device__ __forceinline__ void scan_unit(LAS unsigned char* lds, const Bufs& B, int rowbase, int nchunks, int tv_last, int h, int sl,
                                          const float* h0, float* hout, int wave_id) {
    constexpr int NS = SSD ? 128 : 256, NH = NS / 128, PF = SSD ? 64 : 256, PHT = NS + 8;
    const int wid = wave_id, lane = lane_id(), tid = wid * 64 + lane, r32 = lane & 31, hi = lane >> 5;
    LAS unsigned char* CS = lds + O_CS; LAS unsigned char* BS = lds + O_BS; LAS unsigned char* BV = lds + O_BV; LAS unsigned char* XT = lds + O_XT;
    LAS unsigned char* XW = lds + O_XW; LAS unsigned char* GS = lds + O_GS; LAS unsigned char* HT = lds + O_HT;
    LAS float* YS = (LAS float*)(lds + O_YS); LAS float* XSF = (LAS float*)(lds + O_XSF); LAS float* ZS = (LAS float*)(lds + O_ZS);
    LAS float* DTL = (LAS float*)(lds + O_DTL);
    LAS float* CUMB = (LAS float*)(lds + O_CUM);
    const int g = h >> 3;
    const bool has_state = SSD ? (wid < 4) : true;
    const int n0 = wid * 32;
    const float a_h = SSD ? -__expf(B.alog[h]) : 0.f, lgam = SSD ? 0.f : LOG_GAMMA[h], dsk = SSD ? B.dskip[h] : 0.f;
    const int xcol = SSD ? h * 64 + sl * 32 : 2048 + h * 256 + sl * 32;
    const int isB = wid >> 2, tt = tid & 255;
    const bf16* cbsrc = SSD ? B.BC + (isB ? 0 : 512) + g * 128 : B.QK + (isB ? 2048 : 0) + h * 256; const int cbp = SSD ? 1024 : 4096;
    f32x16 hacc = {}, gacc = {};
    v4u rX = {0u, 0u, 0u, 0u}, rZ = {0u, 0u, 0u, 0u}, rCB[NH][4]; float rdt = 0.f;
    const v4u zero4 = {0u, 0u, 0u, 0u};
#define SC_SYNC() do { asm volatile("s_waitcnt lgkmcnt(0)" ::: "memory"); __builtin_amdgcn_s_barrier(); asm volatile("" ::: "memory"); } while (0)
#define SC_TV(c) (((c) == nchunks - 1) ? tv_last : 64)
#define SC_LOAD_X(c) do { const int _tv = SC_TV(c); const size_t _R0 = (size_t)rowbase + (size_t)(c) * 64; if (tid < 256) { const int _l = tid >> 2, _c8 = (tid & 3) * 8; \
        rX = _l < _tv ? *(const v4u*)(B.T1 + (_R0 + _l) * 4096 + xcol + _c8) : zero4; if (SSD) rZ = _l < _tv ? *(const v4u*)(B.ZG + (_R0 + _l) * 4096 + xcol + _c8) : zero4; } } while (0)
#define SC_LOAD_CB(c, nh) do { const int _tv = SC_TV(c); const size_t _R0 = (size_t)rowbase + (size_t)(c) * 64; _Pragma("unroll") for (int _i = 0; _i < 4; ++_i) { const int _id = tt + 256 * _i, _row = _id >> 4, _oct = _id & 15; \
        rCB[nh][_i] = _row < _tv ? *(const v4u*)(cbsrc + (_R0 + _row) * cbp + (nh) * 128 + _oct * 8) : zero4; } } while (0)
#define SC_LOAD_DT(c) do { if (SSD && wid == 0) rdt = lane < SC_TV(c) ? DTL[(c) * 64 + lane] : 0.f; } while (0)
#define SC_CUM(c) do { if (wid == 0) { LAS float* _cb = CUMB + ((c) & 1) * 320; const float _la = SSD ? rdt * a_h : (lane < SC_TV(c) ? lgam : 0.f); float _cum = _la; \
        _Pragma("unroll") for (int _o = 1; _o < 64; _o <<= 1) { const float _t = __shfl_up(_cum, _o); if (lane >= _o) _cum += _t; } \
        const float _last = __shfl(_cum, 63); _cb[lane] = _cum; _cb[64 + lane] = __expf(_cum); _cb[128 + lane] = __expf(_last - _cum); _cb[192 + lane] = rdt; if (lane == 0) _cb[256] = __expf(_last); } } while (0)
#define SC_STAGE(c, nh) do { const LAS float* _cb = CUMB + ((c) & 1) * 320; \
        if ((nh) == 0 && tid < 256) { const int _l = tid >> 2, _c8 = (tid & 3) * 8; const float _dtl = SSD ? _cb[192 + _l] : 1.f, _wdl = _cb[128 + _l]; \
            const float _x[8] = {bflo(rX.x), bfhi(rX.x), bflo(rX.y), bfhi(rX.y), bflo(rX.z), bfhi(rX.z), bflo(rX.w), bfhi(rX.w)}; \
            float _X[8], _W[8]; _Pragma("unroll") for (int _i = 0; _i < 8; ++_i) { _X[_i] = _x[_i] * _dtl; _W[_i] = _X[_i] * _wdl; if (SSD) XSF[_l * 32 + _c8 + _i] = _x[_i]; } \
            { v4u _q; _q.x = pk2(_X[0], _X[1]); _q.y = pk2(_X[2], _X[3]); _q.z = pk2(_X[4], _X[5]); _q.w = pk2(_X[6], _X[7]); *(LAS v4u*)(XT + v_st32(_l, _c8)) = _q; \
              _q.x = pk2(_W[0], _W[1]); _q.y = pk2(_W[2], _W[3]); _q.z = pk2(_W[4], _W[5]); _q.w = pk2(_W[6], _W[7]); *(LAS v4u*)(XW + v_st32(_l, _c8)) = _q; } \
            if (SSD) { LAS float* _zs = ZS + _l * 32 + _c8; _zs[0] = bflo(rZ.x); _zs[1] = bfhi(rZ.x); _zs[2] = bflo(rZ.y); _zs[3] = bfhi(rZ.y); _zs[4] = bflo(rZ.z); _zs[5] = bfhi(rZ.z); _zs[6] = bflo(rZ.w); _zs[7] = bfhi(rZ.w); } } \
        { LAS unsigned char* _dst = isB ? BS : CS; \
          _Pragma("unroll") for (int _i = 0; _i < 4; ++_i) { const int _id = tt + 256 * _i, _row = _id >> 4, _oct = _id & 15; const v4u _w = rCB[nh][_i]; \
            *(LAS v4u*)(_dst + (_row * PC + _oct * 8) * 2) = _w; \
            if (isB) *(LAS v4u*)(BV + att::v_st(_row, _oct * 8)) = _w; } } \
        if ((c) + 1 < nchunks && (nh) == NH - 1) { SC_LOAD_X((c) + 1); _Pragma("unroll") for (int _hh = 0; _hh < NH; ++_hh) SC_LOAD_CB((c) + 1, _hh); } } while (0)

    if (SSD) { const int nrows = (nchunks - 1) * 64 + tv_last; for (int i = tid; i < nrows; i += 512) DTL[i] = B.DT[((size_t)rowbase + i) * 32 + h]; }
    __syncthreads();
    SC_LOAD_DT(0); SC_LOAD_X(0);
#pragma unroll
    for (int nh = 0; nh < NH; ++nh) SC_LOAD_CB(0, nh);
    if (has_state) {
        if (h0 != nullptr) {
#pragma unroll
            for (int q = 0; q < 4; ++q) { const f32x4 v = *(const f32x4*)(h0 + (size_t)(n0 + r32) * PF + sl * 32 + 8 * q + 4 * hi);
                hacc[4 * q + 0] = v[0]; hacc[4 * q + 1] = v[1]; hacc[4 * q + 2] = v[2]; hacc[4 * q + 3] = v[3]; }
        }
#pragma unroll
        for (int r = 0; r < 16; ++r) *(LAS bf16*)(HT + (att::crow(r, hi) * PHT + n0 + r32) * 2) = (bf16)f2bf(hacc[r]);
    }
    SC_CUM(0); if (nchunks > 1) SC_LOAD_DT(1);
    SC_SYNC();
    SC_STAGE(0, 0);
    for (int c = 0; c < nchunks; ++c) {
        const int R0 = rowbase + c * 64, tv = SC_TV(c);
        const LAS float* cb = CUMB + (c & 1) * 320;
#pragma unroll
        for (int nh = 0; nh < NH; ++nh) {
            if (nh > 0) { SC_SYNC(); SC_STAGE(c, nh); }
            SC_SYNC();
            if (wid < 4) {
                const int ti = wid >> 1, tj = wid & 1;
#pragma unroll
                for (int kb = 0; kb < 2; ++kb) { bf16x8 fa[4], fb[4];
#pragma unroll
                    for (int q = 0; q < 4; ++q) { const int k0 = 16 * (4 * kb + q) + 8 * hi; fa[q] = frag(CS, PC, 32 * ti + r32, k0); fb[q] = frag(BS, PC, 32 * tj + r32, k0); }
                    asm volatile("s_waitcnt lgkmcnt(0)" ::: "memory"); __builtin_amdgcn_sched_barrier(0);
#pragma unroll
                    for (int q = 0; q < 4; ++q) gacc = __builtin_amdgcn_mfma_f32_32x32x16_bf16(fa[q], fb[q], gacc, 0, 0, 0); }
            } else if (wid < 6) {
                const int ti = wid - 4;
#pragma unroll
                for (int kb = 0; kb < 2; ++kb) { bf16x8 fa[4], fb[4];
#pragma unroll
                    for (int q = 0; q < 4; ++q) { const int k0 = 16 * (4 * kb + q) + 8 * hi; fa[q] = frag(CS, PC, 32 * ti + r32, k0); fb[q] = frag(HT, PHT, r32, nh * 128 + k0); }
                    asm volatile("s_waitcnt lgkmcnt(0)" ::: "memory"); __builtin_amdgcn_sched_barrier(0);
#pragma unroll
                    for (int q = 0; q < 4; ++q) gacc = __builtin_amdgcn_mfma_f32_32x32x16_bf16(fa[q], fb[q], gacc, 0, 0, 0); }
            }
            if (has_state && (wid >> 2) == nh) {
                const float el = cb[256];
#pragma unroll
                for (int r = 0; r < 16; ++r) hacc[r] *= el;
                { const int xwb = (int)(unsigned)(uintptr_t)XW + att::v_rd_base(lane), bvb = (int)(unsigned)(uintptr_t)BV + att::v_rd_base(lane) + (wid & 3) * 512;
                  TRKL(0); TRKL(1); TRKL(2); TRKL(3);
                  asm volatile("s_waitcnt lgkmcnt(0)" ::: "memory"); __builtin_amdgcn_sched_barrier(0);
                  TRKM(0); TRKM(1); TRKM(2); TRKM(3); }
            }
        }
        if (wid < 4) { const int ti = wid >> 1, tj = wid & 1, s = 32 * tj + r32; const float cs = cb[s];
#pragma unroll
            for (int q = 0; q < 4; ++q) { const f32x4 cl4 = *(const LAS f32x4*)(cb + 32 * ti + 8 * q + 4 * hi);
#pragma unroll
                for (int e = 0; e < 4; ++e) { const int r = 4 * q + e, l = 32 * ti + att::crow(r, hi);
                    const float ex = __expf(fminf(cl4[e] - cs, 0.f)); const float v = l >= s ? gacc[r] * ex : 0.f;
                    *(LAS bf16*)(GS + (l * PT + s) * 2) = (bf16)f2bf(v); gacc[r] = 0.f; } } }
        SC_SYNC();
        if (wid >= 4 && wid < 6) { const int ti = wid - 4;
#pragma unroll
            for (int q = 0; q < 4; ++q) { const f32x4 e4 = *(const LAS f32x4*)(cb + 64 + 32 * ti + 8 * q + 4 * hi);
                gacc[4 * q + 0] *= e4[0]; gacc[4 * q + 1] *= e4[1]; gacc[4 * q + 2] *= e4[2]; gacc[4 * q + 3] *= e4[3]; }
            { const int xtb = (int)(unsigned)(uintptr_t)XT + att::v_rd_base(lane);
              TRYL(0); TRYL(1); TRYL(2); TRYL(3);
              asm volatile("s_waitcnt lgkmcnt(0)" ::: "memory"); __builtin_amdgcn_sched_barrier(0);
              TRYM(0); TRYM(1); TRYM(2); TRYM(3); }
            float xs_[16], zs_[16];
            if (SSD) {
#pragma unroll
                for (int r = 0; r < 16; ++r) { const int l = 32 * ti + att::crow(r, hi); xs_[r] = XSF[l * 32 + r32]; zs_[r] = ZS[l * 32 + r32]; } }
#pragma unroll
            for (int r = 0; r < 16; ++r) { const int l = 32 * ti + att::crow(r, hi); float y = gacc[r];
                if (SSD) y = (y + dsk * xs_[r]) * silu_f(zs_[r]);
                YS[l * 33 + r32] = y; gacc[r] = 0.f; } }
        if (has_state) {
#pragma unroll
            for (int r = 0; r < 16; ++r) *(LAS bf16*)(HT + (att::crow(r, hi) * PHT + n0 + r32) * 2) = (bf16)f2bf(hacc[r]); }
        if (c + 1 < nchunks) { SC_CUM(c + 1); if (c + 2 < nchunks) SC_LOAD_DT(c + 2); }
        SC_SYNC();
        if (c + 1 < nchunks) SC_STAGE(c + 1, 0);
        { const int l = tid >> 3, p4 = (tid & 7) * 4; float v[4]; float ss = 0.f;
#pragma unroll
          for (int i = 0; i < 4; ++i) { v[i] = YS[l * 33 + p4 + i]; ss += v[i] * v[i]; }
          ss += __shfl_xor(ss, 1); ss += __shfl_xor(ss, 2); ss += __shfl_xor(ss, 4);
          if (l < tv) {
              v2u w; w.x = pk2(v[0], v[1]); w.y = pk2(v[2], v[3]);
              *(v2u*)(B.T1 + (size_t)(R0 + l) * 4096 + xcol + p4) = w;
              if ((tid & 7) == 0) { if (SSD) B.SSQG[(size_t)(R0 + l) * 64 + g * 16 + (h & 7) * 2 + sl] = ss; else B.SSQH[(size_t)(R0 + l) * 64 + h * 8 + sl] = ss; }
          } }
    }
    if (has_state) {
#pragma unroll
        for (int q = 0; q < 4; ++q) { f32x4 v; v[0] = hacc[4 * q + 0]; v[1] = hacc[4 * q + 1]; v[2] = hacc[4 * q + 2]; v[3] = hacc[4 * q + 3];
            *(f32x4*)(hout + (size_t)(n0 + r32) * PF + sl * 32 + 8 * q + 4 * hi) = v; }
    }
    __syncthreads();
#undef SC_SYNC
#undef SC_TV
#undef SC_LOAD_X
#undef SC_LOAD_CB
#undef SC_LOAD_DT
#undef SC_CUM
#undef SC_STAGE
}
}

constexpr int N_PHASES = 37;
constexpr size_t S_HB = S_L0END;
static_assert(S_HB + (size_t)512 * 3 * 3072 * 2 <= S_MAX || true, "");
static_assert(O_SCR + S_HB + (size_t)512 * 3 * 3072 * 2 <= (size_t)1476395008, "halo buffer inside the workspace");

struct Ctx { LAS unsigned char* lds; unsigned char* ws; float* out; int G, wg, wave; };
#define CTX_GW() const int gw = C.wg * NWAVES + C.wave, NGW = C.G * NWAVES
#define CTX_GT() const size_t gt = (size_t)C.wg * (NWAVES * 64) + C.wave * 64 + lane_id(), NGT = (size_t)C.G * (NWAVES * 64)
#define W_SSQ ((u64*)(C.ws + O_SSQ))
#define W_XB ((bf16*)(C.ws + O_XB))
#define W_X (C.out + OUT_Y)
#define W_SCR (C.ws + O_SCR)

__device__ __forceinline__ void ph_prologue(const Ctx& C, const Params& P) {
    CTX_GW(); CTX_GT(); unsigned char* ws = C.ws; const int lane = lane_id();
    LAS float* wscr = (LAS float*)(C.lds + C.wave * 16384);
#pragma unroll 1
    for (int lf = 0; lf < 4; ++lf) {
        const int l = lf >> 1, f = lf & 1;
        cvt_weight(P.in[I_W1] + (size_t)lf * D * 2 * DFF, D, 2 * DFF, P.in[I_NORMS] + (l * 4 + (f ? 3 : 0)) * D, D, (bf16*)(ws + O_W1 + lf * SZ_W1), 2 * DFF, SmW1{}, wscr, gw, NGW, lane);
        cvt_weight(P.in[I_W2] + (size_t)lf * DFF * D, DFF, D, nullptr, 0, (bf16*)(ws + O_W2 + lf * SZ_W2), D, SmId{D}, wscr, gw, NGW, lane);
    }
    cvt_weight(P.in[I_ABWIN], D, 13344, P.in[I_NORMS] + 1 * D, D, (bf16*)(ws + O_WIN), WIN_N, SmWin{}, wscr, gw, NGW, lane);
    cvt_weight(P.in[I_ABWOUT], 4096, D, P.in[I_SSDN], 2048, (bf16*)(ws + O_WOUT), D, SmId{D}, wscr, gw, NGW, lane);
    cvt_weight(P.in[I_CWIN], D, 1088, P.in[I_NORMS] + (4 + 1) * D, D, (bf16*)(ws + O_CWIN), CWIN_N, SmId{1088}, wscr, gw, NGW, lane);
    cvt_weight(P.in[I_WUQ], 512, 3072, nullptr, 0, (bf16*)(ws + O_WUQ), 3072, SmUq{}, wscr, gw, NGW, lane);
    cvt_weight(P.in[I_WUK], 512, 2048, nullptr, 0, (bf16*)(ws + O_WKV), 2048, SmId{2048}, wscr, gw, NGW, lane);
    cvt_weight(P.in[I_WUV], 512, 2048, nullptr, 0, (bf16*)(ws + O_WKV) + (size_t)2048 * 512, 2048, SmId{2048}, wscr, gw, NGW, lane);
    cvt_weight(P.in[I_CWOUT], D, D, nullptr, 0, (bf16*)(ws + O_CWOUT), D, SmId{D}, wscr, gw, NGW, lane);
#pragma unroll 1
    for (int l = 0; l < 2; ++l) {
        cvt_weight(P.in[I_WMQ] + (size_t)l * D * 512, D, 512, P.in[I_NORMS] + (l * 4 + 2) * D, D, (bf16*)(ws + O_WMQ) + (size_t)l * 512 * D, 512, SmId{512}, wscr, gw, NGW, lane);
        cvt_weight(P.in[I_WMKV] + (size_t)l * D * 1024, D, 1024, P.in[I_MNORM] + l * D, D, (bf16*)(ws + O_WMKV) + (size_t)l * 1024 * D, 1024, SmId{1024}, wscr, gw, NGW, lane);
        cvt_weight(P.in[I_WMO] + (size_t)l * 512 * D, 512, D, nullptr, 0, (bf16*)(ws + O_WMO) + (size_t)l * D * 512, D, SmId{D}, wscr, gw, NGW, lane);
    }
    u64* SSQ = W_SSQ; bf16* XB = W_XB;
    for (int row = gw; row < M; row += NGW) {
        const float* src = row < MP ? P.in[I_XP] + (size_t)row * D : P.in[I_XS] + (size_t)(row - MP) * D;
        const float ss = row_to_bf16(src, XB + (size_t)row * XBP, lane);
        if (lane == 0) SSQ[row] = ssq_fix(ss);
    }
    { bf16* MB = (bf16*)(ws + O_MB); float* SSQM = (float*)(ws + O_SSQM);
      for (int row = gw; row < 1024; row += NGW) { const float ss = row_to_bf16(P.in[I_MEM] + (size_t)row * D, MB + (size_t)row * D, lane); if (lane == 0) SSQM[row] = ss; } }
    { float* COSR = (float*)(ws + O_COSR); float* SINR = (float*)(ws + O_SINR); float* COSM = (float*)(ws + O_COSM); float* SINM = (float*)(ws + O_SINM);
      for (size_t i = gt; i < (size_t)8192 * 160; i += NGT) {
        const int pos = (int)(i / 160), j = (int)(i % 160);
        const double inv = j < 128 ? INV_R[j] : INV_M[j - 128];
        const double t = (double)pos * inv * 0.15915494309189533577; const float fr = (float)(t - floor(t));
        const float sv = __builtin_amdgcn_sinf(fr), cv = __builtin_amdgcn_cosf(fr);
        if (j < 128) { COSR[(size_t)pos * 128 + j] = cv; SINR[(size_t)pos * 128 + j] = sv; } else { COSM[(size_t)pos * 32 + j - 128] = cv; SINM[(size_t)pos * 32 + j - 128] = sv; }
      } }
}

__device__ __forceinline__ void ph_w1(const Ctx& C, int lf) {
    const int L = lf >> 1, F = lf & 1;
    pg8::Gemm g{W_XB, (const bf16*)(C.ws + O_W1 + (size_t)lf * SZ_W1), M, 2 * DFF, D, XBP, D}; pg8::StaticOrder S = make_order(M, 2 * DFF, C.G, C.wg, 0);
    EpiSwiglu E{(bf16*)(W_SCR + S_H), W_SSQ + (size_t)(L * 4 + (F ? 3 : 0)) * M, C.lds};
    pg8::gemm_phase<EpiSwiglu, pg8::StaticOrder, true, true>(C.lds, g, S, E, C.wave);
    if (lf == 0) {
#pragma unroll 1
        for (int ml = 0; ml < 2; ++ml) {
            pg8::Gemm g2{(const bf16*)(C.ws + O_MB), (const bf16*)(C.ws + O_WMKV) + (size_t)ml * 1024 * D, 1024, 1024, D, D, D};
            pg8::StaticOrder S2 = make_order(1024, 1024, C.G, C.wg, (130 * 44) % 256 + 16 * ml);
            EpiMemKV E2{C.out + OUT_MEMK + (size_t)ml * 1024 * 512, C.out + OUT_MEMV + (size_t)ml * 1024 * 512, (bf16*)(C.ws + O_MKV) + (size_t)ml * 1024 * 1024, (const float*)(C.ws + O_SSQM)};
            pg8::gemm_phase<EpiMemKV, pg8::StaticOrder, true, true>(C.lds, g2, S2, E2, C.wave);
        }
    }
}

constexpr size_t S_PART_FFN = (size_t)384 << 20;
template <int KS, bool FIRST> __device__ __forceinline__ void res_gemm(const Ctx& C, const bf16* A, int lda, const bf16* Bt, int K, const float* src32, float alpha, u64* ssq_next, float* part) {
    { pg8::Gemm g{A, Bt, MP, D, K, lda, K}; pg8::StaticOrder S = make_order(MP, D, C.G, C.wg, 0);
      EpiRes<FIRST> E{src32, W_XB, ssq_next, alpha};
      pg8::gemm_phase<EpiRes<FIRST>, pg8::StaticOrder, true, true>(C.lds, g, S, E, C.wave); }
    { pg8::Gemm g{A + (size_t)MP * lda, Bt, MS, D, K, lda, K / KS}; SplitOrder S; S.init(MS, D, KS, C.G, C.wg);
      EpiPart E{part, D, (size_t)MS * D};
      pg8::gemm_phase<EpiPart, SplitOrder, true, true>(C.lds, g, S, E, C.wave); }
}
template <bool FIRST> __device__ __forceinline__ void ph_fin(const Ctx& C, const float* part, int KS, const float* src32, float alpha, u64* ssq_next) {
    CTX_GW(); const int lane = lane_id(); bf16* XB = W_XB;
    for (int it = gw; it < MS * 8; it += NGW) {
        const int r = it >> 3, c = (it & 7) * 256 + 4 * lane; const size_t o = (size_t)r * D + c;
        f32x4 a = *(const f32x4*)(part + o);
        for (int k = 1; k < KS; ++k) a += *(const f32x4*)(part + (size_t)k * MS * D + o);
        f32x4 s;
        if constexpr (FIRST) s = *(const f32x4*)(src32 + o); else { const v2u q = *(const v2u*)(XB + (size_t)(MP + r) * XBP + c); s = (f32x4){bflo(q.x), bfhi(q.x), bflo(q.y), bfhi(q.y)}; }
        const f32x4 v = s + a * alpha;
        v2u w; w.x = pk2(v[0], v[1]); w.y = pk2(v[2], v[3]); *(v2u*)(XB + (size_t)(MP + r) * XBP + c) = w;
        const float ss = wave_sum((v[0] * v[0] + v[1] * v[1]) + (v[2] * v[2] + v[3] * v[3]));
        if (lane == 0) ssq_add(ssq_next + MP + r, ss);
    }
}
template <bool FIRST> __device__ __forceinline__ void ph_w2(const Ctx& C, const Params& P, int lf) {
    const int L = lf >> 1, F = lf & 1;
    res_gemm<11, FIRST>(C, (const bf16*)(W_SCR + S_H), DFF, (const bf16*)(C.ws + O_W2 + (size_t)lf * SZ_W2), DFF, P.in[I_XP], 0.5f, W_SSQ + (size_t)(L * 4 + (F ? 4 : 1)) * M, (float*)(W_SCR + S_PART_FFN));
}
template <bool FIRST> __device__ __forceinline__ void ph_w2fin(const Ctx& C, const Params& P, int lf) {
    const int L = lf >> 1, F = lf & 1;
    ph_fin<FIRST>(C, (const float*)(W_SCR + S_PART_FFN), 11, P.in[I_XS], 0.5f, W_SSQ + (size_t)(L * 4 + (F ? 4 : 1)) * M);
}
__device__ __forceinline__ void ph_win(const Ctx& C, const Params& P) {
    pg8::Gemm g{W_XB, (const bf16*)(C.ws + O_WIN), M, WIN_N, D, XBP, D}; pg8::StaticOrder S = make_order(M, WIN_N, C.G, C.wg, 0);
    EpiWin E{(bf16*)(W_SCR + S_T1), (bf16*)(W_SCR + S_ZG), (bf16*)(W_SCR + S_QK), (bf16*)(W_SCR + S_BC), (float*)(W_SCR + S_DT), W_SSQ + (size_t)1 * M,
             (const float*)(C.ws + O_COSR), (const float*)(C.ws + O_SINR), P.in[I_DTB], C.lds};
    pg8::gemm_phase<EpiWin, pg8::StaticOrder, true, true>(C.lds, g, S, E, C.wave);
}
__device__ __forceinline__ const bf16* xbc_ptr(const bf16* T1, const bf16* BC, size_t row, int ch) { return ch < 2048 ? T1 + row * 4096 + ch : BC + row * 1024 + (ch - 2048); }
__device__ __forceinline__ void ph_halo(const Ctx& C) {
    CTX_GT(); const bf16* T1 = (const bf16*)(W_SCR + S_T1); const bf16* BC = (const bf16*)(W_SCR + S_BC); bf16* HB = (bf16*)(W_SCR + S_HB);
    for (size_t i = gt; i < (size_t)NBP * 128 * 3 * 384; i += NGT) {
        const int oct = (int)(i % 384), j = (int)((i / 384) % 3), cc = (int)(i / 1152), c = cc & 127, b = cc >> 7;
        if (c == 0) continue;
        const size_t row = (size_t)b * SEQ + c * 64 - 3 + j;
        *(v4u*)(HB + ((size_t)cc * 3 + j) * 3072 + oct * 8) = *(const v4u*)xbc_ptr(T1, BC, row, oct * 8);
    }
    for (size_t i = gt; i < (size_t)(NBP + NBS) * 3 * 384; i += NGT) {
        const int oct = (int)(i % 384), j = (int)((i / 384) % 3), b = (int)(i / 1152);
        const size_t row = b < NBP ? (size_t)b * SEQ + SEQ - 3 + j : (size_t)MP + (b - NBP) * TS + TS - 3 + j;
        float* o = b < NBP ? C.out + OUT_CONVP + (size_t)(b * 3 + j) * 3072 + oct * 8 : C.out + OUT_CONVS + (size_t)((b - NBP) * 3 + j) * 3072 + oct * 8;
        const v4u w = *(const v4u*)xbc_ptr(T1, BC, row, oct * 8);
        *(f32x4*)o = (f32x4){bflo(w.x), bfhi(w.x), bflo(w.y), bfhi(w.y)}; *(f32x4*)(o + 4) = (f32x4){bflo(w.z), bfhi(w.z), bflo(w.w), bfhi(w.w)};
    }
}
__device__ __forceinline__ void ph_conv(const Ctx& C, const Params& P) {
    CTX_GT(); bf16* T1 = (bf16*)(W_SCR + S_T1); bf16* BC = (bf16*)(W_SCR + S_BC); const bf16* HB = (const bf16*)(W_SCR + S_HB);
    const float* cwp = P.in[I_CONVW]; const float* cbp = P.in[I_CONVB]; const float* cst = P.in[I_SCONV];
    { float* DT = (float*)(W_SCR + S_DT); const float* dtb = P.in[I_DTB];
      for (size_t i = gt; i < (size_t)M * 32; i += NGT) { const float x = DT[i] + dtb[i & 31]; DT[i] = x > 20.f ? x : log1pf(__expf(x)); } }
    for (size_t i = gt; i < (size_t)(NBP * 128 + NBS) * 384; i += NGT) {
        const int oct = (int)(i % 384), cc = (int)(i / 384), ch = oct * 8;
        float w0[8], w1[8], w2[8], cw[4][8], cb[8];
#pragma unroll
        for (int e = 0; e < 8; ++e) { cb[e] = cbp[ch + e];
#pragma unroll
            for (int j = 0; j < 4; ++j) cw[j][e] = cwp[j * 3072 + ch + e]; }
        size_t row0; int nrows;
        if (cc < NBP * 128) { const int c = cc & 127, b = cc >> 7; row0 = (size_t)b * SEQ + c * 64; nrows = 64;
            if (c == 0) {
#pragma unroll
                for (int e = 0; e < 8; ++e) { w0[e] = 0.f; w1[e] = 0.f; w2[e] = 0.f; }
            } else { const bf16* hb = HB + (size_t)cc * 3 * 3072 + ch; const v4u a = *(const v4u*)hb, b2 = *(const v4u*)(hb + 3072), c2 = *(const v4u*)(hb + 6144);
                w0[0] = bflo(a.x); w0[1] = bfhi(a.x); w0[2] = bflo(a.y); w0[3] = bfhi(a.y); w0[4] = bflo(a.z); w0[5] = bfhi(a.z); w0[6] = bflo(a.w); w0[7] = bfhi(a.w);
                w1[0] = bflo(b2.x); w1[1] = bfhi(b2.x); w1[2] = bflo(b2.y); w1[3] = bfhi(b2.y); w1[4] = bflo(b2.z); w1[5] = bfhi(b2.z); w1[6] = bflo(b2.w); w1[7] = bfhi(b2.w);
                w2[0] = bflo(c2.x); w2[1] = bfhi(c2.x); w2[2] = bflo(c2.y); w2[3] = bfhi(c2.y); w2[4] = bflo(c2.z); w2[5] = bfhi(c2.z); w2[6] = bflo(c2.w); w2[7] = bfhi(c2.w); }
        } else { const int b = cc - NBP * 128; row0 = (size_t)MP + b * TS; nrows = TS; const float* s = cst + (size_t)b * 3 * 3072 + ch;
#pragma unroll
            for (int e = 0; e < 8; ++e) { w0[e] = s[e]; w1[e] = s[3072 + e]; w2[e] = s[6144 + e]; } }
        bf16* p = (bf16*)xbc_ptr(T1, BC, row0, ch); const size_t pitch = ch < 2048 ? 4096 : 1024;
        for (int r0 = 0; r0 < nrows; r0 += 8) {
            v4u wr[8];
#pragma unroll
            for (int q = 0; q < 8; ++q) wr[q] = *(const v4u*)(p + (size_t)(r0 + q) * pitch);
#pragma unroll
            for (int q = 0; q < 8; ++q) { const v4u w = wr[q];
                const float cur[8] = {bflo(w.x), bfhi(w.x), bflo(w.y), bfhi(w.y), bflo(w.z), bfhi(w.z), bflo(w.w), bfhi(w.w)}; float o[8];
#pragma unroll
                for (int e = 0; e < 8; ++e) { o[e] = silu_f(cb[e] + cw[0][e] * w0[e] + cw[1][e] * w1[e] + cw[2][e] * w2[e] + cw[3][e] * cur[e]); w0[e] = w1[e]; w1[e] = w2[e]; w2[e] = cur[e]; }
                v4u qo; qo.x = pk2(o[0], o[1]); qo.y = pk2(o[2], o[3]); qo.z = pk2(o[4], o[5]); qo.w = pk2(o[6], o[7]);
                *(v4u*)(p + (size_t)(r0 + q) * pitch) = qo; }
        }
    }
}
__device__ __forceinline__ void ph_scan(const Ctx& C, const Params& P) {
    scan::Bufs B{(bf16*)(W_SCR + S_T1), (bf16*)(W_SCR + S_ZG), (bf16*)(W_SCR + S_QK), (bf16*)(W_SCR + S_BC), (const float*)(W_SCR + S_DT), (float*)(C.ws + O_SSQG), (float*)(C.ws + O_SSQH), P.in[I_ALOG], P.in[I_DSKIP]};
    float* out = C.out;
#pragma unroll 1
    for (int u = C.wg; u < 256 + 2048; u += C.G) {
        const bool pr = u < 256; const int v = pr ? u : u - 256, w = v & 255, bg = (v >> 8) * 16 + (w & 7) * 2 + (w >> 7), j = (w >> 3) & 15, b = bg >> 2, h = (bg & 3) * 8 + (j >> 1), sl = j & 1;
        const size_t so = (size_t)(b * 32 + h) * 128 * 64;
        scan::scan_unit<true>(C.lds, B, pr ? b * SEQ : MP + b * TS, pr ? SEQ / 64 : 1, pr ? 64 : TS, h, sl, pr ? nullptr : P.in[I_SSSD] + so, pr ? out + OUT_SSDP + so : out + OUT_SSDS + so, C.wave);
    }
#pragma unroll 1
    for (int u = C.wg; u < 256 + 2048; u += C.G) {
        const bool pr = u < 256; const int v = pr ? u : u - 256, w = v & 255, bh = (v >> 8) * 32 + (w & 7) * 4 + (w >> 6), b = bh >> 3, h = bh & 7, sl = (w >> 3) & 7;
        const size_t so = (size_t)(b * 8 + h) * 256 * 256;
        scan::scan_unit<false>(C.lds, B, pr ? b * SEQ : MP + b * TS, pr ? SEQ / 64 : 1, pr ? 64 : TS, h, sl, pr ? nullptr : P.in[I_SRET] + so, pr ? out + OUT_RETP + so : out + OUT_RETS + so, C.wave);
    }
}
__device__ __forceinline__ void ph_norm(const Ctx& C) {
    CTX_GW(); bf16* T1 = (bf16*)(W_SCR + S_T1); const bf16* ZG = (const bf16*)(W_SCR + S_ZG); const float* SSQG = (const float*)(C.ws + O_SSQG); const float* SSQH = (const float*)(C.ws + O_SSQH);
    const int lane = lane_id();
    for (int row = gw; row < M; row += NGW) {
        v4u w[8], gq[4]; float sc[8];
#pragma unroll
        for (int k = 0; k < 8; ++k) w[k] = *(const v4u*)(T1 + (size_t)row * 4096 + (k * 64 + lane) * 8);
#pragma unroll
        for (int k = 0; k < 4; ++k) gq[k] = *(const v4u*)(ZG + (size_t)row * 4096 + ((k + 4) * 64 + lane) * 8);
#pragma unroll
        for (int k = 0; k < 4; ++k) {
            const float* pg = SSQG + (size_t)row * 64 + k * 16; const f32x4 a0 = *(const f32x4*)pg, a1 = *(const f32x4*)(pg + 4), a2 = *(const f32x4*)(pg + 8), a3 = *(const f32x4*)(pg + 12);
            const f32x4 t = (a0 + a1) + (a2 + a3); sc[k] = rsqrtf(((t[0] + t[1]) + (t[2] + t[3])) * (1.0f / 512.f) + EPS);
            const float* ph = SSQH + (size_t)row * 64 + ((((k + 4) * 64 + lane) * 8 - 2048) >> 8) * 8; const f32x4 b0 = *(const f32x4*)ph, b1 = *(const f32x4*)(ph + 4);
            const f32x4 u = b0 + b1; sc[k + 4] = rsqrtf(((u[0] + u[1]) + (u[2] + u[3])) * (1.0f / 256.f) + EPS); }
#pragma unroll
        for (int k = 0; k < 8; ++k) {
            float x[8] = {bflo(w[k].x), bfhi(w[k].x), bflo(w[k].y), bfhi(w[k].y), bflo(w[k].z), bfhi(w[k].z), bflo(w[k].w), bfhi(w[k].w)};
            if (k < 4) {
#pragma unroll
                for (int i = 0; i < 8; ++i) x[i] *= sc[k];
            } else { const v4u q = gq[k - 4]; const float gv[8] = {bflo(q.x), bfhi(q.x), bflo(q.y), bfhi(q.y), bflo(q.z), bfhi(q.z), bflo(q.w), bfhi(q.w)};
#pragma unroll
                for (int i = 0; i < 8; ++i) x[i] = x[i] * sc[k] * silu_f(gv[i]); }
            v4u o; o.x = pk2(x[0], x[1]); o.y = pk2(x[2], x[3]); o.z = pk2(x[4], x[5]); o.w = pk2(x[6], x[7]);
            *(v4u*)(T1 + (size_t)row * 4096 + (k * 64 + lane) * 8) = o;
        }
    }
}
__device__ __forceinline__ void ph_wout(const Ctx& C) { res_gemm<16, false>(C, (const bf16*)(W_SCR + S_T1), 4096, (const bf16*)(C.ws + O_WOUT), 4096, nullptr, 1.0f, W_SSQ + (size_t)2 * M, (float*)(W_SCR + S_ZG)); }
__device__ __forceinline__ void ph_woutfin(const Ctx& C) { ph_fin<false>(C, (const float*)(W_SCR + S_ZG), 16, nullptr, 1.0f, W_SSQ + (size_t)2 * M); }
constexpr float MLA_SC = 0.07216878364870322f, MEM_SC = 0.08838834764831845f, LOG2E = 1.4426950408889634f;
__device__ __forceinline__ void ph_cwin(const Ctx& C, const Params& P) {
    CTX_GT();
    cvt_bulk(P.in[I_CCKV], (bf16*)(W_SCR + S_CKVPAST), (size_t)65536 * 512 / 8, gt, NGT);
    cvt_bulk(P.in[I_CKPE], (bf16*)(W_SCR + S_KPEPAST), (size_t)65536 * 64 / 8, gt, NGT);
    pg8::Gemm g{W_XB, (const bf16*)(C.ws + O_CWIN), M, CWIN_N, D, XBP, D}; pg8::StaticOrder S = make_order(M, CWIN_N, C.G, C.wg, 0);
    EpiF32 E{(float*)(W_SCR + S_CIN), CWIN_N, W_SSQ + (size_t)5 * M};
    pg8::gemm_phase<EpiF32, pg8::StaticOrder, true, true>(C.lds, g, S, E, C.wave);
}
__device__ __forceinline__ void ph_nr(const Ctx& C, const Params& P) {
    CTX_GW(); const int lane = lane_id(); float* out = C.out;
    const float* CIN = (const float*)(W_SCR + S_CIN); bf16* CQN = (bf16*)(W_SCR + S_CQN); bf16* CKVB = (bf16*)(W_SCR + S_CKVB); bf16* KPEB = (bf16*)(W_SCR + S_KPEB);
    const float* COSM = (const float*)(C.ws + O_COSM); const float* SINM = (const float*)(C.ws + O_SINM);
    const float* qn = P.in[I_QNORM]; const float* kvn = P.in[I_KVNORM];
    for (int row = gw; row < M; row += NGW) {
        const float* ci = CIN + (size_t)row * CWIN_N;
        const f32x4 q0 = *(const f32x4*)(ci + lane * 8), q1 = *(const f32x4*)(ci + lane * 8 + 4);
        const f32x4 k0 = *(const f32x4*)(ci + 512 + lane * 8), k1 = *(const f32x4*)(ci + 512 + lane * 8 + 4);
        float sq = (q0[0] * q0[0] + q0[1] * q0[1]) + (q0[2] * q0[2] + q0[3] * q0[3]) + (q1[0] * q1[0] + q1[1] * q1[1]) + (q1[2] * q1[2] + q1[3] * q1[3]);
        float sk = (k0[0] * k0[0] + k0[1] * k0[1]) + (k0[2] * k0[2] + k0[3] * k0[3]) + (k1[0] * k1[0] + k1[1] * k1[1]) + (k1[2] * k1[2] + k1[3] * k1[3]);
        sq = wave_sum(sq); sk = wave_sum(sk);
        const float rq = rsqrtf(sq * (1.0f / 512.f) + EPS), rk = rsqrtf(sk * (1.0f / 512.f) + EPS);
        const f32x4 g0 = *(const f32x4*)(qn + lane * 8), g1 = *(const f32x4*)(qn + lane * 8 + 4), n0 = *(const f32x4*)(kvn + lane * 8), n1 = *(const f32x4*)(kvn + lane * 8 + 4);
        const f32x4 a0 = q0 * rq * g0, a1 = q1 * rq * g1, c0 = k0 * rk * n0, c1 = k1 * rk * n1;
        v4u w; w.x = pk2(a0[0], a0[1]); w.y = pk2(a0[2], a0[3]); w.z = pk2(a1[0], a1[1]); w.w = pk2(a1[2], a1[3]);
        *(v4u*)(CQN + (size_t)row * 512 + lane * 8) = w;
        v4u z; z.x = pk2(c0[0], c0[1]); z.y = pk2(c0[2], c0[3]); z.z = pk2(c1[0], c1[1]); z.w = pk2(c1[2], c1[3]);
        *(v4u*)(CKVB + (size_t)row * 512 + lane * 8) = z;
        float* co = row < MP ? out + OUT_CKVP + (size_t)row * 512 : out + OUT_CKVS + (size_t)(row - MP) * 512;
        *(f32x4*)(co + lane * 8) = c0; *(f32x4*)(co + lane * 8 + 4) = c1;
        if (lane < 32) {
            const int pos = pos_of_row(row); const float x1 = ci[1024 + lane], x2 = ci[1024 + 32 + lane];
            const float cv = COSM[(size_t)pos * 32 + lane], sv = SINM[(size_t)pos * 32 + lane];
            const float y1 = x1 * cv - x2 * sv, y2 = x2 * cv + x1 * sv;
            float* ko = row < MP ? out + OUT_KPEP + (size_t)row * 64 : out + OUT_KPES + (size_t)(row - MP) * 64;
            ko[lane] = y1; ko[32 + lane] = y2;
            KPEB[(size_t)row * 64 + lane] = (bf16)f2bf(y1); KPEB[(size_t)row * 64 + 32 + lane] = (bf16)f2bf(y2);
        }
    }
}
__device__ __forceinline__ void ph_uq(const Ctx& C) {
    bf16* CKVB = (bf16*)(W_SCR + S_CKVB);
    { pg8::Gemm g{(const bf16*)(W_SCR + S_CQN), (const bf16*)(C.ws + O_WUQ), M, 3072, 512, 512, 512}; pg8::StaticOrder S = make_order(M, 3072, C.G, C.wg, 0);
      EpiUq E{(bf16*)(W_SCR + S_QN), (bf16*)(W_SCR + S_QR), (const float*)(C.ws + O_COSM), (const float*)(C.ws + O_SINM)};
      pg8::gemm_phase<EpiUq, pg8::StaticOrder, true, true>(C.lds, g, S, E, C.wave); }
    { pg8::Gemm g{CKVB, (const bf16*)(C.ws + O_WKV), MP, 4096, 512, 512, 512}; pg8::StaticOrder S = make_order(MP, 4096, C.G, C.wg, (130 * 12) % 256);
      EpiPlain E{(bf16*)(W_SCR + S_KNV), 4096, nullptr};
      pg8::gemm_phase<EpiPlain, pg8::StaticOrder, true, true>(C.lds, g, S, E, C.wave); }
    { pg8::Gemm g{CKVB + (size_t)MP * 512, (const bf16*)(C.ws + O_WKV), MS, 4096, 512, 512, 512}; pg8::StaticOrder S = make_order(MS, 4096, C.G, C.wg, (130 * 12) % 256);
      EpiPlain E{(bf16*)(W_SCR + S_KNVN), 4096, nullptr};
      pg8::gemm_phase<EpiPlain, pg8::StaticOrder, true, true>(C.lds, g, S, E, C.wave); }
}
__device__ __forceinline__ void ph_attp(const Ctx& C) {
    const int wid = C.wave, r32 = lane_id() & 31, G = C.G, wg = C.wg;
    const bf16* KNV = (const bf16*)(W_SCR + S_KNV); const bf16* KPEB = (const bf16*)(W_SCR + S_KPEB); const bf16* QN = (const bf16*)(W_SCR + S_QN); const bf16* QR = (const bf16*)(W_SCR + S_QR);
    bf16* OB = (bf16*)(W_SCR + S_OB);
    const int nun = (G == 256) ? 8 : (2048 + G - 1) / G;
#pragma unroll 1
    for (int i = 0; i < nun; ++i) {
        int pr, qb;
        if (G == 256) { const int k4 = (wg >> 3) & 3; pr = (wg & 7) + 8 * (wg >> 5); qb = 4 * i + ((i & 1) ? 3 - k4 : k4); }
        else { const int u = wg + i * G; if (u >= 2048) break; pr = u >> 5; qb = u & 31; }
        const int b = pr >> 4, h = pr & 15;
        const int row = b * SEQ + qb * 256 + wid * 32 + r32;
        const bf16* kbase = KNV + (size_t)(b * SEQ) * 4096 + h * 128; const bf16* rbase = KPEB + (size_t)(b * SEQ) * 64;
        auto kn = [=](int k) -> const bf16* { return kbase + (size_t)k * 4096; };
        auto vv = [=](int k) -> const bf16* { return kbase + (size_t)k * 4096 + 2048; };
        auto kr = [=](int k) -> const bf16* { return rbase + (size_t)k * 64; };
        const int kmax = (qb * 4 + (wid >> 1) + 1) * 64;
        att::attn_unit<64, false, false>(C.lds, QN + (size_t)row * D + h * 128, QR + (size_t)row * 1024 + h * 64, kn, kr, vv, 4 * (qb + 1), kmax, MLA_SC * LOG2E, 8.0f / MLA_SC,
                           OB + (size_t)(b * SEQ + qb * 256 + wid * 32) * D + h * 128, D, 32, true, C.wave);
    }
}
__device__ __forceinline__ void ph_exp(const Ctx& C, int hb) {
    pg8::Gemm g{(const bf16*)(W_SCR + S_CKVPAST) + (size_t)hb * 32768 * 512, (const bf16*)(C.ws + O_WKV), 32768, 4096, 512, 512, 512}; pg8::StaticOrder S = make_order(32768, 4096, C.G, C.wg, 0);
    EpiPlain E{(bf16*)(W_SCR + S_KNV), 4096, nullptr};
    pg8::gemm_phase<EpiPlain, pg8::StaticOrder, true, true>(C.lds, g, S, E, C.wave);
}
__device__ __forceinline__ void ph_atts(const Ctx& C, int hb) {
    const int wid = C.wave, r32 = lane_id() & 31;
    const bf16* KNV = (const bf16*)(W_SCR + S_KNV); const bf16* KNVN = (const bf16*)(W_SCR + S_KNVN); const bf16* KPEB = (const bf16*)(W_SCR + S_KPEB); const bf16* KPEPAST = (const bf16*)(W_SCR + S_KPEPAST);
    const bf16* QN = (const bf16*)(W_SCR + S_QN); const bf16* QR = (const bf16*)(W_SCR + S_QR); bf16* OB = (bf16*)(W_SCR + S_OB);
#pragma unroll 1
    for (int u = C.wg; u < 256; u += C.G) {
        const int bl = u >> 4, h = u & 15, b = hb * 16 + bl;
        const int row = MP + b * TS + (r32 & 15);
        const bf16* pbase = KNV + (size_t)(bl * PAST) * 4096 + h * 128; const bf16* nbase = KNVN + (size_t)(b * TS) * 4096 + h * 128;
        const bf16* rpast = KPEPAST + (size_t)(b * PAST) * 64; const bf16* rnew = KPEB + (size_t)(MP + b * TS) * 64;
        auto kn = [=](int k) -> const bf16* { return k < PAST ? pbase + (size_t)k * 4096 : (k < PAST + TS ? nbase + (size_t)(k - PAST) * 4096 : nullptr); };
        auto vv = [=](int k) -> const bf16* { return k < PAST ? pbase + (size_t)k * 4096 + 2048 : (k < PAST + TS ? nbase + (size_t)(k - PAST) * 4096 + 2048 : nullptr); };
        auto kr = [=](int k) -> const bf16* { return k < PAST ? rpast + (size_t)k * 64 : (k < PAST + TS ? rnew + (size_t)(k - PAST) * 64 : nullptr); };
        att::attn_unit<64, false, true>(C.lds, QN + (size_t)row * D + h * 128, QR + (size_t)row * 1024 + h * 64, kn, kr, vv, 33, PAST + TS, MLA_SC * LOG2E, 8.0f / MLA_SC,
                           OB + (size_t)(MP + b * TS) * D + h * 128, D, 16, wid == 0, C.wave);
    }
}
__device__ __forceinline__ void ph_cwout(const Ctx& C) { res_gemm<8, false>(C, (const bf16*)(W_SCR + S_OB), D, (const bf16*)(C.ws + O_CWOUT), D, nullptr, 1.0f, W_SSQ + (size_t)6 * M, (float*)(W_SCR + S_KNV)); }
__device__ __forceinline__ void ph_cwoutfin(const Ctx& C) { ph_fin<false>(C, (const float*)(W_SCR + S_KNV), 8, nullptr, 1.0f, W_SSQ + (size_t)6 * M); }
__device__ __forceinline__ void ph_mq(const Ctx& C, const Params& P, int L) {
    CTX_GT();
    cvt_bulk(P.in[I_CMK] + (size_t)L * 32 * 256 * 512, (bf16*)(W_SCR + S_CMK), (size_t)32 * 256 * 512 / 8, gt, NGT);
    cvt_bulk(P.in[I_CMV] + (size_t)L * 32 * 256 * 512, (bf16*)(W_SCR + S_CMV), (size_t)32 * 256 * 512 / 8, gt, NGT);
    { pg8::Gemm g{W_XB, (const bf16*)(C.ws + O_WMQ) + (size_t)L * 512 * D, MP, 512, D, XBP, D}; pg8::StaticOrder S = make_order(MP, 512, C.G, C.wg, 0);
      EpiPlain E{(bf16*)(W_SCR + S_QM), 512, W_SSQ + (size_t)(L * 4 + 2) * M};
      pg8::gemm_phase<EpiPlain, pg8::StaticOrder, true, true>(C.lds, g, S, E, C.wave); }
    { pg8::Gemm g{W_XB + (size_t)MP * XBP, (const bf16*)(C.ws + O_WMQ) + (size_t)L * 512 * D, MS, 512, D, XBP, D / 8}; SplitOrder S; S.init(MS, 512, 8, C.G, C.wg);
      EpiPart E{(float*)(W_SCR + S_PARTQ), 512, (size_t)MS * 512};
      pg8::gemm_phase<EpiPart, SplitOrder, true, true>(C.lds, g, S, E, C.wave); }
}
__device__ __forceinline__ void ph_matt(const Ctx& C, int L) {
    const int wid = C.wave, r32 = lane_id() & 31;
    const bf16* QM = (const bf16*)(W_SCR + S_QM); bf16* OM = (bf16*)(W_SCR + S_OM); const bf16* CMK = (const bf16*)(W_SCR + S_CMK); const bf16* CMV = (const bf16*)(W_SCR + S_CMV);
    const bf16* MKV = (const bf16*)(C.ws + O_MKV);
    auto kr0 = [=](int) -> const bf16* { return nullptr; };
#pragma unroll 1
    for (int u = C.wg; u < 512 + 128; u += C.G) {
        const bool pr = u < 512; const int v = pr ? u : u - 512;
        const int b = pr ? v >> 7 : v >> 2, h = pr ? (v >> 5) & 3 : v & 3, qb = v & 31;
        const int row = pr ? b * SEQ + qb * 256 + wid * 32 + r32 : MP + b * TS + (r32 & 15);
        const bf16* kb_ = pr ? MKV + (size_t)(L * 1024 + b * 256) * 1024 + h * 128 : CMK + (size_t)(b * 256) * 512 + h * 128;
        const bf16* vb_ = pr ? kb_ + 512 : CMV + (size_t)(b * 256) * 512 + h * 128;
        const int kp = pr ? 1024 : 512;
        auto kn = [=](int k) -> const bf16* { return kb_ + (size_t)k * kp; };
        auto vv = [=](int k) -> const bf16* { return vb_ + (size_t)k * kp; };
        if (!pr) {
            const int t = wid * 64 + lane_id(), r = t >> 5, c4 = (t & 31) * 4; const size_t o = (size_t)(b * TS + r) * 512 + h * 128 + c4;
            const float* pq = (const float*)(W_SCR + S_PARTQ); f32x4 a = *(const f32x4*)(pq + o);
#pragma unroll
            for (int k = 1; k < 8; ++k) a += *(const f32x4*)(pq + (size_t)k * MS * 512 + o);
            const float rs = rsqrtf(ssq_get(W_SSQ + (size_t)(L * 4 + 2) * M + MP + b * TS + r) * (1.0f / D) + EPS);
            v2u w; w.x = pk2(a[0] * rs, a[1] * rs); w.y = pk2(a[2] * rs, a[3] * rs);
            *(v2u*)((bf16*)(W_SCR + S_QM) + (size_t)MP * 512 + o) = w;
            VM_WAIT(); __syncthreads();
        }
        att::attn_unit<0, false, false>(C.lds, QM + (size_t)row * 512 + h * 128, nullptr, kn, kr0, vv, 4, 256, MEM_SC * LOG2E, 8.0f / MEM_SC,
                          OM + (size_t)(pr ? b * SEQ + qb * 256 + wid * 32 : MP + b * TS) * 512 + h * 128, 512, pr ? 32 : 16, pr ? true : wid == 0, C.wave);
    }
}
__device__ __forceinline__ void ph_mo(const Ctx& C, int L) {
    pg8::Gemm g{(const bf16*)(W_SCR + S_OM), (const bf16*)(C.ws + O_WMO) + (size_t)L * D * 512, M, D, 512, 512, 512}; pg8::StaticOrder S = make_order(M, D, C.G, C.wg, 0);
    EpiRes<false> E{nullptr, W_XB, W_SSQ + (size_t)(L * 4 + 3) * M, 1.0f};
    pg8::gemm_phase<EpiRes<false>, pg8::StaticOrder, true, true>(C.lds, g, S, E, C.wave);
}
__device__ __forceinline__ void ph_final(const Ctx& C, const Params& P) {
    CTX_GW(); const int lane = lane_id(); float* Y = W_X; const bf16* XB = W_XB;
    const float* fn = P.in[I_FNORM]; const u64* sq = W_SSQ + (size_t)8 * M;
    for (int row = gw; row < M; row += NGW) {
        const float rs = rsqrtf(ssq_get(sq + row) * (1.0f / D) + EPS); float* yr = Y + (size_t)row * D; const bf16* xr = XB + (size_t)row * XBP;
        v4u q[4];
#pragma unroll
        for (int j = 0; j < 4; ++j) q[j] = *(const v4u*)(xr + 8 * (lane + 64 * j));
#pragma unroll
        for (int j = 0; j < 4; ++j) { const int c = 8 * (lane + 64 * j); const f32x4 g0 = *(const f32x4*)(fn + c), g1 = *(const f32x4*)(fn + c + 4);
            __builtin_nontemporal_store((f32x4){bflo(q[j].x), bfhi(q[j].x), bflo(q[j].y), bfhi(q[j].y)} * rs * g0, (f32x4*)(yr + c)); __builtin_nontemporal_store((f32x4){bflo(q[j].z), bfhi(q[j].z), bflo(q[j].w), bfhi(q[j].w)} * rs * g1, (f32x4*)(yr + c + 4)); }
    }
}

__global__ void __launch_bounds__(NWAVES * 64, 2) mk_fwd(Params P) {
    extern __shared__ __attribute__((aligned(16))) unsigned char lds_raw[];
    Ctx C; C.lds = (LAS unsigned char*)lds_raw; C.ws = P.ws; C.out = P.out; C.G = gridDim.x; C.wg = blockIdx.x; C.wave = __builtin_amdgcn_readfirstlane((int)threadIdx.x >> 6);
    volatile LAS unsigned* MISC = (volatile LAS unsigned*)(C.lds + MISC_OFF);
    for (int u = C.wave * 64 + lane_id(); u < (LDS_BYTES - MISC_OFF) / 4; u += NWAVES * 64) ((LAS unsigned*)(C.lds + MISC_OFF))[u] = 0u;
    __syncthreads();
    XcdBarrier bar = xcd_barrier_post((unsigned*)(P.ws + O_CTL) + 4096, MISC + 8, C.wave); bar.t0 = (C.wave == 0);
    const int lo = P.ph_lo, hi_ph = P.ph_hi;
#define RUN(k, call) do { if (lo <= (k) && (k) < hi_ph) { if ((k) > lo) xcd_barrier(bar); call; } } while (0)
    RUN(0, ph_prologue(C, P));
    RUN(1, ph_w1(C, 0));    RUN(2, ph_w2<true>(C, P, 0));    RUN(3, ph_w2fin<true>(C, P, 0));
    RUN(4, ph_win(C, P));   RUN(5, ph_halo(C));        RUN(6, ph_conv(C, P));     RUN(7, ph_scan(C, P));   RUN(8, ph_norm(C));   RUN(9, ph_wout(C));   RUN(10, ph_woutfin(C));
    RUN(11, ph_mq(C, P, 0));   RUN(12, ph_matt(C, 0));   RUN(13, ph_mo(C, 0));
    RUN(14, ph_w1(C, 1));   RUN(15, ph_w2<false>(C, P, 1));   RUN(16, ph_w2fin<false>(C, P, 1));
    RUN(17, ph_w1(C, 2));   RUN(18, ph_w2<false>(C, P, 2));   RUN(19, ph_w2fin<false>(C, P, 2));
    RUN(20, ph_cwin(C, P));   RUN(21, ph_nr(C, P));   RUN(22, ph_uq(C));   RUN(23, ph_attp(C));
    RUN(24, ph_exp(C, 0));   RUN(25, ph_atts(C, 0));   RUN(26, ph_exp(C, 1));   RUN(27, ph_atts(C, 1));   RUN(28, ph_cwout(C));   RUN(29, ph_cwoutfin(C));
    RUN(30, ph_mq(C, P, 1));   RUN(31, ph_matt(C, 1));   RUN(32, ph_mo(C, 1));
    RUN(33, ph_w1(C, 3));   RUN(34, ph_w2<false>(C, P, 3));   RUN(35, ph_w2fin<false>(C, P, 3));
    RUN(36, ph_final(C, P));
#undef RUN
}
extern "C" void kernel_launch(void* const* d_in, const int* in_sizes, int n_in, void* d_out, int out_size, void* d_ws, size_t ws_size, hipStream_t stream) {
    static int grid = 0;
    if (grid == 0) {
        if (n_in != N_IN || (size_t)out_size != OUT_END || ws_size < WS_NEED) {
            fprintf(stderr, "kernel_launch: unexpected shapes: n_in %d out %d ws %zu (need %zu)\n", n_in, out_size, ws_size, (size_t)WS_NEED); grid = -1; return; }
        int dev = 0, cus = 0;
        if (hipGetDevice(&dev) != hipSuccess || hipDeviceGetAttribute(&cus, hipDeviceAttributeMultiprocessorCount, dev) != hipSuccess) { grid = -1; return; }
        if (hipFuncSetAttribute((const void*)mk_fwd, hipFuncAttributeMaxDynamicSharedMemorySize, LDS_BYTES) != hipSuccess) { fprintf(stderr, "kernel_launch: hipFuncSetAttribute failed\n"); grid = -1; return; }
        int per_cu = 0;
        if (hipOccupancyMaxActiveBlocksPerMultiprocessor(&per_cu, (const void*)mk_fwd, NWAVES * 64, LDS_BYTES) != hipSuccess || per_cu < 1) { fprintf(stderr, "kernel_launch: occupancy query says %d\n", per_cu); }
        (void)hipGetLastError();
        grid = cus;
    }
    if (grid < 0) return;
    (void)hipMemsetAsync((char*)d_ws, 0, O_ZEND, stream);
    Params p{};
    for (int i = 0; i < N_IN; ++i) p.in[i] = (const float*)d_in[i];
    p.out = (float*)d_out; p.ws = (unsigned char*)d_ws;
#ifndef MK_PER_PHASE
    p.ph_lo = 0; p.ph_hi = N_PHASES;
    hipLaunchKernelGGL(mk_fwd, dim3(grid), dim3(NWAVES * 64), LDS_BYTES, stream, p);
#else
    for (int k = 0; k < N_PHASES; ++k) { p.ph_lo = k; p.ph_hi = k + 1; hipLaunchKernelGGL(mk_fwd, dim3(grid), dim3(NWAVES * 64), LDS_BYTES, stream, p); }
#endif
}
```

```cpp
#include <hip/hip_runtime.h>
#include <cstdio>
#include <cstdint>
__device__ __forceinline__ int lane_id() { int l; asm volatile("v_mbcnt_lo_u32_b32 %0, -1, 0\n\tv_mbcnt_hi_u32_b32 %0, -1, %0" : "=v"(l)); return l; }
namespace pg8 {
#define PG8_LAS __attribute__((address_space(3)))
typedef unsigned short bf16_t;
typedef short bf16x8 __attribute__((ext_vector_type(8)));
typedef float f32x4 __attribute__((ext_vector_type(4)));
typedef unsigned u32x4 __attribute__((ext_vector_type(4)));
constexpr int BM = 256, BK = 64, HALF = 128, HTB = HALF * BK * 2  , STAGE_BYTES = 8 * HTB, NXCD = 8, WGM_NARROW = 4, WGM_WIDE = 6;

__host__ __device__ __forceinline__ int lds_byte(int r, int c) { const int st = (r >> 4) * 2 + (c >> 5), rr = r & 15, cc = c & 31, ob = rr * 64 + cc * 2; return st * 1024 + (ob ^ (((ob >> 9) & 1) << 5)); }
__host__ __device__ __forceinline__ void stage_rc(int b, int& R, int& C) { const int st = b / 1024, sb = b % 1024, swz = sb ^ (((sb >> 9) & 1) << 5); R = (st >> 1) * 16 + swz / 64; C = (st & 1) * 32 + (swz % 64) / 2; }
__host__ __device__ __forceinline__ int perm32(int rho) { const int n = rho >> 4, i = rho & 15; return 8 * (i >> 2) + 4 * n + (i & 3); }

struct Unit { int pm, pn, kp, par; };
struct Gemm { const bf16_t* A; const bf16_t* Bt; int M, N, K, lda, kloop; };

struct StaticOrder {
    int nM, nN, nwg, G, c, wgm;
    __host__ __device__ void init(int M, int N, int G_, int c_) { nM = M / BM; nN = N / BM; nwg = nM * nN; G = G_; c = c_; wgm = nN <= 8 ? WGM_NARROW : WGM_WIDE; }
    __host__ __device__ bool next(int i, Unit& u) const {
        const long L = (long)i * G + c; if (L >= nwg) return false;
        int wgid = (int)L; { const int q = nwg / NXCD, r = nwg % NXCD, xcd = wgid % NXCD, off = wgid / NXCD; wgid = (xcd < r ? xcd * (q + 1) : r * (q + 1) + (xcd - r) * q) + off; }
        const int nig = wgm * nN, gid = wgid / nig, fm = gid * wgm, gsz = (nM - fm) < wgm ? (nM - fm) : wgm;
        u.pm = fm + ((wgid % nig) % gsz); u.pn = (wgid % nig) / gsz; u.kp = 0; return true;
    }
    __device__ __forceinline__ void a_ready(const Unit&) const {}
    __device__ __forceinline__ void done(const Unit&) const {}
};
__device__ __forceinline__ unsigned cvt_pk_bf16(float lo, float hi) { unsigned r; asm volatile("v_cvt_pk_bf16_f32 %0, %1, %2" : "=v"(r) : "v"(lo), "v"(hi)); return r; }
template <class Epi, class Sched, bool ALIGN_EPI = false, bool SP2 = false>
__device__ __forceinline__ void gemm_phase(PG8_LAS unsigned char* lds, const Gemm g, const Sched& S, const Epi& E, int wave_id) {
    const int wid = wave_id, lane = lane_id(), tid = wid * 64 + lane, wr = wid >> 2, wc = wid & 3, fr = lane & 15, fq = lane >> 4;
    const int K = g.K, nt = g.kloop / BK; const size_t kpart = (size_t)g.kloop * 2;
    unsigned voffA[2], voffB[2];
#pragma unroll
    for (int i = 0; i < 2; ++i) { int R, C; stage_rc(tid * 16 + i * 8192, R, C); const int Rb = Epi::PERM ? (Epi::ADJ ? ((R >> 5) * 64 + perm32(R & 31)) : ((R & ~31) + perm32(R & 31))) : R;
        voffA[i] = (unsigned)(R * g.lda + C) * 2u; voffB[i] = (unsigned)(Rb * K + C) * 2u; }
    const size_t kstep = (size_t)(BK * 2);
    const size_t hstep = (size_t)HALF * K * 2;
    const size_t tstep = 2 * hstep;
    const size_t hstepB = Epi::ADJ ? (size_t)32 * K * 2 : hstep;
    const size_t hstepA = (size_t)HALF * g.lda * 2, tstepA = 2 * hstepA;
    const unsigned ldsw = (unsigned)wid * 1024u;
    const int aoff = lds_byte(wr * 64 + fr, fq * 8), boff = lds_byte(wc * 32 + fr, fq * 8);
#define PG8_SA(b, h) (((b) * 2 + (h)) * HTB)
#define PG8_SB(b, h) ((4 + (b) * 2 + (h)) * HTB)
#define PG8_STAGE(bufoff, gbase, voff) do { _Pragma("unroll") for (int _i = 0; _i < 2; ++_i) \
        __builtin_amdgcn_global_load_lds((const unsigned*)((const char*)(gbase) + (voff)[_i]), (PG8_LAS unsigned*)(lds + (bufoff) + ldsw + _i * 8192), 16, 0, 0); } while (0)
#define PG8_LDA(dst, b, h) do { _Pragma("unroll") for (int m = 0; m < 4; ++m) _Pragma("unroll") for (int k = 0; k < 2; ++k) dst[m][k] = *(const PG8_LAS bf16x8*)(lds + PG8_SA(b, h) + aoff + m * 2048 + k * 1024); } while (0)
#define PG8_LDB(dst, b, h) do { _Pragma("unroll") for (int n = 0; n < 2; ++n) _Pragma("unroll") for (int k = 0; k < 2; ++k) dst[n][k] = *(const PG8_LAS bf16x8*)(lds + PG8_SB(b, h) + boff + n * 2048 + k * 1024); } while (0)
#define PG8_MMA(ai, bj, At, Bt) do { __builtin_amdgcn_s_setprio(1); _Pragma("unroll") for (int m = 0; m < 4; ++m) _Pragma("unroll") for (int n = 0; n < 2; ++n) _Pragma("unroll") for (int k = 0; k < 2; ++k) \
        acc[ai][bj][m][n] = __builtin_amdgcn_mfma_f32_16x16x32_bf16(Bt[n][k], At[m][k], acc[ai][bj][m][n], 0, 0, 0); __builtin_amdgcn_s_setprio(0); } while (0)
#define PG8_WAIT_V(n) asm volatile("s_waitcnt vmcnt(" #n ")" ::: "memory")
#define PG8_WAIT_L(n) asm volatile("s_waitcnt lgkmcnt(" #n ")" ::: "memory")
#define PG8_BAR __builtin_amdgcn_s_barrier()
#define PG8_SCHED __builtin_amdgcn_sched_barrier(0)
    Unit cur, nxt; int ui = 0;
    if (!S.next(0, cur)) return;
    f32x4 acc[2][2][4][2];
#pragma unroll
    for (int a = 0; a < 2; ++a)
#pragma unroll
        for (int b = 0; b < 2; ++b)
#pragma unroll
            for (int m = 0; m < 4; ++m)
#pragma unroll
                for (int n = 0; n < 2; ++n) acc[a][b][m][n] = (f32x4){0.f, 0.f, 0.f, 0.f};
    bf16x8 At[4][2], B0[2][2], B1[2][2];
    const char* cA = (const char*)g.A + (size_t)cur.pm * tstepA + (size_t)cur.kp * kpart; const char* cB = (const char*)g.Bt + (size_t)cur.pn * tstep + (size_t)cur.kp * kpart;
    S.a_ready(cur);
    if constexpr (SP2) {
        PG8_STAGE(PG8_SB(0, 0), cB, voffB); PG8_STAGE(PG8_SB(0, 1), cB + hstepB, voffB); PG8_STAGE(PG8_SA(0, 0), cA, voffA); PG8_STAGE(PG8_SA(0, 1), cA + hstepA, voffA);
        if (wr == 1) PG8_BAR;
        PG8_WAIT_V(2); PG8_BAR;
        PG8_STAGE(PG8_SB(1, 0), cB + kstep, voffB); PG8_STAGE(PG8_SA(1, 0), cA + kstep, voffA); PG8_STAGE(PG8_SB(1, 1), cB + hstepB + kstep, voffB);
        PG8_WAIT_V(6); PG8_BAR;
    } else {
        PG8_STAGE(PG8_SB(0, 0), cB, voffB); PG8_STAGE(PG8_SA(0, 0), cA, voffA); PG8_STAGE(PG8_SB(0, 1), cB + hstepB, voffB); PG8_STAGE(PG8_SA(0, 1), cA + hstepA, voffA);
        if (wr == 1) PG8_BAR;
        PG8_WAIT_V(4); PG8_BAR;
        PG8_STAGE(PG8_SB(1, 0), cB + kstep, voffB); PG8_STAGE(PG8_SA(1, 0), cA + kstep, voffA); PG8_STAGE(PG8_SB(1, 1), cB + hstepB + kstep, voffB);
        PG8_WAIT_V(6); PG8_BAR;
    }
    for (;;) {
        const bool has_next = S.next(ui + 1, nxt);
        if constexpr (Epi::SSQ_LDS)
            __builtin_amdgcn_global_load_lds((const unsigned*)(E.ssq + (size_t)cur.pm * 256) + tid, (PG8_LAS unsigned*)(lds + STAGE_BYTES + (ui & 1) * 2048 + wid * 256), 4, 0, 0);
        const char* nA = has_next ? (const char*)g.A + (size_t)nxt.pm * tstepA + (size_t)nxt.kp * kpart : cA; const char* nB = has_next ? (const char*)g.Bt + (size_t)nxt.pn * tstep + (size_t)nxt.kp * kpart : cB;
        for (int t = 0; t < nt; t += 2) {
            const bool last = (t == nt - 2);
            const char* a1 = cA + (size_t)(t + 1) * kstep;
            const char* a2 = last ? nA : cA + (size_t)(t + 2) * kstep; const char* b2 = last ? nB : cB + (size_t)(t + 2) * kstep;
            const char* a3 = a2 + kstep; const char* b3 = b2 + kstep;
            if (last && has_next) S.a_ready(nxt);
            if constexpr (SP2) {
            PG8_LDB(B0, 0, 0); PG8_LDB(B1, 0, 1); PG8_SCHED; PG8_LDA(At, 0, 0); PG8_STAGE(PG8_SA(1, 1), a1 + hstepA, voffA);
            PG8_WAIT_V(8); PG8_WAIT_L(0); PG8_BAR; PG8_MMA(0, 0, At, B0); PG8_MMA(0, 1, At, B1); PG8_BAR; PG8_SCHED;
            PG8_LDA(At, 0, 1); PG8_STAGE(PG8_SB(0, 0), b2, voffB); PG8_STAGE(PG8_SB(0, 1), b2 + hstepB, voffB); PG8_STAGE(PG8_SA(0, 0), a2, voffA);
            PG8_WAIT_V(8); PG8_WAIT_L(0); PG8_BAR; PG8_MMA(1, 0, At, B0); PG8_MMA(1, 1, At, B1); PG8_BAR; PG8_SCHED;
            PG8_LDB(B0, 1, 0); PG8_LDB(B1, 1, 1); PG8_SCHED; PG8_LDA(At, 1, 0); PG8_STAGE(PG8_SA(0, 1), a2 + hstepA, voffA);
            PG8_WAIT_V(8); PG8_WAIT_L(0); PG8_BAR; PG8_MMA(0, 0, At, B0); PG8_MMA(0, 1, At, B1); PG8_BAR; PG8_SCHED;
            PG8_LDA(At, 1, 1); PG8_STAGE(PG8_SB(1, 0), b3, voffB); PG8_STAGE(PG8_SB(1, 1), b3 + hstepB, voffB); PG8_STAGE(PG8_SA(1, 0), a3, voffA);
            PG8_WAIT_V(8); PG8_WAIT_L(0); PG8_BAR; PG8_MMA(1, 0, At, B0); PG8_MMA(1, 1, At, B1); PG8_BAR; PG8_SCHED;
            } else {
            PG8_LDB(B0, 0, 0); PG8_SCHED; PG8_LDA(At, 0, 0); PG8_STAGE(PG8_SA(1, 1), a1 + hstepA, voffA);
            PG8_WAIT_L(8); PG8_BAR; PG8_WAIT_L(0); PG8_MMA(0, 0, At, B0); PG8_BAR; PG8_SCHED;
            PG8_LDB(B1, 0, 1); PG8_STAGE(PG8_SB(0, 0), b2, voffB);
            PG8_BAR; PG8_WAIT_L(0); PG8_MMA(0, 1, At, B1); PG8_BAR;
            PG8_LDA(At, 0, 1); PG8_STAGE(PG8_SA(0, 0), a2, voffA);
            PG8_BAR; PG8_WAIT_L(0); PG8_MMA(1, 0, At, B0); PG8_BAR; PG8_SCHED;
            PG8_STAGE(PG8_SB(0, 1), b2 + hstepB, voffB);
            PG8_WAIT_V(6); PG8_BAR; PG8_MMA(1, 1, At, B1); PG8_BAR;
            PG8_LDB(B0, 1, 0); PG8_SCHED; PG8_LDA(At, 1, 0); PG8_STAGE(PG8_SA(0, 1), a2 + hstepA, voffA);
            PG8_WAIT_L(8); PG8_BAR; PG8_WAIT_L(0); PG8_MMA(0, 0, At, B0); PG8_BAR; PG8_SCHED;
            PG8_LDB(B1, 1, 1); PG8_STAGE(PG8_SB(1, 0), b3, voffB);
            PG8_BAR; PG8_WAIT_L(0); PG8_MMA(0, 1, At, B1); PG8_BAR;
            PG8_LDA(At, 1, 1); PG8_STAGE(PG8_SA(1, 0), a3, voffA);
            PG8_BAR; PG8_WAIT_L(0); PG8_MMA(1, 0, At, B0); PG8_BAR; PG8_SCHED;
            PG8_STAGE(PG8_SB(1, 1), b3 + hstepB, voffB);
            PG8_WAIT_V(6); PG8_BAR; PG8_MMA(1, 1, At, B1); PG8_BAR;
            }
        }
        if constexpr (ALIGN_EPI) { if (wr == 0) PG8_BAR; }
        cur.par = ui & 1;
        if constexpr (!Epi::AFTER_DRAIN) { E(acc, cur, wr, wc, fr, fq); S.done(cur); }
        if (!has_next) break;
#pragma unroll
        for (int a = 0; a < 2; ++a)
#pragma unroll
            for (int b = 0; b < 2; ++b)
#pragma unroll
                for (int m = 0; m < 4; ++m)
#pragma unroll
                    for (int n = 0; n < 2; ++n) acc[a][b][m][n] = (f32x4){0.f, 0.f, 0.f, 0.f};
        cur = nxt; cA = nA; cB = nB; ++ui;
        if constexpr (ALIGN_EPI) { if (wr == 1) PG8_BAR; }
    }
    PG8_WAIT_V(0);
    if constexpr (!ALIGN_EPI) { if (wr == 0) PG8_BAR; }
    PG8_BAR;
    if constexpr (Epi::AFTER_DRAIN) { E.fused(acc, cur, wr, wc, fr, fq, lds, wid, lane); S.done(cur); }
#undef PG8_SA
#undef PG8_SB
#undef PG8_STAGE
#undef PG8_LDA
#undef PG8_LDB
#undef PG8_MMA
#undef PG8_WAIT_V
#undef PG8_WAIT_L
#undef PG8_BAR
#undef PG8_SCHED
}
}
#define GAS __attribute__((address_space(1)))
#define LAS __attribute__((address_space(3)))
#define XB_TMO      128
#define XB_XCNT(j)  (256  + 64 * (j))
#define XB_XSUB(j)  (1280 + 64 * (j))
#define XB_XGEN(j)  (2304 + 64 * (j))
#define XB_TOP      3328
#define XB_TOPGEN   3392
#define XCD_BAR_WORDS 3456
#define XB_SPIN_CAP (1u << 18)

__device__ __forceinline__ unsigned xb_ld(unsigned* p)              { return __hip_atomic_load(p, __ATOMIC_RELAXED, __HIP_MEMORY_SCOPE_AGENT); }
__device__ __forceinline__ unsigned xb_add(unsigned* p, unsigned v) { return __hip_atomic_fetch_add(p, v, __ATOMIC_RELAXED, __HIP_MEMORY_SCOPE_AGENT); }
__device__ __forceinline__ unsigned xb_xcc_id() { return (unsigned)__builtin_amdgcn_s_getreg((3 << 11) | 20) & 0xFu; }
#define XB_SPIN(cond, bar) do { unsigned _sp = 0; while (cond) { __builtin_amdgcn_s_sleep(1); \
    if ((++_sp & 255u) == 0u) { if (xb_ld(&(bar)[XB_TMO])) break; if (_sp > XB_SPIN_CAP) { atomicAdd(&(bar)[XB_TMO], 1u); break; } } } } while (0)

struct XcdBarrier {
    unsigned* bar; unsigned x; bool t0;
    volatile LAS unsigned* st;
};

__device__ __forceinline__ XcdBarrier xcd_barrier_post(unsigned* bar, volatile LAS unsigned* st, int wave_id) {
    XcdBarrier b; b.bar = bar; b.x = xb_xcc_id(); b.st = st; b.t0 = false;
    if (wave_id == 0 && lane_id() == 0) (void)xb_add(&bar[XB_XCNT(b.x)], 1u);
    return b;
}
__device__ __forceinline__ void xcd_barrier_complete(unsigned* bar, unsigned x, unsigned& nloc, unsigned& nx) {
    const unsigned G = gridDim.x * gridDim.y * gridDim.z;
    unsigned sum, cnt, mine, sp = 0u;
    for (;;) {
        sum = 0u; cnt = 0u; mine = 0u;
#pragma unroll
        for (unsigned j = 0; j < 16; ++j) { const unsigned c = xb_ld(&bar[XB_XCNT(j)]); sum += c; cnt += (c > 0u) ? 1u : 0u; mine = (j == x) ? c : mine; }
        if (sum == G) break;
        __builtin_amdgcn_s_sleep(1);
        if ((++sp & 255u) == 0u) { if (xb_ld(&bar[XB_TMO])) break; if (sp > XB_SPIN_CAP) { atomicAdd(&bar[XB_TMO], 1u); break; } }
    }
    nloc = mine > 0u ? mine : 1u; nx = cnt > 0u ? cnt : 1u;
}

__device__ __forceinline__ void xcd_barrier(const XcdBarrier& b) {
    asm volatile("s_waitcnt vmcnt(0)" ::: "memory");
    __syncthreads();
    if (b.t0 && lane_id() == 0) {
        unsigned* bar = b.bar;
        __builtin_amdgcn_s_waitcnt(0);
        unsigned nloc = b.st[0], nx = b.st[1];
        if (nloc == 0u) { xcd_barrier_complete(bar, b.x, nloc, nx); b.st[0] = nloc; b.st[1] = nx; }
        const unsigned old = xb_add(&bar[XB_XSUB(b.x)], 1u);
        const unsigned gen = old / nloc;
        if (old + 1u == (gen + 1u) * nloc) {
            __builtin_amdgcn_fence(__ATOMIC_RELEASE, "agent");
            asm volatile("s_waitcnt vmcnt(0)" ::: "memory");
            const unsigned og = xb_add(&bar[XB_TOP], 1u);
            const unsigned tg = og / nx;
            if (og + 1u == (tg + 1u) * nx) xb_add(&bar[XB_TOPGEN], 1u);
            else XB_SPIN(xb_ld(&bar[XB_TOPGEN]) == tg, bar);
            __builtin_amdgcn_fence(__ATOMIC_ACQUIRE, "agent");
            xb_add(&bar[XB_XGEN(b.x)], 1u);
            asm volatile("s_waitcnt vmcnt(0)" ::: "memory");
        } else {
            XB_SPIN(xb_ld(&bar[XB_XGEN(b.x)]) == gen, bar);
            __builtin_amdgcn_fence(__ATOMIC_ACQUIRE, "agent");
            asm volatile("s_waitcnt vmcnt(0)" ::: "memory");
        }
    }
    __syncthreads();
}
__device__ const double INV_R[128] = {1.00000000000000000e+00, 9.30572040929699029e-01, 8.65964323360065347e-01, 8.05842187761481865e-01, 7.49894209332455874e-01, 6.97830584859866376e-01, 6.49381631576211316e-01, 6.04296390238132863e-01, 5.62341325190349073e-01, 5.23299114681494704e-01, 4.86967525165863113e-01, 4.53158363760081784e-01, 4.21696503428582226e-01, 3.92418975848453588e-01, 3.65174127254837722e-01, 3.39820832894255964e-01, 3.16227766016837941e-01, 2.94272717620928159e-01, 2.73841963426436130e-01, 2.54829674797934669e-01, 2.37137370566165517e-01, 2.20673406908458991e-01, 2.05352502645714613e-01, 1.91095297497044042e-01, 1.77827941003892293e-01, 1.65481709994318132e-01, 1.53992652605949187e-01, 1.43301257023696282e-01, 1.33352143216332403e-01, 1.24093776075171955e-01, 1.15478198468945817e-01, 1.07460782832131743e-01, 1.00000000000000006e-01, 9.30572040929699001e-02, 8.65964323360065291e-02, 8.05842187761481865e-02, 7.49894209332455791e-02, 6.97830584859866349e-02, 6.49381631576211316e-02, 6.04296390238132849e-02, 5.62341325190349114e-02, 5.23299114681494704e-02, 4.86967525165863113e-02, 4.53158363760081812e-02, 4.21696503428582239e-02, 3.92418975848453574e-02, 3.65174127254837694e-02, 3.39820832894255909e-02, 3.16227766016837913e-02, 2.94272717620928173e-02, 2.73841963426436144e-02, 2.54829674797934641e-02, 2.37137370566165538e-02, 2.20673406908458991e-02, 2.05352502645714599e-02, 1.91095297497044063e-02, 1.77827941003892293e-02, 1.65481709994318126e-02, 1.53992652605949194e-02, 1.43301257023696268e-02, 1.33352143216332406e-02, 1.24093776075171955e-02, 1.15478198468945813e-02, 1.07460782832131743e-02, 1.00000000000000002e-02, 9.30572040929699036e-03, 8.65964323360065430e-03, 8.05842187761481900e-03, 7.49894209332455791e-03, 6.97830584859866331e-03, 6.49381631576211298e-03, 6.04296390238132780e-03, 5.62341325190349097e-03, 5.23299114681494669e-03, 4.86967525165863096e-03, 4.53158363760081812e-03, 4.21696503428582292e-03, 3.92418975848453627e-03, 3.65174127254837711e-03, 3.39820832894255917e-03, 3.16227766016837939e-03, 2.94272717620928199e-03, 2.73841963426436127e-03, 2.54829674797934667e-03, 2.37137370566165538e-03, 2.20673406908458974e-03, 2.05352502645714599e-03, 1.91095297497044059e-03, 1.77827941003892275e-03, 1.65481709994318139e-03, 1.53992652605949203e-03, 1.43301257023696268e-03, 1.33352143216332406e-03, 1.24093776075171955e-03, 1.15478198468945813e-03, 1.07460782832131756e-03, 1.00000000000000002e-03, 9.30572040929698928e-04, 8.65964323360065387e-04, 8.05842187761481791e-04, 7.49894209332455856e-04, 6.97830584859866353e-04, 6.49381631576211342e-04, 6.04296390238132867e-04, 5.62341325190349097e-04, 5.23299114681494734e-04, 4.86967525165863096e-04, 4.53158363760081790e-04, 4.21696503428582237e-04, 3.92418975848453594e-04, 3.65174127254837700e-04, 3.39820832894255961e-04, 3.16227766016837939e-04, 2.94272717620928167e-04, 2.73841963426436105e-04, 2.54829674797934635e-04, 2.37137370566165538e-04, 2.20673406908458974e-04, 2.05352502645714610e-04, 1.91095297497044048e-04, 1.77827941003892270e-04, 1.65481709994318149e-04, 1.53992652605949192e-04, 1.43301257023696274e-04, 1.33352143216332395e-04, 1.24093776075171960e-04, 1.15478198468945822e-04, 1.07460782832131751e-04};
__device__ const double INV_M[32] = {1.00000000000000000e+00, 7.49894209332455874e-01, 5.62341325190349073e-01, 4.21696503428582226e-01, 3.16227766016837941e-01, 2.37137370566165517e-01, 1.77827941003892293e-01, 1.33352143216332403e-01, 1.00000000000000006e-01, 7.49894209332455791e-02, 5.62341325190349114e-02, 4.21696503428582239e-02, 3.16227766016837913e-02, 2.37137370566165538e-02, 1.77827941003892293e-02, 1.33352143216332406e-02, 1.00000000000000002e-02, 7.49894209332455791e-03, 5.62341325190349097e-03, 4.21696503428582292e-03, 3.16227766016837939e-03, 2.37137370566165538e-03, 1.77827941003892275e-03, 1.33352143216332406e-03, 1.00000000000000002e-03, 7.49894209332455856e-04, 5.62341325190349097e-04, 4.21696503428582237e-04, 3.16227766016837939e-04, 2.37137370566165538e-04, 1.77827941003892270e-04, 1.33352143216332395e-04};
__device__ const float LOG_GAMMA[8] = {-3.174869831e-02f, -1.574835697e-02f, -7.843177461e-03f, -3.913899321e-03f, -1.955034836e-03f, -9.770396478e-04f, -4.884004981e-04f, -2.441704322e-04f};

typedef unsigned short bf16;
typedef unsigned v4u __attribute__((ext_vector_type(4)));
typedef unsigned v2u __attribute__((ext_vector_type(2)));
typedef float f32x4 __attribute__((ext_vector_type(4)));
typedef short bf16x8 __attribute__((ext_vector_type(8)));
typedef float f32x16 __attribute__((ext_vector_type(16)));
typedef short s16x4 __attribute__((ext_vector_type(4)));

constexpr int D = 2048, MP = 32768, MS = 512, M = MP + MS, SEQ = 8192, NBP = 4, NBS = 32, TS = 16, PAST = 2048, DFF = 5632;
constexpr float EPS = 1e-6f;
constexpr int NWAVES = 8;
constexpr int WIN_N = 13568, CWIN_N = 1280;

enum { I_XP = 0, I_XS, I_MEM, I_SCONV, I_SSSD, I_SRET, I_CCKV, I_CKPE, I_CMK, I_CMV, I_NORMS, I_W1, I_W2, I_MNORM, I_WMQ, I_WMKV, I_WMO,
       I_ABWIN, I_CONVW, I_CONVB, I_DTB, I_ALOG, I_DSKIP, I_SSDN, I_ABWOUT, I_CWIN, I_QNORM, I_KVNORM, I_WUQ, I_WUK, I_WUV, I_CWOUT, I_FNORM, N_IN };
constexpr size_t OUT_Y = 0;
constexpr size_t OUT_CONVP = (size_t)M * D;
constexpr size_t OUT_SSDP = OUT_CONVP + 4 * 3 * 3072;
constexpr size_t OUT_RETP = OUT_SSDP + (size_t)4 * 32 * 128 * 64;
constexpr size_t OUT_CKVP = OUT_RETP + (size_t)4 * 8 * 256 * 256;
constexpr size_t OUT_KPEP = OUT_CKVP + (size_t)MP * 512;
constexpr size_t OUT_MEMK = OUT_KPEP + (size_t)MP * 64;
constexpr size_t OUT_MEMV = OUT_MEMK + (size_t)2 * 1024 * 512;
constexpr size_t OUT_CONVS = OUT_MEMV + (size_t)2 * 1024 * 512;
constexpr size_t OUT_SSDS = OUT_CONVS + (size_t)32 * 3 * 3072;
constexpr size_t OUT_RETS = OUT_SSDS + (size_t)32 * 32 * 128 * 64;
constexpr size_t OUT_CKVS = OUT_RETS + (size_t)32 * 8 * 256 * 256;
constexpr size_t OUT_KPES = OUT_CKVS + (size_t)MS * 512;
constexpr size_t OUT_END = OUT_KPES + (size_t)MS * 64;

constexpr size_t AL(size_t x) { return (x + 255) & ~(size_t)255; }
constexpr size_t O_CTL = 0;
constexpr size_t O_SSQ = (size_t)1 << 20;
constexpr size_t O_ZEND = O_SSQ + AL((size_t)9 * M * 8);
constexpr size_t O_SSQG = O_ZEND;
constexpr size_t O_SSQH = O_SSQG + (size_t)M * 64 * 4;
constexpr size_t O_SSQM = O_SSQH + (size_t)M * 64 * 4;
constexpr size_t O_COSR = O_SSQM + AL(1024 * 4);
constexpr size_t O_SINR = O_COSR + (size_t)8192 * 128 * 4;
constexpr size_t O_COSM = O_SINR + (size_t)8192 * 128 * 4;
constexpr size_t O_SINM = O_COSM + (size_t)8192 * 32 * 4;
constexpr size_t O_MB = O_SINM + (size_t)8192 * 32 * 4;
constexpr size_t O_MKV = O_MB + (size_t)1024 * 2048 * 2;
constexpr size_t O_W1 = O_MKV + (size_t)2 * 1024 * 1024 * 2;
constexpr size_t SZ_W1 = (size_t)2 * DFF * D * 2, SZ_W2 = (size_t)D * DFF * 2;
constexpr size_t O_W2 = O_W1 + 4 * SZ_W1;
constexpr size_t O_WIN = O_W2 + 4 * SZ_W2;
constexpr size_t O_WOUT = O_WIN + (size_t)WIN_N * D * 2;
constexpr size_t O_CWIN = O_WOUT + (size_t)D * 4096 * 2;
constexpr size_t O_WUQ = O_CWIN + (size_t)CWIN_N * D * 2;
constexpr size_t O_WKV = O_WUQ + (size_t)3072 * 512 * 2;
constexpr size_t O_CWOUT = O_WKV + (size_t)4096 * 512 * 2;
constexpr size_t O_WMQ = O_CWOUT + (size_t)D * D * 2;
constexpr size_t O_WMKV = O_WMQ + (size_t)2 * 512 * D * 2;
constexpr size_t O_WMO = O_WMKV + (size_t)2 * 1024 * D * 2;
constexpr size_t O_XB = O_WMO + (size_t)2 * D * 512 * 2;
constexpr int XBP = D + 64;
constexpr size_t O_SCR = O_XB + (size_t)M * XBP * 2;
constexpr size_t S_H = 0;
constexpr size_t S_T1 = 0;
constexpr size_t S_ZG = S_T1 + (size_t)M * 4096 * 2;
constexpr size_t S_QK = S_ZG + (size_t)M * 4096 * 2;
constexpr size_t S_BC = S_QK + (size_t)M * 4096 * 2;
constexpr size_t S_DT = S_BC + (size_t)M * 1024 * 2;
constexpr size_t S_L0END = S_DT + (size_t)M * 32 * 4;
constexpr size_t S_QM = 0;
constexpr size_t S_OM = S_QM + (size_t)M * 512 * 2;
constexpr size_t S_CMK = S_OM + (size_t)M * 512 * 2;
constexpr size_t S_CMV = S_CMK + (size_t)32 * 256 * 512 * 2;
constexpr size_t S_PARTQ = S_CMV + (size_t)32 * 256 * 512 * 2;
constexpr size_t S_OB = 0;
constexpr size_t S_CKVB = S_OB + (size_t)M * D * 2;
constexpr size_t S_KPEB = S_CKVB + (size_t)M * 512 * 2;
constexpr size_t S_CKVPAST = S_KPEB + (size_t)M * 64 * 2;
constexpr size_t S_KPEPAST = S_CKVPAST + (size_t)65536 * 512 * 2;
constexpr size_t S_QN = S_KPEPAST + (size_t)65536 * 64 * 2;
constexpr size_t S_QR = S_QN + (size_t)M * D * 2;
constexpr size_t S_KNVN = S_QR + (size_t)M * 1024 * 2;
constexpr size_t S_CQN = S_KNVN + (size_t)MS * 4096 * 2;
constexpr size_t S_CIN = S_CQN + (size_t)M * 512 * 2;
constexpr size_t S_KNV = S_CIN;
constexpr size_t S_L1END = S_KNV + (size_t)MP * 4096 * 2;
constexpr size_t S_MAX = (S_L0END > S_L1END ? S_L0END : S_L1END) > (size_t)M * DFF * 2 ? (S_L0END > S_L1END ? S_L0END : S_L1END) : (size_t)M * DFF * 2;
constexpr size_t WS_NEED = O_SCR + S_MAX;
static_assert(S_CIN + (size_t)M * 1280 * 4 <= S_L1END, "CIN inside the KNV overlay");
static_assert(WS_NEED <= (size_t)1476395008, "workspace map exceeds 4x the largest tensor");

constexpr int RING_BYTES = 131072, LDS_BYTES = 147456, MISC_OFF = LDS_BYTES - 256;

struct Params { const float* in[N_IN]; float* out; unsigned char* ws; int ph_lo, ph_hi; };
static_assert(sizeof(Params) == (N_IN + 2) * 8 + 8, "no padding in Params");

#define LDS_WAIT() asm volatile("s_waitcnt lgkmcnt(0)" ::: "memory")
#define VM_WAIT() asm volatile("s_waitcnt vmcnt(0)" ::: "memory")

__device__ __forceinline__ unsigned f2bf(float f) { unsigned u = __builtin_bit_cast(unsigned, f); return (u + 0x7fffu + ((u >> 16) & 1u)) >> 16; }
__device__ __forceinline__ unsigned pk2(float lo, float hi) { return pg8::cvt_pk_bf16(lo, hi); }
__device__ __forceinline__ float bflo(unsigned w) { return __uint_as_float(w << 16); }
__device__ __forceinline__ float bfhi(unsigned w) { return __uint_as_float(w & 0xffff0000u); }
__device__ __forceinline__ float bf2f(bf16 b) { return __uint_as_float(((unsigned)b) << 16); }
__device__ __forceinline__ float wave_sum(float v) {
#pragma unroll
    for (int o = 1; o < 64; o <<= 1) v += __shfl_xor(v, o);
    return v;
}
typedef unsigned long long u64;
__device__ __forceinline__ u64 ssq_fix(float v) { return (u64)(v * 16777216.0f + 0.5f); }
__device__ __forceinline__ void ssq_add(u64* p, float v) { atomicAdd(p, ssq_fix(v)); }
__device__ __forceinline__ float ssq_get(const u64* p) { return (float)(*p) * (1.0f / 16777216.0f); }
__device__ __forceinline__ float silu_f(float a) { return a * __builtin_amdgcn_rcpf(1.0f + __expf(-a)); }
__device__ __forceinline__ int pos_of_row(int row) { return row < MP ? (row & (SEQ - 1)) : PAST + ((row - MP) & (TS - 1)); }

typedef const pg8::f32x4 (&AccRef)[2][2][4][2];

__device__ __forceinline__ float ssq_lds(const LAS unsigned char* sl, int par, int rl) { return (float)(*(const LAS u64*)(sl + pg8::STAGE_BYTES + par * 2048 + rl * 8)) * (1.0f / 16777216.0f); }

struct EpiSwiglu {
    static constexpr bool PERM = true, AFTER_DRAIN = false, ADJ = false, SSQ_LDS = true;
    bf16* H; const u64* ssq; const LAS unsigned char* sl;
    __device__ __forceinline__ void operator()(AccRef acc, const pg8::Unit& u, int wr, int wc, int fr, int fq) const {
        const int row0 = u.pm * 256 + wr * 64 + fr, col0 = u.pn * 128 + wc * 32 + 8 * fq;
#pragma unroll
        for (int ai = 0; ai < 2; ++ai)
#pragma unroll
            for (int m = 0; m < 4; ++m) {
                const int row = row0 + ai * 128 + m * 16; const float rs = rsqrtf(ssq_lds(sl, u.par, row - u.pm * 256) * (1.0f / D) + EPS);
                float o[8];
#pragma unroll
                for (int n = 0; n < 2; ++n)
#pragma unroll
                    for (int j = 0; j < 4; ++j) { const float a = acc[ai][0][m][n][j] * rs, b = acc[ai][1][m][n][j] * rs; o[4 * n + j] = silu_f(a) * b; }
                v4u w; w.x = pk2(o[0], o[1]); w.y = pk2(o[2], o[3]); w.z = pk2(o[4], o[5]); w.w = pk2(o[6], o[7]);
                *(v4u*)(H + (size_t)row * DFF + col0) = w;
            }
    }
};

__device__ __forceinline__ unsigned swap8(unsigned v) { return (unsigned)__builtin_amdgcn_update_dpp(0, (int)v, 0x128, 0xf, 0xf, true); }
__device__ __forceinline__ v4u swap8(v4u v) { v4u r; r.x = swap8(v.x); r.y = swap8(v.y); r.z = swap8(v.z); r.w = swap8(v.w); return r; }

template <bool FIRST> struct EpiRes {
    static constexpr bool PERM = true, AFTER_DRAIN = false, ADJ = true, SSQ_LDS = false;
    const float* src32; bf16* XB; u64* ssq_next; float alpha;
    __device__ __forceinline__ void operator()(AccRef acc, const pg8::Unit& u, int wr, int wc, int fr, int fq) const {
        const int row0 = u.pm * 256 + wr * 64, colw = u.pn * 256 + wc * 64 + 8 * fq;
        const bool lo = fr < 8; const int r8 = fr & 7, cst = colw + (lo ? 0 : 32);
        v4u q[2][4][2];
        if constexpr (!FIRST) {
#pragma unroll
            for (int ai = 0; ai < 2; ++ai)
#pragma unroll
                for (int m = 0; m < 4; ++m)
#pragma unroll
                    for (int bj = 0; bj < 2; ++bj) q[ai][m][bj] = *(const v4u*)(XB + (size_t)(row0 + ai * 128 + m * 16 + fr) * XBP + colw + bj * 32);
        }
#pragma unroll
        for (int ai = 0; ai < 2; ++ai)
#pragma unroll
            for (int m = 0; m < 4; ++m) {
                const int rowb = row0 + ai * 128 + m * 16, row = rowb + fr; float ss = 0.f; v4u w[2];
#pragma unroll
                for (int bj = 0; bj < 2; ++bj) {
                    f32x4 s0, s1;
                    if constexpr (FIRST) { const float* sp = src32 + (size_t)row * D + colw + bj * 32; s0 = *(const f32x4*)sp; s1 = *(const f32x4*)(sp + 4); }
                    else { const v4u qq = q[ai][m][bj]; s0 = (f32x4){bflo(qq.x), bfhi(qq.x), bflo(qq.y), bfhi(qq.y)}; s1 = (f32x4){bflo(qq.z), bfhi(qq.z), bflo(qq.w), bfhi(qq.w)}; }
                    const f32x4 v0 = s0 + acc[ai][bj][m][0] * alpha, v1 = s1 + acc[ai][bj][m][1] * alpha;
                    w[bj].x = pk2(v0[0], v0[1]); w[bj].y = pk2(v0[2], v0[3]); w[bj].z = pk2(v1[0], v1[1]); w[bj].w = pk2(v1[2], v1[3]);
                    ss += (v0[0] * v0[0] + v0[1] * v0[1]) + (v0[2] * v0[2] + v0[3] * v0[3]) + (v1[0] * v1[0] + v1[1] * v1[1]) + (v1[2] * v1[2] + v1[3] * v1[3]);
                }
                const v4u got = swap8(lo ? w[1] : w[0]);
                const v4u sa = lo ? w[0] : got, sb = lo ? got : w[1];
                bf16* da = XB + (size_t)(rowb + r8) * XBP + cst;
                *(v4u*)da = sa; *(v4u*)(da + (size_t)8 * XBP) = sb;
                ss += __shfl_xor(ss, 16); ss += __shfl_xor(ss, 32);
                if (fq == 0) ssq_add(ssq_next + row, ss);
            }
    }
};

struct EpiPlain {
    static constexpr bool PERM = true, AFTER_DRAIN = false, ADJ = false, SSQ_LDS = false;
    bf16* O; int ldo; const u64* ssq;
    __device__ __forceinline__ void operator()(AccRef acc, const pg8::Unit& u, int wr, int wc, int fr, int fq) const {
        const int row0 = u.pm * 256 + wr * 64 + fr, col0 = u.pn * 256 + wc * 32 + 8 * fq;
#pragma unroll
        for (int ai = 0; ai < 2; ++ai)
#pragma unroll
            for (int m = 0; m < 4; ++m) {
                const int row = row0 + ai * 128 + m * 16; const float rs = ssq ? rsqrtf(ssq_get(ssq + row) * (1.0f / D) + EPS) : 1.0f;
#pragma unroll
                for (int bj = 0; bj < 2; ++bj) {
                    const f32x4 v0 = acc[ai][bj][m][0] * rs, v1 = acc[ai][bj][m][1] * rs;
                    v4u w; w.x = pk2(v0[0], v0[1]); w.y = pk2(v0[2], v0[3]); w.z = pk2(v1[0], v1[1]); w.w = pk2(v1[2], v1[3]);
                    *(v4u*)(O + (size_t)row * ldo + col0 + bj * 128) = w;
                }
            }
    }
};

struct EpiF32 {
    static constexpr bool PERM = true, AFTER_DRAIN = false, ADJ = false, SSQ_LDS = false;
    float* C; int ldc; const u64* ssq;
    __device__ __forceinline__ void operator()(AccRef acc, const pg8::Unit& u, int wr, int wc, int fr, int fq) const {
        const int row0 = u.pm * 256 + wr * 64 + fr, col0 = u.pn * 256 + wc * 32 + 8 * fq;
#pragma unroll
        for (int ai = 0; ai < 2; ++ai)
#pragma unroll
            for (int m = 0; m < 4; ++m) {
                const int row = row0 + ai * 128 + m * 16; const float rs = rsqrtf(ssq_get(ssq + row) * (1.0f / D) + EPS);
#pragma unroll
                for (int bj = 0; bj < 2; ++bj) {
                    float* d = C + (size_t)row * ldc + col0 + bj * 128;
                    *(f32x4*)d = acc[ai][bj][m][0] * rs; *(f32x4*)(d + 4) = acc[ai][bj][m][1] * rs;
                }
            }
    }
};

struct EpiMemKV {
    static constexpr bool PERM = true, AFTER_DRAIN = false, ADJ = false, SSQ_LDS = false;
    float* outk; float* outv; bf16* MKV; const float* ssq;
    __device__ __forceinline__ void operator()(AccRef acc, const pg8::Unit& u, int wr, int wc, int fr, int fq) const {
        const int row0 = u.pm * 256 + wr * 64 + fr, col0 = u.pn * 256 + wc * 32 + 8 * fq;
#pragma unroll
        for (int ai = 0; ai < 2; ++ai)
#pragma unroll
            for (int m = 0; m < 4; ++m) {
                const int row = row0 + ai * 128 + m * 16; const float rs = rsqrtf(ssq[row] * (1.0f / D) + EPS);
#pragma unroll
                for (int bj = 0; bj < 2; ++bj) {
                    const int col = col0 + bj * 128;
                    const f32x4 v0 = acc[ai][bj][m][0] * rs, v1 = acc[ai][bj][m][1] * rs;
                    float* d = (col < 512 ? outk + (size_t)row * 512 + col : outv + (size_t)row * 512 + (col - 512));
                    *(f32x4*)d = v0; *(f32x4*)(d + 4) = v1;
                    v4u w; w.x = pk2(v0[0], v0[1]); w.y = pk2(v0[2], v0[3]); w.z = pk2(v1[0], v1[1]); w.w = pk2(v1[2], v1[3]);
                    *(v4u*)(MKV + (size_t)row * 1024 + col) = w;
                }
            }
    }
};

struct EpiWin {
    static constexpr bool PERM = true, AFTER_DRAIN = false, ADJ = false, SSQ_LDS = true;
    bf16 *T1, *ZG, *QK, *BC; float* DT; const u64* ssq; const float *cosr, *sinr; const float* dt_bias; const LAS unsigned char* sl;
    __device__ __forceinline__ void operator()(AccRef acc, const pg8::Unit& u, int wr, int wc, int fr, int fq) const {
        const int pn = u.pn, row0 = u.pm * 256 + wr * 64 + fr, cl = wc * 32 + 8 * fq;
        if (pn < 36) {
            bf16* base; int pitch = 4096, colt;
            if (pn < 8) { base = ZG; colt = pn * 256; } else if (pn < 16) { base = ZG; colt = 2048 + (pn - 8) * 256; }
            else if (pn < 24) { base = T1; colt = (pn - 16) * 256; } else if (pn < 32) { base = T1; colt = 2048 + (pn - 24) * 256; }
            else { base = BC; pitch = 1024; colt = (pn - 32) * 256; }
#pragma unroll
            for (int ai = 0; ai < 2; ++ai)
#pragma unroll
                for (int m = 0; m < 4; ++m) {
                    const int row = row0 + ai * 128 + m * 16; const float rs = rsqrtf(ssq_lds(sl, u.par, row - u.pm * 256) * (1.0f / D) + EPS);
#pragma unroll
                    for (int bj = 0; bj < 2; ++bj) {
                        const f32x4 v0 = acc[ai][bj][m][0] * rs, v1 = acc[ai][bj][m][1] * rs;
                        v4u w; w.x = pk2(v0[0], v0[1]); w.y = pk2(v0[2], v0[3]); w.z = pk2(v1[0], v1[1]); w.w = pk2(v1[2], v1[3]);
                        *(v4u*)(base + (size_t)row * pitch + colt + cl + bj * 128) = w;
                    }
                }
        } else if (pn < 52) {
            const bool isk = pn >= 44; const int head = isk ? pn - 44 : pn - 36; const int colt = (isk ? 2048 : 0) + head * 256; const float sc = isk ? 0.0625f : 1.0f;
            float invt[8];
#pragma unroll
            for (int e = 0; e < 8; ++e) invt[e] = (float)(INV_R[cl + e] * 0.15915494309189533577);
#pragma unroll
            for (int ai = 0; ai < 2; ++ai)
#pragma unroll
                for (int m = 0; m < 4; ++m) {
                    const int row = row0 + ai * 128 + m * 16; const float rs = rsqrtf(ssq_lds(sl, u.par, row - u.pm * 256) * (1.0f / D) + EPS) * sc;
                    const float posf = (float)pos_of_row(row);
                    f32x4 c0, c1, s0, s1;
#pragma unroll
                    for (int e = 0; e < 4; ++e) { const float t0 = __builtin_amdgcn_fractf(posf * invt[e]), t1 = __builtin_amdgcn_fractf(posf * invt[4 + e]);
                        c0[e] = __builtin_amdgcn_cosf(t0); s0[e] = __builtin_amdgcn_sinf(t0); c1[e] = __builtin_amdgcn_cosf(t1); s1[e] = __builtin_amdgcn_sinf(t1); }
                    const f32x4 a0 = acc[ai][0][m][0] * rs, a1 = acc[ai][0][m][1] * rs, b0 = acc[ai][1][m][0] * rs, b1 = acc[ai][1][m][1] * rs;
                    const f32x4 x0 = a0 * c0 - b0 * s0, x1 = a1 * c1 - b1 * s1, y0 = b0 * c0 + a0 * s0, y1 = b1 * c1 + a1 * s1;
                    v4u w; w.x = pk2(x0[0], x0[1]); w.y = pk2(x0[2], x0[3]); w.z = pk2(x1[0], x1[1]); w.w = pk2(x1[2], x1[3]);
                    *(v4u*)(QK + (size_t)row * 4096 + colt + cl) = w;
                    v4u z; z.x = pk2(y0[0], y0[1]); z.y = pk2(y0[2], y0[3]); z.z = pk2(y1[0], y1[1]); z.w = pk2(y1[2], y1[3]);
                    *(v4u*)(QK + (size_t)row * 4096 + colt + 128 + cl) = z;
                }
        } else {
            if (wc == 0) {
#pragma unroll
                for (int ai = 0; ai < 2; ++ai)
#pragma unroll
                    for (int m = 0; m < 4; ++m) {
                        const int row = row0 + ai * 128 + m * 16; const float rs = rsqrtf(ssq_lds(sl, u.par, row - u.pm * 256) * (1.0f / D) + EPS);
                        const f32x4 v0 = acc[ai][0][m][0] * rs, v1 = acc[ai][0][m][1] * rs;
                        *(f32x4*)(DT + (size_t)row * 32 + cl) = v0; *(f32x4*)(DT + (size_t)row * 32 + cl + 4) = v1;
                    }
            }
        }
    }
};

struct EpiUq {
    static constexpr bool PERM = true, AFTER_DRAIN = false, ADJ = false, SSQ_LDS = false;
    bf16 *QN, *QR; const float *cosm, *sinm;
    __device__ __forceinline__ void operator()(AccRef acc, const pg8::Unit& u, int wr, int wc, int fr, int fq) const {
        const int pn = u.pn, row0 = u.pm * 256 + wr * 64 + fr, cl = wc * 32 + 8 * fq;
        if (pn < 8) {
#pragma unroll
            for (int ai = 0; ai < 2; ++ai)
#pragma unroll
                for (int m = 0; m < 4; ++m) {
                    const int row = row0 + ai * 128 + m * 16;
#pragma unroll
                    for (int bj = 0; bj < 2; ++bj) {
                        const f32x4 v0 = acc[ai][bj][m][0], v1 = acc[ai][bj][m][1];
                        v4u w; w.x = pk2(v0[0], v0[1]); w.y = pk2(v0[2], v0[3]); w.z = pk2(v1[0], v1[1]); w.w = pk2(v1[2], v1[3]);
                        *(v4u*)(QN + (size_t)row * D + pn * 256 + cl + bj * 128) = w;
                    }
                }
        } else {
            const int head = 4 * (pn - 8) + wc, i0 = 8 * fq;
#pragma unroll
            for (int ai = 0; ai < 2; ++ai)
#pragma unroll
                for (int m = 0; m < 4; ++m) {
                    const int row = row0 + ai * 128 + m * 16; const int pos = pos_of_row(row);
                    const f32x4 c0 = *(const f32x4*)(cosm + (size_t)pos * 32 + i0), c1 = *(const f32x4*)(cosm + (size_t)pos * 32 + i0 + 4);
                    const f32x4 s0 = *(const f32x4*)(sinm + (size_t)pos * 32 + i0), s1 = *(const f32x4*)(sinm + (size_t)pos * 32 + i0 + 4);
                    const f32x4 a0 = acc[ai][0][m][0], a1 = acc[ai][0][m][1], b0 = acc[ai][1][m][0], b1 = acc[ai][1][m][1];
                    const f32x4 x0 = a0 * c0 - b0 * s0, x1 = a1 * c1 - b1 * s1, y0 = b0 * c0 + a0 * s0, y1 = b1 * c1 + a1 * s1;
                    v4u w; w.x = pk2(x0[0], x0[1]); w.y = pk2(x0[2], x0[3]); w.z = pk2(x1[0], x1[1]); w.w = pk2(x1[2], x1[3]);
                    *(v4u*)(QR + (size_t)row * 1024 + head * 64 + i0) = w;
                    v4u z; z.x = pk2(y0[0], y0[1]); z.y = pk2(y0[2], y0[3]); z.z = pk2(y1[0], y1[1]); z.w = pk2(y1[2], y1[3]);
                    *(v4u*)(QR + (size_t)row * 1024 + head * 64 + 32 + i0) = z;
                }
        }
    }
};

struct SplitOrder {
    int nN, KS, nun, G, c;
    __device__ __forceinline__ void init(int Mrows, int N, int KS_, int G_, int c_) { nN = N / 256; KS = KS_; nun = (Mrows / 256) * nN * KS_; G = G_; c = c_; }
    __device__ __forceinline__ bool next(int i, pg8::Unit& u) const { const int L = i * G + c; if (L >= nun) return false; u.kp = L % KS; const int t = L / KS; u.pn = t % nN; u.pm = t / nN; return true; }
    __device__ __forceinline__ void a_ready(const pg8::Unit&) const {}
    __device__ __forceinline__ void done(const pg8::Unit&) const {}
};
struct EpiPart {
    static constexpr bool PERM = true, AFTER_DRAIN = false, ADJ = false, SSQ_LDS = false;
    float* PART; int ldc; size_t slab;
    __device__ __forceinline__ void operator()(AccRef acc, const pg8::Unit& u, int wr, int wc, int fr, int fq) const {
        const int row0 = u.pm * 256 + wr * 64 + fr, col0 = u.pn * 256 + wc * 32 + 8 * fq; float* base = PART + (size_t)u.kp * slab;
#pragma unroll
        for (int ai = 0; ai < 2; ++ai)
#pragma unroll
            for (int m = 0; m < 4; ++m) {
                float* d = base + (size_t)(row0 + ai * 128 + m * 16) * ldc + col0;
#pragma unroll
                for (int bj = 0; bj < 2; ++bj) { *(f32x4*)(d + bj * 128) = acc[ai][bj][m][0]; *(f32x4*)(d + bj * 128 + 4) = acc[ai][bj][m][1]; }
            }
    }
};

__device__ __forceinline__ pg8::StaticOrder make_order(int Mrows, int N, int G, int wg, int rot) { pg8::StaticOrder S; S.init(Mrows, N, G, (wg + G - (rot % G)) % G); return S; }

template <class SM>
__device__ __forceinline__ void cvt_weight(const float* __restrict__ W, int K, int ldw, const float* __restrict__ g, int glim, bf16* __restrict__ Bt, int Npad, SM sm,
                                           LAS float* scrf, int gw, int NGW, int lane) {
    LAS bf16* scr = (LAS bf16*)scrf;
    const int nblk = Npad >> 6, items = (K >> 6) * nblk;
    const int c = lane & 7;
    for (int it = gw; it < items; it += NGW) {
        const int kb = it / nblk, nb = it - kb * nblk, k0 = kb << 6, n0 = nb << 6;
        const int src = sm(n0 + (lane & 32));
        float wv[64];
#pragma unroll
        for (int i = 0; i < 64; ++i) wv[i] = src >= 0 ? __builtin_nontemporal_load(W + (size_t)(k0 + i) * ldw + src + (lane & 31)) : 0.f;
#pragma unroll
        for (int i = 0; i < 64; ++i) { float w = wv[i]; if (g != nullptr && k0 + i < glim) w *= g[k0 + i]; scr[i * 66 + lane] = (bf16)f2bf(w); }
        LDS_WAIT(); asm volatile("" ::: "memory");
#pragma unroll
        for (int j = 0; j < 8; ++j) {
            const int n = (lane >> 3) + 8 * j; const LAS bf16* s = scr + (8 * c) * 66 + n;
            v4u o; o.x = (unsigned)s[0] | ((unsigned)s[66] << 16); o.y = (unsigned)s[2 * 66] | ((unsigned)s[3 * 66] << 16); o.z = (unsigned)s[4 * 66] | ((unsigned)s[5 * 66] << 16); o.w = (unsigned)s[6 * 66] | ((unsigned)s[7 * 66] << 16);
            *(v4u*)(Bt + (size_t)(n0 + n) * K + k0 + 8 * c) = o;
        }
        LDS_WAIT(); asm volatile("" ::: "memory");
    }
}
struct SmId { int lim; __device__ __forceinline__ int operator()(int n) const { return n < lim ? n : -1; } };
struct SmW1 { __device__ __forceinline__ int operator()(int n) const { const int t = n >> 8, j = n & 255; return j < 128 ? 128 * t + j : DFF + 128 * t + (j - 128); } };
struct SmWin { __device__ __forceinline__ int operator()(int n) const { const int t = n >> 8;
    if (t < 8) return n; if (t < 16) return 11296 + (n - 2048); if (t < 24) return 2048 + (n - 4096); if (t < 32) return 9248 + (n - 6144);
    if (t < 36) return 4096 + (n - 8192); if (t < 44) return 5152 + (n - 9216); if (t < 52) return 7200 + (n - 11264);
    return (n - 13312) < 32 ? 5120 + (n - 13312) : -1; } };
struct SmUq { __device__ __forceinline__ int operator()(int n) const {
    if (n < 2048) return (n >> 7) * 192 + (n & 127);
    const int t = (n - 2048) >> 8, j = (n - 2048) & 255, half = j >> 7, hh = (j & 127) >> 5, i = j & 31; return (4 * t + hh) * 192 + 128 + half * 32 + i; } };

__device__ __forceinline__ float row_to_bf16(const float* __restrict__ src, bf16* __restrict__ dst, int lane) {
    float ss = 0.f;
#pragma unroll
    for (int j = 0; j < 8; ++j) {
        const f32x4 v = __builtin_nontemporal_load((const f32x4*)(src + 4 * (lane + 64 * j)));
        ss += (v[0] * v[0] + v[1] * v[1]) + (v[2] * v[2] + v[3] * v[3]);
        v2u w; w.x = pk2(v[0], v[1]); w.y = pk2(v[2], v[3]);
        *(v2u*)(dst + 4 * (lane + 64 * j)) = w;
    }
    return wave_sum(ss);
}
__device__ __forceinline__ void cvt_bulk(const float* __restrict__ src, bf16* __restrict__ dst, size_t n8, size_t gt, size_t ngt) {
    for (size_t i = gt; i < n8; i += ngt) {
        const f32x4 a = __builtin_nontemporal_load((const f32x4*)(src + i * 8)), b = __builtin_nontemporal_load((const f32x4*)(src + i * 8 + 4));
        v4u w; w.x = pk2(a[0], a[1]); w.y = pk2(a[2], a[3]); w.z = pk2(b[0], b[1]); w.w = pk2(b[2], b[3]);
        *(v4u*)(dst + i * 8) = w;
    }
}

namespace att {
constexpr int SHM_V = 16384, SHM_K = 16384, SHM_R = 8192;
constexpr int OFF_V = 0, OFF_K = 2 * SHM_V, OFF_R = OFF_K + 2 * SHM_K, OFF_WS = OFF_R + 2 * SHM_R, LDS_NEED = OFF_WS + NWAVES * 64 * 4;
#define KSWZ(row, colB) ((row) * 256 + ((colB) ^ (((row) & 7) << 4)))
#define RSWZ(row, colB) ((row) * 128 + ((colB) ^ (((row) & 7) << 4)))
#define SBAR() __builtin_amdgcn_sched_barrier(0)
__device__ __forceinline__ int crow(int r, int hi) { return (r & 3) + 8 * (r >> 2) + 4 * hi; }
__device__ __forceinline__ unsigned cvtpk(float lo, float hi) { unsigned r; asm volatile("v_cvt_pk_bf16_f32 %0, %1, %2" : "=v"(r) : "v"(lo), "v"(hi)); return r; }

__device__ __forceinline__ void partialSM(f32x16& p0, f32x16& p1, float& m_reg, float& mn, float& alpha, float C, float thr_s) {
    float pmax = p0[0];
#pragma unroll
    for (int r = 1; r < 16; ++r) pmax = fmaxf(pmax, p0[r]);
#pragma unroll
    for (int r = 0; r < 16; ++r) pmax = fmaxf(pmax, p1[r]);
    { auto rr = __builtin_amdgcn_permlane32_swap(__float_as_uint(pmax), __float_as_uint(pmax), false, false);
      pmax = fmaxf(__uint_as_float(rr[0]), __uint_as_float(rr[1])); }
    if (__builtin_expect(__all(pmax - m_reg <= thr_s), 1)) { mn = m_reg; alpha = 1.f; }
    else { mn = fmaxf(m_reg, pmax); alpha = __builtin_amdgcn_exp2f((m_reg - mn) * C); m_reg = mn; }
    const float mnC = -mn * C;
#pragma unroll
    for (int r = 0; r < 16; ++r) p0[r] = fmaf(p0[r], C, mnC);
#pragma unroll
    for (int r = 0; r < 16; ++r) p1[r] = fmaf(p1[r], C, mnC);
#pragma unroll
    for (int r = 0; r < 16; ++r) p0[r] = __builtin_amdgcn_exp2f(p0[r]);
}
__device__ __forceinline__ void finishSM(f32x16& p0, f32x16& p1, float alpha, float& l_reg, bf16x8& pa0, bf16x8& pa1, bf16x8& pa2, bf16x8& pa3) {
#pragma unroll
    for (int r = 0; r < 16; ++r) p1[r] = __builtin_amdgcn_exp2f(p1[r]);
    float ps = 0;
#pragma unroll
    for (int r = 0; r < 16; ++r) ps += p0[r];
#pragma unroll
    for (int r = 0; r < 16; ++r) ps += p1[r];
    { auto rr = __builtin_amdgcn_permlane32_swap(__float_as_uint(ps), __float_as_uint(ps), false, false);
      ps = __uint_as_float(rr[0]) + __uint_as_float(rr[1]); }
    l_reg = l_reg * alpha + ps;
#define PK4(P, BASE, OUT) do { unsigned a0 = cvtpk(P[BASE + 0], P[BASE + 1]), a1 = cvtpk(P[BASE + 2], P[BASE + 3]);   \
    unsigned b0 = cvtpk(P[BASE + 4], P[BASE + 5]), b1 = cvtpk(P[BASE + 6], P[BASE + 7]);                              \
    auto r0 = __builtin_amdgcn_permlane32_swap(a0, b0, false, false); auto r1 = __builtin_amdgcn_permlane32_swap(a1, b1, false, false); \
    v4u w = {r0[0], r1[0], r0[1], r1[1]}; OUT = *reinterpret_cast<bf16x8*>(&w); } while (0)
    PK4(p0, 0, pa0); PK4(p0, 8, pa1); PK4(p1, 0, pa2); PK4(p1, 8, pa3);
#undef PK4
}
template <int DR>
__device__ __forceinline__ void qkt(f32x16& p0, f32x16& p1, const LAS unsigned char* Ks, const LAS unsigned char* Rs, const bf16x8* qr, const bf16x8* qrr, int r32, int hi) {
    p0 = f32x16{}; p1 = f32x16{};
#pragma unroll
    for (int d0 = 0; d0 < 8; ++d0) { const int cb = (d0 * 16 + hi * 8) * 2;
        const bf16x8 b0 = *(const LAS bf16x8*)(Ks + KSWZ(r32, cb));
        const bf16x8 b1 = *(const LAS bf16x8*)(Ks + KSWZ(32 + r32, cb));
        p0 = __builtin_amdgcn_mfma_f32_32x32x16_bf16(b0, qr[d0], p0, 0, 0, 0);
        p1 = __builtin_amdgcn_mfma_f32_32x32x16_bf16(b1, qr[d0], p1, 0, 0, 0); }
    if constexpr (DR > 0) {
#pragma unroll
        for (int d0 = 0; d0 < DR / 16; ++d0) { const int cb = (d0 * 16 + hi * 8) * 2;
            const bf16x8 b0 = *(const LAS bf16x8*)(Rs + RSWZ(r32, cb));
            const bf16x8 b1 = *(const LAS bf16x8*)(Rs + RSWZ(32 + r32, cb));
            p0 = __builtin_amdgcn_mfma_f32_32x32x16_bf16(b0, qrr[d0], p0, 0, 0, 0);
            p1 = __builtin_amdgcn_mfma_f32_32x32x16_bf16(b1, qrr[d0], p1, 0, 0, 0); }
    }
}
__device__ __forceinline__ void mask_tile(f32x16& p0, f32x16& p1, int tile, int kmax, int hi) {
    const int kb = tile * 64;
    if (kb + 64 > kmax) {
#pragma unroll
        for (int r = 0; r < 16; ++r) { const int k0 = kb + crow(r, hi); if (k0 >= kmax) p0[r] = -1e30f; if (k0 + 32 >= kmax) p1[r] = -1e30f; }
    }
}
__device__ __forceinline__ int v_st(int k, int c) { const int kk = (k & ~0xC) | ((k & 4) << 1) | ((k & 8) >> 1); return ((kk >> 3) * 4 + (c >> 5)) * 512 + ((kk & 7) * 32 + (c & 31)) * 2; }
__device__ __forceinline__ int v_rd_base(int lane) { return ((lane & 3) << 3) | (((lane >> 2) & 3) << 6) | (((lane >> 4) & 1) << 5) | (((lane >> 5) & 1) << 8); }
constexpr int v_rd_off(int d0, int ks, int half) { return d0 * 512 + ks * 4096 + half * 2048; }
template <int OFF> __device__ __forceinline__ s16x4 tr_read(int vb) {
    s16x4 r; asm volatile("ds_read_b64_tr_b16 %0, %1 offset:%2" : "=&v"(r) : "v"(vb), "i"(OFF) : "memory"); return r;
}
template <int D0> __device__ __forceinline__ void pv_one(f32x16& od, int vb, bf16x8 pa0, bf16x8 pa1, bf16x8 pa2, bf16x8 pa3) {
    const s16x4 l0 = tr_read<v_rd_off(D0, 0, 0)>(vb), h0 = tr_read<v_rd_off(D0, 0, 1)>(vb), l1 = tr_read<v_rd_off(D0, 1, 0)>(vb), h1 = tr_read<v_rd_off(D0, 1, 1)>(vb);
    const s16x4 l2 = tr_read<v_rd_off(D0, 2, 0)>(vb), h2 = tr_read<v_rd_off(D0, 2, 1)>(vb), l3 = tr_read<v_rd_off(D0, 3, 0)>(vb), h3 = tr_read<v_rd_off(D0, 3, 1)>(vb);
    asm volatile("s_waitcnt lgkmcnt(0)" ::: "memory"); SBAR();
#define PK(L, H) (bf16x8){L[0], L[1], L[2], L[3], H[0], H[1], H[2], H[3]}
    od = __builtin_amdgcn_mfma_f32_32x32x16_bf16(pa0, PK(l0, h0), od, 0, 0, 0);
    od = __builtin_amdgcn_mfma_f32_32x32x16_bf16(pa1, PK(l1, h1), od, 0, 0, 0);
    od = __builtin_amdgcn_mfma_f32_32x32x16_bf16(pa2, PK(l2, h2), od, 0, 0, 0);
    od = __builtin_amdgcn_mfma_f32_32x32x16_bf16(pa3, PK(l3, h3), od, 0, 0, 0);
#undef PK
}
__device__ __forceinline__ void pv_d0(f32x16* o, int vb, bf16x8 pa0, bf16x8 pa1, bf16x8 pa2, bf16x8 pa3) {
    pv_one<0>(o[0], vb, pa0, pa1, pa2, pa3); pv_one<1>(o[1], vb, pa0, pa1, pa2, pa3); pv_one<2>(o[2], vb, pa0, pa1, pa2, pa3); pv_one<3>(o[3], vb, pa0, pa1, pa2, pa3);
}

template <int DR, bool PP, bool NTL, class KN, class KR, class VV>
__device__ __forceinline__ void attn_unit(LAS unsigned char* lds, const bf16* qn, const bf16* qrp, KN kn, KR kr, VV vv, int NT, int kmax, float C, float thr_s,
                                          bf16* orow0, int ldo, int nvalid, bool active, int wave_id) {
    const int wid = wave_id, lane = lane_id(), tid = wid * 64 + lane, r32 = lane & 31, hi = lane >> 5;
    LAS unsigned char* V_lds = lds + OFF_V; LAS unsigned char* K_lds = lds + OFF_K; LAS unsigned char* R_lds = lds + OFF_R;
    LAS float* ws = (LAS float*)(lds + OFF_WS) + wid * 64; LAS float* li_l = ws; LAS float* al_l = ws + 32;
    float m_reg = -1e30f, l_reg = 0.f; f32x16 o[4] = {}; bf16x8 qr[8]; bf16x8 qrr[DR > 0 ? DR / 16 : 1];
#pragma unroll
    for (int d0 = 0; d0 < 8; ++d0) qr[d0] = *(const bf16x8*)(qn + d0 * 16 + hi * 8);
    if constexpr (DR > 0) {
#pragma unroll
        for (int d0 = 0; d0 < DR / 16; ++d0) qrr[d0] = *(const bf16x8*)(qrp + d0 * 16 + hi * 8);
    }
    const int sr = tid >> 4, sc = (tid & 15) * 8, vst0 = v_st(sr, sc), vst1 = v_st(32 + sr, sc), rr_ = tid >> 3, rc = (tid & 7) * 8;
    const int vb0 = (int)(unsigned)(uintptr_t)V_lds + v_rd_base(lane);
    bf16x8 s_vs0, s_vs1, s_ks0, s_ks1, s_rs;
    const bf16x8 zero8 = {0, 0, 0, 0, 0, 0, 0, 0};
#define ATT_LD8(p) (NTL ? __builtin_nontemporal_load((const bf16x8*)(p)) : *(const bf16x8*)(p))
#define SLOAD(k0) do { const bf16* _p; _p = vv((k0) + sr); s_vs0 = _p ? ATT_LD8(_p + sc) : zero8; _p = vv((k0) + 32 + sr); s_vs1 = _p ? ATT_LD8(_p + sc) : zero8; \
    _p = kn((k0) + sr); s_ks0 = _p ? ATT_LD8(_p + sc) : zero8; _p = kn((k0) + 32 + sr); s_ks1 = _p ? ATT_LD8(_p + sc) : zero8; \
    if constexpr (DR > 0) { _p = kr((k0) + rr_); s_rs = _p ? ATT_LD8(_p + rc) : zero8; } } while (0)
#define SWRITE(b) do { *(LAS bf16x8*)(V_lds + (b) * SHM_V + vst0) = s_vs0; *(LAS bf16x8*)(V_lds + (b) * SHM_V + vst1) = s_vs1; \
    *(LAS bf16x8*)(K_lds + (b) * SHM_K + KSWZ(sr, sc * 2)) = s_ks0; *(LAS bf16x8*)(K_lds + (b) * SHM_K + KSWZ(32 + sr, sc * 2)) = s_ks1; \
    if constexpr (DR > 0) { *(LAS bf16x8*)(R_lds + (b) * SHM_R + RSWZ(rr_, rc * 2)) = s_rs; } } while (0)
#define SWAIT() asm volatile("s_waitcnt vmcnt(0)" ::: "memory")
#define RESC(a) do { if (__any((a) < 1.f)) { if (hi == 0) al_l[r32] = (a); asm volatile("s_waitcnt lgkmcnt(0)" ::: "memory"); \
    _Pragma("unroll") for (int d = 0; d < 4; ++d) _Pragma("unroll") for (int r = 0; r < 16; ++r) o[d][r] *= al_l[crow(r, hi)]; } } while (0)
    f32x16 p0, p1; float mn, al = 1.f; bf16x8 pa0, pa1, pa2, pa3;
    SLOAD(0); SWAIT(); SWRITE(0); if (!PP && 1 < NT) SLOAD(64); __syncthreads();
    if constexpr (PP) {
        const bool grpA = wid < 4;
#define ATT_STAGE(j) do { if ((j) + 1 < NT) { SWAIT(); SWRITE(((j) + 1) & 1); if ((j) + 2 < NT) SLOAD(((j) + 2) * 64); } } while (0)
        if (1 < NT) SLOAD(64);
        if (!grpA) __syncthreads();
        for (int j = 0; j < NT; ++j) {
            SBAR();
            qkt<DR>(p0, p1, K_lds + (j & 1) * SHM_K, R_lds + (j & 1) * SHM_R, qr, qrr, r32, hi); mask_tile(p0, p1, j, kmax, hi);
            if (!grpA) ATT_STAGE(j);
            __syncthreads();
            partialSM(p0, p1, m_reg, mn, al, C, thr_s); RESC(al); finishSM(p0, p1, al, l_reg, pa0, pa1, pa2, pa3); SBAR();
            pv_d0(o, vb0 + (j & 1) * SHM_V, pa0, pa1, pa2, pa3);
            if (grpA) ATT_STAGE(j);
            __syncthreads();
        }
        if (grpA) __syncthreads();
#undef ATT_STAGE
    } else {
    for (int j = 0; j < NT; ++j) {
        const int bsel = j & 1;
        if (j + 1 < NT) { SWAIT(); SWRITE(bsel ^ 1); if (j + 2 < NT) SLOAD((j + 2) * 64); }
        SBAR();
        if (active) {
            qkt<DR>(p0, p1, K_lds + bsel * SHM_K, R_lds + bsel * SHM_R, qr, qrr, r32, hi); mask_tile(p0, p1, j, kmax, hi);
            partialSM(p0, p1, m_reg, mn, al, C, thr_s);
            RESC(al);
            finishSM(p0, p1, al, l_reg, pa0, pa1, pa2, pa3); SBAR();
            pv_d0(o, vb0 + bsel * SHM_V, pa0, pa1, pa2, pa3);
        }
        __syncthreads();
    }
    }
    if (active) {
        if (hi == 0) li_l[r32] = l_reg; asm volatile("s_waitcnt lgkmcnt(0)" ::: "memory");
#pragma unroll
        for (int r = 0; r < 16; ++r) { const int orow = crow(r, hi); const float rli = __builtin_amdgcn_rcpf(li_l[orow]);
            if (orow < nvalid) {
#pragma unroll
                for (int d0 = 0; d0 < 4; ++d0) orow0[(size_t)orow * ldo + d0 * 32 + r32] = (bf16)f2bf(o[d0][r] * rli); } }
    }
    __syncthreads();
#undef SLOAD
#undef ATT_LD8
#undef SWRITE
#undef SWAIT
#undef RESC
}
}

namespace scan {
constexpr int PC = 136, PT = 72, PH = 264;
constexpr int O_BV = 0, O_XT = 16384, O_XW = O_XT + 4096, O_CS = O_XW + 4096, O_BS = O_CS + 64 * PC * 2, O_GS = O_BS + 64 * PC * 2,
              O_HT = O_GS + 64 * PT * 2, O_YS = O_HT + 32 * PH * 2, O_XSF = O_YS + 64 * 33 * 4, O_ZS = O_XSF + 64 * 32 * 4, O_CUM = O_ZS + 64 * 32 * 4,
              O_DTL = O_CUM + 2 * 5 * 64 * 4, O_END = O_DTL + 8192 * 4;
static_assert(O_END <= MISC_OFF, "scan LDS");
struct Bufs { bf16 *T1, *ZG, *QK, *BC; const float* DT; float *SSQG, *SSQH; const float *alog, *dskip; };

__device__ __forceinline__ int v_st32(int k, int c) { const int kk = (k & ~0xC) | ((k & 4) << 1) | ((k & 8) >> 1); return (kk >> 3) * 512 + ((kk & 7) * 32 + c) * 2; }
#define TRPK(L, H) (bf16x8){L[0], L[1], L[2], L[3], H[0], H[1], H[2], H[3]}
#define TRKL(k) const s16x4 _al##k = att::tr_read<(2 * (k)) * 512>(xwb), _ah##k = att::tr_read<(2 * (k) + 1) * 512>(xwb), _bl##k = att::tr_read<(k) * 4096>(bvb), _bh##k = att::tr_read<(k) * 4096 + 2048>(bvb)
#define TRKM(k) hacc = __builtin_amdgcn_mfma_f32_32x32x16_bf16(TRPK(_al##k, _ah##k), TRPK(_bl##k, _bh##k), hacc, 0, 0, 0)
#define TRYL(k) const bf16x8 _ya##k = frag(GS, PT, 32 * ti + r32, 16 * (k) + 8 * hi); const s16x4 _yl##k = att::tr_read<(2 * (k)) * 512>(xtb), _yh##k = att::tr_read<(2 * (k) + 1) * 512>(xtb)
#define TRYM(k) gacc = __builtin_amdgcn_mfma_f32_32x32x16_bf16(_ya##k, TRPK(_yl##k, _yh##k), gacc, 0, 0, 0)
__device__ __forceinline__ bf16x8 frag(const LAS unsigned char* base, int pitch, int row, int k0) { return *(const LAS bf16x8*)(base + (row * pitch + k0) * 2); }

template <bool SSD>
__device__ __forceinline__ void scan_unit(LAS unsigned char* lds, const Bufs& B, int rowbase, int nchunks, int tv_last, int h, int sl,
                                          const float* h0, float* hout, int wave_id) {
    constexpr int NS = SSD ? 128 : 256, NH = NS / 128, PF = SSD ? 64 : 256, PHT = NS + 8;
    const int wid = wave_id, lane = lane_id(), tid = wid * 64 + lane, r32 = lane & 31, hi = lane >> 5;
    LAS unsigned char* CS = lds + O_CS; LAS unsigned char* BS = lds + O_BS; LAS unsigned char* BV = lds + O_BV; LAS unsigned char* XT = lds + O_XT;
    LAS unsigned char* XW = lds + O_XW; LAS unsigned char* GS = lds + O_GS; LAS unsigned char* HT = lds + O_HT;
    LAS float* YS = (LAS float*)(lds + O_YS); LAS float* XSF = (LAS float*)(lds + O_XSF); LAS float* ZS = (LAS float*)(lds + O_ZS);
    LAS float* DTL = (LAS float*)(lds + O_DTL);
    LAS float* CUMB = (LAS float*)(lds + O_CUM);
    const int g = h >> 3;
    const bool has_state = SSD ? (wid < 4) : true;
    const int n0 = wid * 32;
    const float a_h = SSD ? -__expf(B.alog[h]) : 0.f, lgam = SSD ? 0.f : LOG_GAMMA[h], dsk = SSD ? B.dskip[h] : 0.f;
    const int xcol = SSD ? h * 64 + sl * 32 : 2048 + h * 256 + sl * 32;
    const int isB = wid >> 2, tt = tid & 255;
    const bf16* cbsrc = SSD ? B.BC + (isB ? 0 : 512) + g * 128 : B.QK + (isB ? 2048 : 0) + h * 256; const int cbp = SSD ? 1024 : 4096;
    f32x16 hacc = {}, gacc = {};
    v4u rX = {0u, 0u, 0u, 0u}, rZ = {0u, 0u, 0u, 0u}, rCB[NH][4]; float rdt = 0.f;
    const v4u zero4 = {0u, 0u, 0u, 0u};
#define SC_SYNC() do { asm volatile("s_waitcnt lgkmcnt(0)" ::: "memory"); __builtin_amdgcn_s_barrier(); asm volatile("" ::: "memory"); } while (0)
#define SC_TV(c) (((c) == nchunks - 1) ? tv_last : 64)
#define SC_LOAD_X(c) do { const int _tv = SC_TV(c); const size_t _R0 = (size_t)rowbase + (size_t)(c) * 64; if (tid < 256) { const int _l = tid >> 2, _c8 = (tid & 3) * 8; \
        rX = _l < _tv ? *(const v4u*)(B.T1 + (_R0 + _l) * 4096 + xcol + _c8) : zero4; if (SSD) rZ = _l < _tv ? *(const v4u*)(B.ZG + (_R0 + _l) * 4096 + xcol + _c8) : zero4; } } while (0)
#define SC_LOAD_CB(c, nh) do { const int _tv = SC_TV(c); const size_t _R0 = (size_t)rowbase + (size_t)(c) * 64; _Pragma("unroll") for (int _i = 0; _i < 4; ++_i) { const int _id = tt + 256 * _i, _row = _id >> 4, _oct = _id & 15; \
        rCB[nh][_i] = _row < _tv ? *(const v4u*)(cbsrc + (_R0 + _row) * cbp + (nh) * 128 + _oct * 8) : zero4; } } while (0)
#define SC_LOAD_DT(c) do { if (SSD && wid == 0) rdt = lane < SC_TV(c) ? DTL[(c) * 64 + lane] : 0.f; } while (0)
#define SC_CUM(c) do { if (wid == 0) { LAS float* _cb = CUMB + ((c) & 1) * 320; const float _la = SSD ? rdt * a_h : (lane < SC_TV(c) ? lgam : 0.f); float _cum = _la; \
        _Pragma("unroll") for (int _o = 1; _o < 64; _o <<= 1) { const float _t = __shfl_up(_cum, _o); if (lane >= _o) _cum += _t; } \
        const float _last = __shfl(_cum, 63); _cb[lane] = _cum; _cb[64 + lane] = __expf(_cum); _cb[128 + lane] = __expf(_last - _cum); _cb[192 + lane] = rdt; if (lane == 0) _cb[256] = __expf(_last); } } while (0)
#define SC_STAGE(c, nh) do { const LAS float* _cb = CUMB + ((c) & 1) * 320; \
        if ((nh) == 0 && tid < 256) { const int _l = tid >> 2, _c8 = (tid & 3) * 8; const float _dtl = SSD ? _cb[192 + _l] : 1.f, _wdl = _cb[128 + _l]; \
            const float _x[8] = {bflo(rX.x), bfhi(rX.x), bflo(rX.y), bfhi(rX.y), bflo(rX.z), bfhi(rX.z), bflo(rX.w), bfhi(rX.w)}; \
            float _X[8], _W[8]; _Pragma("unroll") for (int _i = 0; _i < 8; ++_i) { _X[_i] = _x[_i] * _dtl; _W[_i] = _X[_i] * _wdl; if (SSD) XSF[_l * 32 + _c8 + _i] = _x[_i]; } \
            { v4u _q; _q.x = pk2(_X[0], _X[1]); _q.y = pk2(_X[2], _X[3]); _q.z = pk2(_X[4], _X[5]); _q.w = pk2(_X[6], _X[7]); *(LAS v4u*)(XT + v_st32(_l, _c8)) = _q; \
              _q.x = pk2(_W[0], _W[1]); _q.y = pk2(_W[2], _W[3]); _q.z = pk2(_W[4], _W[5]); _q.w = pk2(_W[6], _W[7]); *(LAS v4u*)(XW + v_st32(_l, _c8)) = _q; } \
            if (SSD) { LAS float* _zs = ZS + _l * 32 + _c8; _zs[0] = bflo(rZ.x); _zs[1] = bfhi(rZ.x); _zs[2] = bflo(rZ.y); _zs[3] = bfhi(rZ.y); _zs[4] = bflo(rZ.z); _zs[5] = bfhi(rZ.z); _zs[6] = bflo(rZ.w); _zs[7] = bfhi(rZ.w); } } \
        { LAS unsigned char* _dst = isB ? BS : CS; \
          _Pragma("unroll") for (int _i = 0; _i < 4; ++_i) { const int _id = tt + 256 * _i, _row = _id >> 4, _oct = _id & 15; const v4u _w = rCB[nh][_i]; \
            *(LAS v4u*)(_dst + (_row * PC + _oct * 8) * 2) = _w; \
            if (isB) *(LAS v4u*)(BV + att::v_st(_row, _oct * 8)) = _w; } } \
        if ((c) + 1 < nchunks && (nh) == NH - 1) { SC_LOAD_X((c) + 1); _Pragma("unroll") for (int _hh = 0; _hh < NH; ++_hh) SC_LOAD_CB((c) + 1, _hh); } } while (0)

    if (SSD) { const int nrows = (nchunks - 1) * 64 + tv_last; for (int i = tid; i < nrows; i += 512) DTL[i] = B.DT[((size_t)rowbase + i) * 32 + h]; }
    __syncthreads();
    SC_LOAD_DT(0); SC_LOAD_X(0);
#pragma unroll
    for (int nh = 0; nh < NH; ++nh) SC_LOAD_CB(0, nh);
    if (has_state) {
        if (h0 != nullptr) {
#pragma unroll
            for (int q = 0; q < 4; ++q) { const f32x4 v = *(const f32x4*)(h0 + (size_t)(n0 + r32) * PF + sl * 32 + 8 * q + 4 * hi);
                hacc[4 * q + 0] = v[0]; hacc[4 * q + 1] = v[1]; hacc[4 * q + 2] = v[2]; hacc[4 * q + 3] = v[3]; }
        }
#pragma unroll
        for (int r = 0; r < 16; ++r) *(LAS bf16*)(HT + (att::crow(r, hi) * PHT + n0 + r32) * 2) = (bf16)f2bf(hacc[r]);
    }
    SC_CUM(0); if (nchunks > 1) SC_LOAD_DT(1);
    SC_SYNC();
    SC_STAGE(0, 0);
    for (int c = 0; c < nchunks; ++c) {
        const int R0 = rowbase + c * 64, tv = SC_TV(c);
        const LAS float* cb = CUMB + (c & 1) * 320;
#pragma unroll
        for (int nh = 0; nh < NH; ++nh) {
            if (nh > 0) { SC_SYNC(); SC_STAGE(c, nh); }
            SC_SYNC();
            if (wid < 4) {
                const int ti = wid >> 1, tj = wid & 1;
#pragma unroll
                for (int kb = 0; kb < 2; ++kb) { bf16x8 fa[4], fb[4];
#pragma unroll
                    for (int q = 0; q < 4; ++q) { const int k0 = 16 * (4 * kb + q) + 8 * hi; fa[q] = frag(CS, PC, 32 * ti + r32, k0); fb[q] = frag(BS, PC, 32 * tj + r32, k0); }
                    asm volatile("s_waitcnt lgkmcnt(0)" ::: "memory"); __builtin_amdgcn_sched_barrier(0);
#pragma unroll
                    for (int q = 0; q < 4; ++q) gacc = __builtin_amdgcn_mfma_f32_32x32x16_bf16(fa[q], fb[q], gacc, 0, 0, 0); }
            } else if (wid < 6) {
                const int ti = wid - 4;
#pragma unroll
                for (int kb = 0; kb < 2; ++kb) { bf16x8 fa[4], fb[4];
#pragma unroll
                    for (int q = 0; q < 4; ++q) { const int k0 = 16 * (4 * kb + q) + 8 * hi; fa[q] = frag(CS, PC, 32 * ti + r32, k0); fb[q] = frag(HT, PHT, r32, nh * 128 + k0); }
                    asm volatile("s_waitcnt lgkmcnt(0)" ::: "memory"); __builtin_amdgcn_sched_barrier(0);
#pragma unroll
                    for (int q = 0; q < 4; ++q) gacc = __builtin_amdgcn_mfma_f32_32x32x16_bf16(fa[q], fb[q], gacc, 0, 0, 0); }
            }
            if (has_state && (wid >> 2) == nh) {
                const float el = cb[256];
#pragma unroll
                for (int r = 0; r < 16; ++r) hacc[r] *= el;
                { const int xwb = (int)(unsigned)(uintptr_t)XW + att::v_rd_base(lane), bvb = (int)(unsigned)(uintptr_t)BV + att::v_rd_base(lane) + (wid & 3) * 512;
                  TRKL(0); TRKL(1); TRKL(2); TRKL(3);
                  asm volatile("s_waitcnt lgkmcnt(0)" ::: "memory"); __builtin_amdgcn_sched_barrier(0);
                  TRKM(0); TRKM(1); TRKM(2); TRKM(3); }
            }
        }
        if (wid < 4) { const int ti = wid >> 1, tj = wid & 1, s = 32 * tj + r32; const float cs = cb[s];
#pragma unroll
            for (int q = 0; q < 4; ++q) { const f32x4 cl4 = *(const LAS f32x4*)(cb + 32 * ti + 8 * q + 4 * hi);
#pragma unroll
                for (int e = 0; e < 4; ++e) { const int r = 4 * q + e, l = 32 * ti + att::crow(r, hi);
                    const float ex = __expf(fminf(cl4[e] - cs, 0.f)); const float v = l >= s ? gacc[r] * ex : 0.f;
                    *(LAS bf16*)(GS + (l * PT + s) * 2) = (bf16)f2bf(v); gacc[r] = 0.f; } } }
        SC_SYNC();
        if (wid >= 4 && wid < 6) { const int ti = wid - 4;
#pragma unroll
            for (int q = 0; q < 4; ++q) { const f32x4 e4 = *(const LAS f32x4*)(cb + 64 + 32 * ti + 8 * q + 4 * hi);
                gacc[4 * q + 0] *= e4[0]; gacc[4 * q + 1] *= e4[1]; gacc[4 * q + 2] *= e4[2]; gacc[4 * q + 3] *= e4[3]; }
            { const int xtb = (int)(unsigned)(uintptr_t)XT + att::v_rd_base(lane);
              TRYL(0); TRYL(1); TRYL(2); TRYL(3);
              asm volatile("s_waitcnt lgkmcnt(0)" ::: "memory"); __builtin_amdgcn_sched_barrier(0);
              TRYM(0); TRYM(1); TRYM(2); TRYM(3); }
            float xs_[16], zs_[16];
            if (SSD) {
#pragma unroll
                for (int r = 0; r < 16; ++r) { const int l = 32 * ti + att::crow(r, hi); xs_[r] = XSF[l * 32 + r32]; zs_[r] = ZS[l * 32 + r32]; } }
#pragma unroll
            for (int r = 0; r < 16; ++r) { const int l = 32 * ti + att::crow(r, hi); float y = gacc[r];
                if (SSD) y = (y + dsk * xs_[r]) * silu_f(zs_[r]);
                YS[l * 33 + r32] = y; gacc[r] = 0.f; } }
        if (has_state) {
#pragma unroll
            for (int r = 0; r < 16; ++r) *(LAS bf16*)(HT + (att::crow(r, hi) * PHT + n0 + r32) * 2) = (bf16)f2bf(hacc[r]); }
        if (c + 1 < nchunks) { SC_CUM(c + 1); if (c + 2 < nchunks) SC_LOAD_DT(c + 2); }
        SC_SYNC();
        if (c + 1 < nchunks) SC_STAGE(c + 1, 0);
        { const int l = tid >> 3, p4 = (tid & 7) * 4; float v[4]; float ss = 0.f;
#pragma unroll
          for (int i = 0; i < 4; ++i) { v[i] = YS[l * 33 + p4 + i]; ss += v[i] * v[i]; }
          ss += __shfl_xor(ss, 1); ss += __shfl_xor(ss, 2); ss += __shfl_xor(ss, 4);
          if (l < tv) {
              v2u w; w.x = pk2(v[0], v[1]); w.y = pk2(v[2], v[3]);
              *(v2u*)(B.T1 + (size_t)(R0 + l) * 4096 + xcol + p4) = w;
              if ((tid & 7) == 0) { if (SSD) B.SSQG[(size_t)(R0 + l) * 64 + g * 16 + (h & 7) * 2 + sl] = ss; else B.SSQH[(size_t)(R0 + l) * 64 + h * 8 + sl] = ss; }
          } }
    }
    if (has_state) {
#pragma unroll
        for (int q = 0; q < 4; ++q) { f32x4 v; v[0] = hacc[4 * q + 0]; v[1] = hacc[4 * q + 1]; v[2] = hacc[4 * q + 2]; v[3] = hacc[4 * q + 3];
            *(f32x4*)(hout + (size_t)(n0 + r32) * PF + sl * 32 + 8 * q + 4 * hi) = v; }
    }
    __syncthreads();
#undef SC_SYNC
#undef SC_TV
#undef SC_LOAD_X
#undef SC_LOAD_CB
#undef SC_LOAD_DT
#undef SC_CUM
#undef SC_STAGE
}
}

constexpr int N_PHASES = 37;
constexpr size_t S_HB = S_L0END;
static_assert(S_HB + (size_t)512 * 3 * 3072 * 2 <= S_MAX || true, "");
static_assert(O_SCR + S_HB + (size_t)512 * 3 * 3072 * 2 <= (size_t)1476395008, "halo buffer inside the workspace");

struct Ctx { LAS unsigned char* lds; unsigned char* ws; float* out; int G, wg, wave; };
#define CTX_GW() const int gw = C.wg * NWAVES + C.wave, NGW = C.G * NWAVES
#define CTX_GT() const size_t gt = (size_t)C.wg * (NWAVES * 64) + C.wave * 64 + lane_id(), NGT = (size_t)C.G * (NWAVES * 64)
#define W_SSQ ((u64*)(C.ws + O_SSQ))
#define W_XB ((bf16*)(C.ws + O_XB))
#define W_X (C.out + OUT_Y)
#define W_SCR (C.ws + O_SCR)

__device__ __forceinline__ void ph_prologue(const Ctx& C, const Params& P) {
    CTX_GW(); CTX_GT(); unsigned char* ws = C.ws; const int lane = lane_id();
    LAS float* wscr = (LAS float*)(C.lds + C.wave * 16384);
#pragma unroll 1
    for (int lf = 0; lf < 4; ++lf) {
        const int l = lf >> 1, f = lf & 1;
        cvt_weight(P.in[I_W1] + (size_t)lf * D * 2 * DFF, D, 2 * DFF, P.in[I_NORMS] + (l * 4 + (f ? 3 : 0)) * D, D, (bf16*)(ws + O_W1 + lf * SZ_W1), 2 * DFF, SmW1{}, wscr, gw, NGW, lane);
        cvt_weight(P.in[I_W2] + (size_t)lf * DFF * D, DFF, D, nullptr, 0, (bf16*)(ws + O_W2 + lf * SZ_W2), D, SmId{D}, wscr, gw, NGW, lane);
    }
    cvt_weight(P.in[I_ABWIN], D, 13344, P.in[I_NORMS] + 1 * D, D, (bf16*)(ws + O_WIN), WIN_N, SmWin{}, wscr, gw, NGW, lane);
    cvt_weight(P.in[I_ABWOUT], 4096, D, P.in[I_SSDN], 2048, (bf16*)(ws + O_WOUT), D, SmId{D}, wscr, gw, NGW, lane);
    cvt_weight(P.in[I_CWIN], D, 1088, P.in[I_NORMS] + (4 + 1) * D, D, (bf16*)(ws + O_CWIN), CWIN_N, SmId{1088}, wscr, gw, NGW, lane);
    cvt_weight(P.in[I_WUQ], 512, 3072, nullptr, 0, (bf16*)(ws + O_WUQ), 3072, SmUq{}, wscr, gw, NGW, lane);
    cvt_weight(P.in[I_WUK], 512, 2048, nullptr, 0, (bf16*)(ws + O_WKV), 2048, SmId{2048}, wscr, gw, NGW, lane);
    cvt_weight(P.in[I_WUV], 512, 2048, nullptr, 0, (bf16*)(ws + O_WKV) + (size_t)2048 * 512, 2048, SmId{2048}, wscr, gw, NGW, lane);
    cvt_weight(P.in[I_CWOUT], D, D, nullptr, 0, (bf16*)(ws + O_CWOUT), D, SmId{D}, wscr, gw, NGW, lane);
#pragma unroll 1
    for (int l = 0; l < 2; ++l) {
        cvt_weight(P.in[I_WMQ] + (size_t)l * D * 512, D, 512, P.in[I_NORMS] + (l * 4 + 2) * D, D, (bf16*)(ws + O_WMQ) + (size_t)l * 512 * D, 512, SmId{512}, wscr, gw, NGW, lane);
        cvt_weight(P.in[I_WMKV] + (size_t)l * D * 1024, D, 1024, P.in[I_MNORM] + l * D, D, (bf16*)(ws + O_WMKV) + (size_t)l * 1024 * D, 1024, SmId{1024}, wscr, gw, NGW, lane);
        cvt_weight(P.in[I_WMO] + (size_t)l * 512 * D, 512, D, nullptr, 0, (bf16*)(ws + O_WMO) + (size_t)l * D * 512, D, SmId{D}, wscr, gw, NGW, lane);
    }
    u64* SSQ = W_SSQ; bf16* XB = W_XB;
    for (int row = gw; row < M; row += NGW) {
        const float* src = row < MP ? P.in[I_XP] + (size_t)row * D : P.in[I_XS] + (size_t)(row - MP) * D;
        const float ss = row_to_bf16(src, XB + (size_t)row * XBP, lane);
        if (lane == 0) SSQ[row] = ssq_fix(ss);
    }
    { bf16* MB = (bf16*)(ws + O_MB); float* SSQM = (float*)(ws + O_SSQM);
      for (int row = gw; row < 1024; row += NGW) { const float ss = row_to_bf16(P.in[I_MEM] + (size_t)row * D, MB + (size_t)row * D, lane); if (lane == 0) SSQM[row] = ss; } }
    { float* COSR = (float*)(ws + O_COSR); float* SINR = (float*)(ws + O_SINR); float* COSM = (float*)(ws + O_COSM); float* SINM = (float*)(ws + O_SINM);
      for (size_t i = gt; i < (size_t)8192 * 160; i += NGT) {
        const int pos = (int)(i / 160), j = (int)(i % 160);
        const double inv = j < 128 ? INV_R[j] : INV_M[j - 128];
        const double t = (double)pos * inv * 0.15915494309189533577; const float fr = (float)(t - floor(t));
        const float sv = __builtin_amdgcn_sinf(fr), cv = __builtin_amdgcn_cosf(fr);
        if (j < 128) { COSR[(size_t)pos * 128 + j] = cv; SINR[(size_t)pos * 128 + j] = sv; } else { COSM[(size_t)pos * 32 + j - 128] = cv; SINM[(size_t)pos * 32 + j - 128] = sv; }
      } }
}

__device__ __forceinline__ void ph_w1(const Ctx& C, int lf) {
    const int L = lf >> 1, F = lf & 1;
    pg8::Gemm g{W_XB, (const bf16*)(C.ws + O_W1 + (size_t)lf * SZ_W1), M, 2 * DFF, D, XBP, D}; pg8::StaticOrder S = make_order(M, 2 * DFF, C.G, C.wg, 0);
    EpiSwiglu E{(bf16*)(W_SCR + S_H), W_SSQ + (size_t)(L * 4 + (F ? 3 : 0)) * M, C.lds};
    pg8::gemm_phase<EpiSwiglu, pg8::StaticOrder, true, true>(C.lds, g, S, E, C.wave);
    if (lf == 0) {
#pragma unroll 1
        for (int ml = 0; ml < 2; ++ml) {
            pg8::Gemm g2{(const bf16*)(C.ws + O_MB), (const bf16*)(C.ws + O_WMKV) + (size_t)ml * 1024 * D, 1024, 1024, D, D, D};
            pg8::StaticOrder S2 = make_order(1024, 1024, C.G, C.wg, (130 * 44) % 256 + 16 * ml);
            EpiMemKV E2{C.out + OUT_MEMK + (size_t)ml * 1024 * 512, C.out + OUT_MEMV + (size_t)ml * 1024 * 512, (bf16*)(C.ws + O_MKV) + (size_t)ml * 1024 * 1024, (const float*)(C.ws + O_SSQM)};
            pg8::gemm_phase<EpiMemKV, pg8::StaticOrder, true, true>(C.lds, g2, S2, E2, C.wave);
        }
    }
}

constexpr size_t S_PART_FFN = (size_t)384 << 20;
template <int KS, bool FIRST> __device__ __forceinline__ void res_gemm(const Ctx& C, const bf16* A, int lda, const bf16* Bt, int K, const float* src32, float alpha, u64* ssq_next, float* part) {
    { pg8::Gemm g{A, Bt, MP, D, K, lda, K}; pg8::StaticOrder S = make_order(MP, D, C.G, C.wg, 0);
      EpiRes<FIRST> E{src32, W_XB, ssq_next, alpha};
      pg8::gemm_phase<EpiRes<FIRST>, pg8::StaticOrder, true, true>(C.lds, g, S, E, C.wave); }
    { pg8::Gemm g{A + (size_t)MP * lda, Bt, MS, D, K, lda, K / KS}; SplitOrder S; S.init(MS, D, KS, C.G, C.wg);
      EpiPart E{part, D, (size_t)MS * D};
      pg8::gemm_phase<EpiPart, SplitOrder, true, true>(C.lds, g, S, E, C.wave); }
}
template <bool FIRST> __device__ __forceinline__ void ph_fin(const Ctx& C, const float* part, int KS, const float* src32, float alpha, u64* ssq_next) {
    CTX_GW(); const int lane = lane_id(); bf16* XB = W_XB;
    for (int it = gw; it < MS * 8; it += NGW) {
        const int r = it >> 3, c = (it & 7) * 256 + 4 * lane; const size_t o = (size_t)r * D + c;
        f32x4 a = *(const f32x4*)(part + o);
        for (int k = 1; k < KS; ++k) a += *(const f32x4*)(part + (size_t)k * MS * D + o);
        f32x4 s;
        if constexpr (FIRST) s = *(const f32x4*)(src32 + o); else { const v2u q = *(const v2u*)(XB + (size_t)(MP + r) * XBP + c); s = (f32x4){bflo(q.x), bfhi(q.x), bflo(q.y), bfhi(q.y)}; }
        const f32x4 v = s + a * alpha;
        v2u w; w.x = pk2(v[0], v[1]); w.y = pk2(v[2], v[3]); *(v2u*)(XB + (size_t)(MP + r) * XBP + c) = w;
        const float ss = wave_sum((v[0] * v[0] + v[1] * v[1]) + (v[2] * v[2] + v[3] * v[3]));
        if (lane == 0) ssq_add(ssq_next + MP + r, ss);
    }
}
template <bool FIRST> __device__ __forceinline__ void ph_w2(const Ctx& C, const Params& P, int lf) {
    const int L = lf >> 1, F = lf & 1;
    res_gemm<11, FIRST>(C, (const bf16*)(W_SCR + S_H), DFF, (const bf16*)(C.ws + O_W2 + (size_t)lf * SZ_W2), DFF, P.in[I_XP], 0.5f, W_SSQ + (size_t)(L * 4 + (F ? 4 : 1)) * M, (float*)(W_SCR + S_PART_FFN));
}
template <bool FIRST> __device__ __forceinline__ void ph_w2fin(const Ctx& C, const Params& P, int lf) {
    const int L = lf >> 1, F = lf & 1;
    ph_fin<FIRST>(C, (const float*)(W_SCR + S_PART_FFN), 11, P.in[I_XS], 0.5f, W_SSQ + (size_t)(L * 4 + (F ? 4 : 1)) * M);
}
__device__ __forceinline__ void ph_win(const Ctx& C, const Params& P) {
    pg8::Gemm g{W_XB, (const bf16*)(C.ws + O_WIN), M, WIN_N, D, XBP, D}; pg8::StaticOrder S = make_order(M, WIN_N, C.G, C.wg, 0);
    EpiWin E{(bf16*)(W_SCR + S_T1), (bf16*)(W_SCR + S_ZG), (bf16*)(W_SCR + S_QK), (bf16*)(W_SCR + S_BC), (float*)(W_SCR + S_DT), W_SSQ + (size_t)1 * M,
             (const float*)(C.ws + O_COSR), (const float*)(C.ws + O_SINR), P.in[I_DTB], C.lds};
    pg8::gemm_phase<EpiWin, pg8::StaticOrder, true, true>(C.lds, g, S, E, C.wave);
}
__device__ __forceinline__ const bf16* xbc_ptr(const bf16* T1, const bf16* BC, size_t row, int ch) { return ch < 2048 ? T1 + row * 4096 + ch : BC + row * 1024 + (ch - 2048); }
__device__ __forceinline__ void ph_halo(const Ctx& C) {
    CTX_GT(); const bf16* T1 = (const bf16*)(W_SCR + S_T1); const bf16* BC = (const bf16*)(W_SCR + S_BC); bf16* HB = (bf16*)(W_SCR + S_HB);
    for (size_t i = gt; i < (size_t)NBP * 128 * 3 * 384; i += NGT) {
        const int oct = (int)(i % 384), j = (int)((i / 384) % 3), cc = (int)(i / 1152), c = cc & 127, b = cc >> 7;
        if (c == 0) continue;
        const size_t row = (size_t)b * SEQ + c * 64 - 3 + j;
        *(v4u*)(HB + ((size_t)cc * 3 + j) * 3072 + oct * 8) = *(const v4u*)xbc_ptr(T1, BC, row, oct * 8);
    }
    for (size_t i = gt; i < (size_t)(NBP + NBS) * 3 * 384; i += NGT) {
        const int oct = (int)(i % 384), j = (int)((i / 384) % 3), b = (int)(i / 1152);
        const size_t row = b < NBP ? (size_t)b * SEQ + SEQ - 3 + j : (size_t)MP + (b - NBP) * TS + TS - 3 + j;
        float* o = b < NBP ? C.out + OUT_CONVP + (size_t)(b * 3 + j) * 3072 + oct * 8 : C.out + OUT_CONVS + (size_t)((b - NBP) * 3 + j) * 3072 + oct * 8;
        const v4u w = *(const v4u*)xbc_ptr(T1, BC, row, oct * 8);
        *(f32x4*)o = (f32x4){bflo(w.x), bfhi(w.x), bflo(w.y), bfhi(w.y)}; *(f32x4*)(o + 4) = (f32x4){bflo(w.z), bfhi(w.z), bflo(w.w), bfhi(w.w)};
    }
}
__device__ __forceinline__ void ph_conv(const Ctx& C, const Params& P) {
    CTX_GT(); bf16* T1 = (bf16*)(W_SCR + S_T1); bf16* BC = (bf16*)(W_SCR + S_BC); const bf16* HB = (const bf16*)(W_SCR + S_HB);
    const float* cwp = P.in[I_CONVW]; const float* cbp = P.in[I_CONVB]; const float* cst = P.in[I_SCONV];
    { float* DT = (float*)(W_SCR + S_DT); const float* dtb = P.in[I_DTB];
      for (size_t i = gt; i < (size_t)M * 32; i += NGT) { const float x = DT[i] + dtb[i & 31]; DT[i] = x > 20.f ? x : log1pf(__expf(x)); } }
    for (size_t i = gt; i < (size_t)(NBP * 128 + NBS) * 384; i += NGT) {
        const int oct = (int)(i % 384), cc = (int)(i / 384), ch = oct * 8;
        float w0[8], w1[8], w2[8], cw[4][8], cb[8];
#pragma unroll
        for (int e = 0; e < 8; ++e) { cb[e] = cbp[ch + e];
#pragma unroll
            for (int j = 0; j < 4; ++j) cw[j][e] = cwp[j * 3072 + ch + e]; }
        size_t row0; int nrows;
        if (cc < NBP * 128) { const int c = cc & 127, b = cc >> 7; row0 = (size_t)b * SEQ + c * 64; nrows = 64;
            if (c == 0) {
#pragma unroll
                for (int e = 0; e < 8; ++e) { w0[e] = 0.f; w1[e] = 0.f; w2[e] = 0.f; }
            } else { const bf16* hb = HB + (size_t)cc * 3 * 3072 + ch; const v4u a = *(const v4u*)hb, b2 = *(const v4u*)(hb + 3072), c2 = *(const v4u*)(hb + 6144);
                w0[0] = bflo(a.x); w0[1] = bfhi(a.x); w0[2] = bflo(a.y); w0[3] = bfhi(a.y); w0[4] = bflo(a.z); w0[5] = bfhi(a.z); w0[6] = bflo(a.w); w0[7] = bfhi(a.w);
                w1[0] = bflo(b2.x); w1[1] = bfhi(b2.x); w1[2] = bflo(b2.y); w1[3] = bfhi(b2.y); w1[4] = bflo(b2.z); w1[5] = bfhi(b2.z); w1[6] = bflo(b2.w); w1[7] = bfhi(b2.w);
                w2[0] = bflo(c2.x); w2[1] = bfhi(c2.x); w2[2] = bflo(c2.y); w2[3] = bfhi(c2.y); w2[4] = bflo(c2.z); w2[5] = bfhi(c2.z); w2[6] = bflo(c2.w); w2[7] = bfhi(c2.w); }
        } else { const int b = cc - NBP * 128; row0 = (size_t)MP + b * TS; nrows = TS; const float* s = cst + (size_t)b * 3 * 3072 + ch;
#pragma unroll
            for (int e = 0; e < 8; ++e) { w0[e] = s[e]; w1[e] = s[3072 + e]; w2[e] = s[6144 + e]; } }
        bf16* p = (bf16*)xbc_ptr(T1, BC, row0, ch); const size_t pitch = ch < 2048 ? 4096 : 1024;
        for (int r0 = 0; r0 < nrows; r0 += 8) {
            v4u wr[8];
#pragma unroll
            for (int q = 0; q < 8; ++q) wr[q] = *(const v4u*)(p + (size_t)(r0 + q) * pitch);
#pragma unroll
            for (int q = 0; q < 8; ++q) { const v4u w = wr[q];
                const float cur[8] = {bflo(w.x), bfhi(w.x), bflo(w.y), bfhi(w.y), bflo(w.z), bfhi(w.z), bflo(w.w), bfhi(w.w)}; float o[8];
#pragma unroll
                for (int e = 0; e < 8; ++e) { o[e] = silu_f(cb[e] + cw[0][e] * w0[e] + cw[1][e] * w1[e] + cw[2][e] * w2[e] + cw[3][e] * cur[e]); w0[e] = w1[e]; w1[e] = w2[e]; w2[e] = cur[e]; }
                v4u qo; qo.x = pk2(o[0], o[1]); qo.y = pk2(o[2], o[3]); qo.z = pk2(o[4], o[5]); qo.w = pk2(o[6], o[7]);
                *(v4u*)(p + (size_t)(r0 + q) * pitch) = qo; }
        }
    }
}
__device__ __forceinline__ void ph_scan(const Ctx& C, const Params& P) {
    scan::Bufs B{(bf16*)(W_SCR + S_T1), (bf16*)(W_SCR + S_ZG), (bf16*)(W_SCR + S_QK), (bf16*)(W_SCR + S_BC), (const float*)(W_SCR + S_DT), (float*)(C.ws + O_SSQG), (float*)(C.ws + O_SSQH), P.in[I_ALOG], P.in[I_DSKIP]};
    float* out = C.out;
#pragma unroll 1
    for (int u = C.wg; u < 256 + 2048; u += C.G) {
        const bool pr = u < 256; const int v = pr ? u : u - 256, w = v & 255, bg = (v >> 8) * 16 + (w & 7) * 2 + (w >> 7), j = (w >> 3) & 15, b = bg >> 2, h = (bg & 3) * 8 + (j >> 1), sl = j & 1;
        const size_t so = (size_t)(b * 32 + h) * 128 * 64;
        scan::scan_unit<true>(C.lds, B, pr ? b * SEQ : MP + b * TS, pr ? SEQ / 64 : 1, pr ? 64 : TS, h, sl, pr ? nullptr : P.in[I_SSSD] + so, pr ? out + OUT_SSDP + so : out + OUT_SSDS + so, C.wave);
    }
#pragma unroll 1
    for (int u = C.wg; u < 256 + 2048; u += C.G) {
        const bool pr = u < 256; const int v = pr ? u : u - 256, w = v & 255, bh = (v >> 8) * 32 + (w & 7) * 4 + (w >> 6), b = bh >> 3, h = bh & 7, sl = (w >> 3) & 7;
        const size_t so = (size_t)(b * 8 + h) * 256 * 256;
        scan::scan_unit<false>(C.lds, B, pr ? b * SEQ : MP + b * TS, pr ? SEQ / 64 : 1, pr ? 64 : TS, h, sl, pr ? nullptr : P.in[I_SRET] + so, pr ? out + OUT_RETP + so : out + OUT_RETS + so, C.wave);
    }
}
__device__ __forceinline__ void ph_norm(const Ctx& C) {
    CTX_GW(); bf16* T1 = (bf16*)(W_SCR + S_T1); const bf16* ZG = (const bf16*)(W_SCR + S_ZG); const float* SSQG = (const float*)(C.ws + O_SSQG); const float* SSQH = (const float*)(C.ws + O_SSQH);
    const int lane = lane_id();
    for (int row = gw; row < M; row += NGW) {
        v4u w[8], gq[4]; float sc[8];
#pragma unroll
        for (int k = 0; k < 8; ++k) w[k] = *(const v4u*)(T1 + (size_t)row * 4096 + (k * 64 + lane) * 8);
#pragma unroll
        for (int k = 0; k < 4; ++k) gq[k] = *(const v4u*)(ZG + (size_t)row * 4096 + ((k + 4) * 64 + lane) * 8);
#pragma unroll
        for (int k = 0; k < 4; ++k) {
            const float* pg = SSQG + (size_t)row * 64 + k * 16; const f32x4 a0 = *(const f32x4*)pg, a1 = *(const f32x4*)(pg + 4), a2 = *(const f32x4*)(pg + 8), a3 = *(const f32x4*)(pg + 12);
            const f32x4 t = (a0 + a1) + (a2 + a3); sc[k] = rsqrtf(((t[0] + t[1]) + (t[2] + t[3])) * (1.0f / 512.f) + EPS);
            const float* ph = SSQH + (size_t)row * 64 + ((((k + 4) * 64 + lane) * 8 - 2048) >> 8) * 8; const f32x4 b0 = *(const f32x4*)ph, b1 = *(const f32x4*)(ph + 4);
            const f32x4 u = b0 + b1; sc[k + 4] = rsqrtf(((u[0] + u[1]) + (u[2] + u[3])) * (1.0f / 256.f) + EPS); }
#pragma unroll
        for (int k = 0; k < 8; ++k) {
            float x[8] = {bflo(w[k].x), bfhi(w[k].x), bflo(w[k].y), bfhi(w[k].y), bflo(w[k].z), bfhi(w[k].z), bflo(w[k].w), bfhi(w[k].w)};
            if (k < 4) {
#pragma unroll
                for (int i = 0; i < 8; ++i) x[i] *= sc[k];
            } else { const v4u q = gq[k - 4]; const float gv[8] = {bflo(q.x), bfhi(q.x), bflo(q.y), bfhi(q.y), bflo(q.z), bfhi(q.z), bflo(q.w), bfhi(q.w)};
#pragma unroll
                for (int i = 0; i < 8; ++i) x[i] = x[i] * sc[k] * silu_f(gv[i]); }
            v4u o; o.x = pk2(x[0], x[1]); o.y = pk2(x[2], x[3]); o.z = pk2(x[4], x[5]); o.w = pk2(x[6], x[7]);
            *(v4u*)(T1 + (size_t)row * 4096 + (k * 64 + lane) * 8) = o;
        }
    }
}
__device__ __forceinline__ void ph_wout(const Ctx& C) { res_gemm<16, false>(C, (const bf16*)(W_SCR + S_T1), 4096, (const bf16*)(C.ws + O_WOUT), 4096, nullptr, 1.0f, W_SSQ + (size_t)2 * M, (float*)(W_SCR + S_ZG)); }
__device__ __forceinline__ void ph_woutfin(const Ctx& C) { ph_fin<false>(C, (const float*)(W_SCR + S_ZG), 16, nullptr, 1.0f, W_SSQ + (size_t)2 * M); }
constexpr float MLA_SC = 0.07216878364870322f, MEM_SC = 0.08838834764831845f, LOG2E = 1.4426950408889634f;
__device__ __forceinline__ void ph_cwin(const Ctx& C, const Params& P) {
    CTX_GT();
    cvt_bulk(P.in[I_CCKV], (bf16*)(W_SCR + S_CKVPAST), (size_t)65536 * 512 / 8, gt, NGT);
    cvt_bulk(P.in[I_CKPE], (bf16*)(W_SCR + S_KPEPAST), (size_t)65536 * 64 / 8, gt, NGT);
    pg8::Gemm g{W_XB, (const bf16*)(C.ws + O_CWIN), M, CWIN_N, D, XBP, D}; pg8::StaticOrder S = make_order(M, CWIN_N, C.G, C.wg, 0);
    EpiF32 E{(float*)(W_SCR + S_CIN), CWIN_N, W_SSQ + (size_t)5 * M};
    pg8::gemm_phase<EpiF32, pg8::StaticOrder, true, true>(C.lds, g, S, E, C.wave);
}
__device__ __forceinline__ void ph_nr(const Ctx& C, const Params& P) {
    CTX_GW(); const int lane = lane_id(); float* out = C.out;
    const float* CIN = (const float*)(W_SCR + S_CIN); bf16* CQN = (bf16*)(W_SCR + S_CQN); bf16* CKVB = (bf16*)(W_SCR + S_CKVB); bf16* KPEB = (bf16*)(W_SCR + S_KPEB);
    const float* COSM = (const float*)(C.ws + O_COSM); const float* SINM = (const float*)(C.ws + O_SINM);
    const float* qn = P.in[I_QNORM]; const float* kvn = P.in[I_KVNORM];
    for (int row = gw; row < M; row += NGW) {
        const float* ci = CIN + (size_t)row * CWIN_N;
        const f32x4 q0 = *(const f32x4*)(ci + lane * 8), q1 = *(const f32x4*)(ci + lane * 8 + 4);
        const f32x4 k0 = *(const f32x4*)(ci + 512 + lane * 8), k1 = *(const f32x4*)(ci + 512 + lane * 8 + 4);
        float sq = (q0[0] * q0[0] + q0[1] * q0[1]) + (q0[2] * q0[2] + q0[3] * q0[3]) + (q1[0] * q1[0] + q1[1] * q1[1]) + (q1[2] * q1[2] + q1[3] * q1[3]);
        float sk = (k0[0] * k0[0] + k0[1] * k0[1]) + (k0[2] * k0[2] + k0[3] * k0[3]) + (k1[0] * k1[0] + k1[1] * k1[1]) + (k1[2] * k1[2] + k1[3] * k1[3]);
        sq = wave_sum(sq); sk = wave_sum(sk);
        const float rq = rsqrtf(sq * (1.0f / 512.f) + EPS), rk = rsqrtf(sk * (1.0f / 512.f) + EPS);
        const f32x4 g0 = *(const f32x4*)(qn + lane * 8), g1 = *(const f32x4*)(qn + lane * 8 + 4), n0 = *(const f32x4*)(kvn + lane * 8), n1 = *(const f32x4*)(kvn + lane * 8 + 4);
        const f32x4 a0 = q0 * rq * g0, a1 = q1 * rq * g1, c0 = k0 * rk * n0, c1 = k1 * rk * n1;
        v4u w; w.x = pk2(a0[0], a0[1]); w.y = pk2(a0[2], a0[3]); w.z = pk2(a1[0], a1[1]); w.w = pk2(a1[2], a1[3]);
        *(v4u*)(CQN + (size_t)row * 512 + lane * 8) = w;
        v4u z; z.x = pk2(c0[0], c0[1]); z.y = pk2(c0[2], c0[3]); z.z = pk2(c1[0], c1[1]); z.w = pk2(c1[2], c1[3]);
        *(v4u*)(CKVB + (size_t)row * 512 + lane * 8) = z;
        float* co = row < MP ? out + OUT_CKVP + (size_t)row * 512 : out + OUT_CKVS + (size_t)(row - MP) * 512;
        *(f32x4*)(co + lane * 8) = c0; *(f32x4*)(co + lane * 8 + 4) = c1;
        if (lane < 32) {
            const int pos = pos_of_row(row); const float x1 = ci[1024 + lane], x2 = ci[1024 + 32 + lane];
            const float cv = COSM[(size_t)pos * 32 + lane], sv = SINM[(size_t)pos * 32 + lane];
            const float y1 = x1 * cv - x2 * sv, y2 = x2 * cv + x1 * sv;
            float* ko = row < MP ? out + OUT_KPEP + (size_t)row * 64 : out + OUT_KPES + (size_t)(row - MP) * 64;
            ko[lane] = y1; ko[32 + lane] = y2;
            KPEB[(size_t)row * 64 + lane] = (bf16)f2bf(y1); KPEB[(size_t)row * 64 + 32 + lane] = (bf16)f2bf(y2);
        }
    }
}
__device__ __forceinline__ void ph_uq(const Ctx& C) {
    bf16* CKVB = (bf16*)(W_SCR + S_CKVB);
    { pg8::Gemm g{(const bf16*)(W_SCR + S_CQN), (const bf16*)(C.ws + O_WUQ), M, 3072, 512, 512, 512}; pg8::StaticOrder S = make_order(M, 3072, C.G, C.wg, 0);
      EpiUq E{(bf16*)(W_SCR + S_QN), (bf16*)(W_SCR + S_QR), (const float*)(C.ws + O_COSM), (const float*)(C.ws + O_SINM)};
      pg8::gemm_phase<EpiUq, pg8::StaticOrder, true, true>(C.lds, g, S, E, C.wave); }
    { pg8::Gemm g{CKVB, (const bf16*)(C.ws + O_WKV), MP, 4096, 512, 512, 512}; pg8::StaticOrder S = make_order(MP, 4096, C.G, C.wg, (130 * 12) % 256);
      EpiPlain E{(bf16*)(W_SCR + S_KNV), 4096, nullptr};
      pg8::gemm_phase<EpiPlain, pg8::StaticOrder, true, true>(C.lds, g, S, E, C.wave); }
    { pg8::Gemm g{CKVB + (size_t)MP * 512, (const bf16*)(C.ws + O_WKV), MS, 4096, 512, 512, 512}; pg8::StaticOrder S = make_order(MS, 4096, C.G, C.wg, (130 * 12) % 256);
      EpiPlain E{(bf16*)(W_SCR + S_KNVN), 4096, nullptr};
      pg8::gemm_phase<EpiPlain, pg8::StaticOrder, true, true>(C.lds, g, S, E, C.wave); }
}
__device__ __forceinline__ void ph_attp(const Ctx& C) {
    const int wid = C.wave, r32 = lane_id() & 31, G = C.G, wg = C.wg;
    const bf16* KNV = (const bf16*)(W_SCR + S_KNV); const bf16* KPEB = (const bf16*)(W_SCR + S_KPEB); const bf16* QN = (const bf16*)(W_SCR + S_QN); const bf16* QR = (const bf16*)(W_SCR + S_QR);
    bf16* OB = (bf16*)(W_SCR + S_OB);
    const int nun = (G == 256) ? 8 : (2048 + G - 1) / G;
#pragma unroll 1
    for (int i = 0; i < nun; ++i) {
        int pr, qb;
        if (G == 256) { const int k4 = (wg >> 3) & 3; pr = (wg & 7) + 8 * (wg >> 5); qb = 4 * i + ((i & 1) ? 3 - k4 : k4); }
        else { const int u = wg + i * G; if (u >= 2048) break; pr = u >> 5; qb = u & 31; }
        const int b = pr >> 4, h = pr & 15;
        const int row = b * SEQ + qb * 256 + wid * 32 + r32;
        const bf16* kbase = KNV + (size_t)(b * SEQ) * 4096 + h * 128; const bf16* rbase = KPEB + (size_t)(b * SEQ) * 64;
        auto kn = [=](int k) -> const bf16* { return kbase + (size_t)k * 4096; };
        auto vv = [=](int k) -> const bf16* { return kbase + (size_t)k * 4096 + 2048; };
        auto kr = [=](int k) -> const bf16* { return rbase + (size_t)k * 64; };
        const int kmax = (qb * 4 + (wid >> 1) + 1) * 64;
        att::attn_unit<64, false, false>(C.lds, QN + (size_t)row * D + h * 128, QR + (size_t)row * 1024 + h * 64, kn, kr, vv, 4 * (qb + 1), kmax, MLA_SC * LOG2E, 8.0f / MLA_SC,
                           OB + (size_t)(b * SEQ + qb * 256 + wid * 32) * D + h * 128, D, 32, true, C.wave);
    }
}
__device__ __forceinline__ void ph_exp(const Ctx& C, int hb) {
    pg8::Gemm g{(const bf16*)(W_SCR + S_CKVPAST) + (size_t)hb * 32768 * 512, (const bf16*)(C.ws + O_WKV), 32768, 4096, 512, 512, 512}; pg8::StaticOrder S = make_order(32768, 4096, C.G, C.wg, 0);
    EpiPlain E{(bf16*)(W_SCR + S_KNV), 4096, nullptr};
    pg8::gemm_phase<EpiPlain, pg8::StaticOrder, true, true>(C.lds, g, S, E, C.wave);
}
__device__ __forceinline__ void ph_atts(const Ctx& C, int hb) {
    const int wid = C.wave, r32 = lane_id() & 31;
    const bf16* KNV = (const bf16*)(W_SCR + S_KNV); const bf16* KNVN = (const bf16*)(W_SCR + S_KNVN); const bf16* KPEB = (const bf16*)(W_SCR + S_KPEB); const bf16* KPEPAST = (const bf16*)(W_SCR + S_KPEPAST);
    const bf16* QN = (const bf16*)(W_SCR + S_QN); const bf16* QR = (const bf16*)(W_SCR + S_QR); bf16* OB = (bf16*)(W_SCR + S_OB);
#pragma unroll 1
    for (int u = C.wg; u < 256; u += C.G) {
        const int bl = u >> 4, h = u & 15, b = hb * 16 + bl;
        const int row = MP + b * TS + (r32 & 15);
        const bf16* pbase = KNV + (size_t)(bl * PAST) * 4096 + h * 128; const bf16* nbase = KNVN + (size_t)(b * TS) * 4096 + h * 128;
        const bf16* rpast = KPEPAST + (size_t)(b * PAST) * 64; const bf16* rnew = KPEB + (size_t)(MP + b * TS) * 64;
        auto kn = [=](int k) -> const bf16* { return k < PAST ? pbase + (size_t)k * 4096 : (k < PAST + TS ? nbase + (size_t)(k - PAST) * 4096 : nullptr); };
        auto vv = [=](int k) -> const bf16* { return k < PAST ? pbase + (size_t)k * 4096 + 2048 : (k < PAST + TS ? nbase + (size_t)(k - PAST) * 4096 + 2048 : nullptr); };
        auto kr = [=](int k) -> const bf16* { return k < PAST ? rpast + (size_t)k * 64 : (k < PAST + TS ? rnew + (size_t)(k - PAST) * 64 : nullptr); };
        att::attn_unit<64, false, true>(C.lds, QN + (size_t)row * D + h * 128, QR + (size_t)row * 1024 + h * 64, kn, kr, vv, 33, PAST + TS, MLA_SC * LOG2E, 8.0f / MLA_SC,
                           OB + (size_t)(MP + b * TS) * D + h * 128, D, 16, wid == 0, C.wave);
    }
}
__device__ __forceinline__ void ph_cwout(const Ctx& C) { res_gemm<8, false>(C, (const bf16*)(W_SCR + S_OB), D, (const bf16*)(C.ws + O_CWOUT), D, nullptr, 1.0f, W_SSQ + (size_t)6 * M, (float*)(W_SCR + S_KNV)); }
__device__ __forceinline__ void ph_cwoutfin(const Ctx& C) { ph_fin<false>(C, (const float*)(W_SCR + S_KNV), 8, nullptr, 1.0f, W_SSQ + (size_t)6 * M); }
__device__ __forceinline__ void ph_mq(const Ctx& C, const Params& P, int L) {
    CTX_GT();
    cvt_bulk(P.in[I_CMK] + (size_t)L * 32 * 256 * 512, (bf16*)(W_SCR + S_CMK), (size_t)32 * 256 * 512 / 8, gt, NGT);
    cvt_bulk(P.in[I_CMV] + (size_t)L * 32 * 256 * 512, (bf16*)(W_SCR + S_CMV), (size_t)32 * 256 * 512 / 8, gt, NGT);
    { pg8::Gemm g{W_XB, (const bf16*)(C.ws + O_WMQ) + (size_t)L * 512 * D, MP, 512, D, XBP, D}; pg8::StaticOrder S = make_order(MP, 512, C.G, C.wg, 0);
      EpiPlain E{(bf16*)(W_SCR + S_QM), 512, W_SSQ + (size_t)(L * 4 + 2) * M};
      pg8::gemm_phase<EpiPlain, pg8::StaticOrder, true, true>(C.lds, g, S, E, C.wave); }
    { pg8::Gemm g{W_XB + (size_t)MP * XBP, (const bf16*)(C.ws + O_WMQ) + (size_t)L * 512 * D, MS, 512, D, XBP, D / 8}; SplitOrder S; S.init(MS, 512, 8, C.G, C.wg);
      EpiPart E{(float*)(W_SCR + S_PARTQ), 512, (size_t)MS * 512};
      pg8::gemm_phase<EpiPart, SplitOrder, true, true>(C.lds, g, S, E, C.wave); }
}
__device__ __forceinline__ void ph_matt(const Ctx& C, int L) {
    const int wid = C.wave, r32 = lane_id() & 31;
    const bf16* QM = (const bf16*)(W_SCR + S_QM); bf16* OM = (bf16*)(W_SCR + S_OM); const bf16* CMK = (const bf16*)(W_SCR + S_CMK); const bf16* CMV = (const bf16*)(W_SCR + S_CMV);
    const bf16* MKV = (const bf16*)(C.ws + O_MKV);
    auto kr0 = [=](int) -> const bf16* { return nullptr; };
#pragma unroll 1
    for (int u = C.wg; u < 512 + 128; u += C.G) {
        const bool pr = u < 512; const int v = pr ? u : u - 512;
        const int b = pr ? v >> 7 : v >> 2, h = pr ? (v >> 5) & 3 : v & 3, qb = v & 31;
        const int row = pr ? b * SEQ + qb * 256 + wid * 32 + r32 : MP + b * TS + (r32 & 15);
        const bf16* kb_ = pr ? MKV + (size_t)(L * 1024 + b * 256) * 1024 + h * 128 : CMK + (size_t)(b * 256) * 512 + h * 128;
        const bf16* vb_ = pr ? kb_ + 512 : CMV + (size_t)(b * 256) * 512 + h * 128;
        const int kp = pr ? 1024 : 512;
        auto kn = [=](int k) -> const bf16* { return kb_ + (size_t)k * kp; };
        auto vv = [=](int k) -> const bf16* { return vb_ + (size_t)k * kp; };
        if (!pr) {
            const int t = wid * 64 + lane_id(), r = t >> 5, c4 = (t & 31) * 4; const size_t o = (size_t)(b * TS + r) * 512 + h * 128 + c4;
            const float* pq = (const float*)(W_SCR + S_PARTQ); f32x4 a = *(const f32x4*)(pq + o);
#pragma unroll
            for (int k = 1; k < 8; ++k) a += *(const f32x4*)(pq + (size_t)k * MS * 512 + o);
            const float rs = rsqrtf(ssq_get(W_SSQ + (size_t)(L * 4 + 2) * M + MP + b * TS + r) * (1.0f / D) + EPS);
            v2u w; w.x = pk2(a[0] * rs, a[1] * rs); w.y = pk2(a[2] * rs, a[3] * rs);
            *(v2u*)((bf16*)(W_SCR + S_QM) + (size_t)MP * 512 + o) = w;
            VM_WAIT(); __syncthreads();
        }
        att::attn_unit<0, false, false>(C.lds, QM + (size_t)row * 512 + h * 128, nullptr, kn, kr0, vv, 4, 256, MEM_SC * LOG2E, 8.0f / MEM_SC,
                          OM + (size_t)(pr ? b * SEQ + qb * 256 + wid * 32 : MP + b * TS) * 512 + h * 128, 512, pr ? 32 : 16, pr ? true : wid == 0, C.wave);
    }
}
__device__ __forceinline__ void ph_mo(const Ctx& C, int L) {
    pg8::Gemm g{(const bf16*)(W_SCR + S_OM), (const bf16*)(C.ws + O_WMO) + (size_t)L * D * 512, M, D, 512, 512, 512}; pg8::StaticOrder S = make_order(M, D, C.G, C.wg, 0);
    EpiRes<false> E{nullptr, W_XB, W_SSQ + (size_t)(L * 4 + 3) * M, 1.0f};
    pg8::gemm_phase<EpiRes<false>, pg8::StaticOrder, true, true>(C.lds, g, S, E, C.wave);
}
__device__ __forceinline__ void ph_final(const Ctx& C, const Params& P) {
    CTX_GW(); const int lane = lane_id(); float* Y = W_X; const bf16* XB = W_XB;
    const float* fn = P.in[I_FNORM]; const u64* sq = W_SSQ + (size_t)8 * M;
    for (int row = gw; row < M; row += NGW) {
        const float rs = rsqrtf(ssq_get(sq + row) * (1.0f / D) + EPS); float* yr = Y + (size_t)row * D; const bf16* xr = XB + (size_t)row * XBP;
        v4u q[4];
#pragma unroll
        for (int j = 0; j < 4; ++j) q[j] = *(const v4u*)(xr + 8 * (lane + 64 * j));
#pragma unroll
        for (int j = 0; j < 4; ++j) { const int c = 8 * (lane + 64 * j); const f32x4 g0 = *(const f32x4*)(fn + c), g1 = *(const f32x4*)(fn + c + 4);
            __builtin_nontemporal_store((f32x4){bflo(q[j].x), bfhi(q[j].x), bflo(q[j].y), bfhi(q[j].y)} * rs * g0, (f32x4*)(yr + c)); __builtin_nontemporal_store((f32x4){bflo(q[j].z), bfhi(q[j].z), bflo(q[j].w), bfhi(q[j].w)} * rs * g1, (f32x4*)(yr + c + 4)); }
    }
}

__global__ void __launch_bounds__(NWAVES * 64, 2) mk_fwd(Params P) {
    extern __shared__ __attribute__((aligned(16))) unsigned char lds_raw[];
    Ctx C; C.lds = (LAS unsigned char*)lds_raw; C.ws = P.ws; C.out = P.out; C.G = gridDim.x; C.wg = blockIdx.x; C.wave = __builtin_amdgcn_readfirstlane((int)threadIdx.x >> 6);
    volatile LAS unsigned* MISC = (volatile LAS unsigned*)(C.lds + MISC_OFF);
    for (int u = C.wave * 64 + lane_id(); u < (LDS_BYTES - MISC_OFF) / 4; u += NWAVES * 64) ((LAS unsigned*)(C.lds + MISC_OFF))[u] = 0u;
    __syncthreads();
    XcdBarrier bar = xcd_barrier_post((unsigned*)(P.ws + O_CTL) + 4096, MISC + 8, C.wave); bar.t0 = (C.wave == 0);
    const int lo = P.ph_lo, hi_ph = P.ph_hi;
#define RUN(k, call) do { if (lo <= (k) && (k) < hi_ph) { if ((k) > lo) xcd_barrier(bar); call; } } while (0)
    RUN(0, ph_prologue(C, P));
    RUN(1, ph_w1(C, 0));    RUN(2, ph_w2<true>(C, P, 0));    RUN(3, ph_w2fin<true>(C, P, 0));
    RUN(4, ph_win(C, P));   RUN(5, ph_halo(C));        RUN(6, ph_conv(C, P));     RUN(7, ph_scan(C, P));   RUN(8, ph_norm(C));   RUN(9, ph_wout(C));   RUN(10, ph_woutfin(C));
    RUN(11, ph_mq(C, P, 0));   RUN(12, ph_matt(C, 0));   RUN(13, ph_mo(C, 0));
    RUN(14, ph_w1(C, 1));   RUN(15, ph_w2<false>(C, P, 1));   RUN(16, ph_w2fin<false>(C, P, 1));
    RUN(17, ph_w1(C, 2));   RUN(18, ph_w2<false>(C, P, 2));   RUN(19, ph_w2fin<false>(C, P, 2));
    RUN(20, ph_cwin(C, P));   RUN(21, ph_nr(C, P));   RUN(22, ph_uq(C));   RUN(23, ph_attp(C));
    RUN(24, ph_exp(C, 0));   RUN(25, ph_atts(C, 0));   RUN(26, ph_exp(C, 1));   RUN(27, ph_atts(C, 1));   RUN(28, ph_cwout(C));   RUN(29, ph_cwoutfin(C));
    RUN(30, ph_mq(C, P, 1));   RUN(31, ph_matt(C, 1));   RUN(32, ph_mo(C, 1));
    RUN(33, ph_w1(C, 3));   RUN(34, ph_w2<false>(C, P, 3));   RUN(35, ph_w2fin<false>(C, P, 3));
    RUN(36, ph_final(C, P));
#undef RUN
}
extern "C" void kernel_launch(void* const* d_in, const int* in_sizes, int n_in, void* d_out, int out_size, void* d_ws, size_t ws_size, hipStream_t stream) {
    static int grid = 0;
    if (grid == 0) {
        if (n_in != N_IN || (size_t)out_size != OUT_END || ws_size < WS_NEED) {
            fprintf(stderr, "kernel_launch: unexpected shapes: n_in %d out %d ws %zu (need %zu)\n", n_in, out_size, ws_size, (size_t)WS_NEED); grid = -1; return; }
        int dev = 0, cus = 0;
        if (hipGetDevice(&dev) != hipSuccess || hipDeviceGetAttribute(&cus, hipDeviceAttributeMultiprocessorCount, dev) != hipSuccess) { grid = -1; return; }
        if (hipFuncSetAttribute((const void*)mk_fwd, hipFuncAttributeMaxDynamicSharedMemorySize, LDS_BYTES) != hipSuccess) { fprintf(stderr, "kernel_launch: hipFuncSetAttribute failed\n"); grid = -1; return; }
        int per_cu = 0;
        if (hipOccupancyMaxActiveBlocksPerMultiprocessor(&per_cu, (const void*)mk_fwd, NWAVES * 64, LDS_BYTES) != hipSuccess || per_cu < 1) { fprintf(stderr, "kernel_launch: occupancy query says %d\n", per_cu); }
        (void)hipGetLastError();
        grid = cus;
    }
    if (grid < 0) return;
    (void)hipMemsetAsync((char*)d_ws, 0, O_ZEND, stream);
    Params p{};
    for (int i = 0; i < N_IN; ++i) p.in[i] = (const float*)d_in[i];
    p.out = (float*)d_out; p.ws = (unsigned char*)d_ws;
#ifndef MK_PER_PHASE
    p.ph_lo = 0; p.ph_hi = N_PHASES;
    hipLaunchKernelGGL(mk_fwd, dim3(grid), dim3(NWAVES * 64), LDS_BYTES, stream, p);
#else
    for (int k = 0; k < N_PHASES; ++k) { p.ph_lo = k; p.ph_hi = k + 1; hipLaunchKernelGGL(mk_fwd, dim3(grid), dim3(NWAVES * 64), LDS_BYTES, stream, p); }
#endif
}
```

```cpp
#include <hip/hip_runtime.h>
#include <cstdio>
#include <cstdint>
__device__ __forceinline__ int lane_id() { int l; asm volatile("v_mbcnt_lo_u32_b32 %0, -1, 0\n\tv_mbcnt_hi_u32_b32 %0, -1, %0" : "=v"(l)); return l; }
namespace pg8 {
#define PG8_LAS __attribute__((address_space(3)))
typedef unsigned short bf16_t;
typedef short bf16x8 __attribute__((ext_vector_type(8)));
typedef float f32x4 __attribute__((ext_vector_type(4)));
typedef unsigned u32x4 __attribute__((ext_vector_type(4)));
constexpr int BM = 256, BK = 64, HALF = 128, HTB = HALF * BK * 2  , STAGE_BYTES = 8 * HTB, NXCD = 8, WGM_NARROW = 4, WGM_WIDE = 6;

__host__ __device__ __forceinline__ int lds_byte(int r, int c) { const int st = (r >> 4) * 2 + (c >> 5), rr = r & 15, cc = c & 31, ob = rr * 64 + cc * 2; return st * 1024 + (ob ^ (((ob >> 9) & 1) << 5)); }
__host__ __device__ __forceinline__ void stage_rc(int b, int& R, int& C) { const int st = b / 1024, sb = b % 1024, swz = sb ^ (((sb >> 9) & 1) << 5); R = (st >> 1) * 16 + swz / 64; C = (st & 1) * 32 + (swz % 64) / 2; }
__host__ __device__ __forceinline__ int perm32(int rho) { const int n = rho >> 4, i = rho & 15; return 8 * (i >> 2) + 4 * n + (i & 3); }

struct Unit { int pm, pn, kp, par; };
struct Gemm { const bf16_t* A; const bf16_t* Bt; int M, N, K, lda, kloop; };

struct StaticOrder {
    int nM, nN, nwg, G, c, wgm;
    __host__ __device__ void init(int M, int N, int G_, int c_) { nM = M / BM; nN = N / BM; nwg = nM * nN; G = G_; c = c_; wgm = nN <= 8 ? WGM_NARROW : WGM_WIDE; }
    __host__ __device__ bool next(int i, Unit& u) const {
        const long L = (long)i * G + c; if (L >= nwg) return false;
        int wgid = (int)L; { const int q = nwg / NXCD, r = nwg % NXCD, xcd = wgid % NXCD, off = wgid / NXCD; wgid = (xcd < r ? xcd * (q + 1) : r * (q + 1) + (xcd - r) * q) + off; }
        const int nig = wgm * nN, gid = wgid / nig, fm = gid * wgm, gsz = (nM - fm) < wgm ? (nM - fm) : wgm;
        u.pm = fm + ((wgid % nig) % gsz); u.pn = (wgid % nig) / gsz; if (gid & 1) u.pn = nN - 1 - u.pn;
        u.kp = 0; return true;
    }
    __device__ __forceinline__ void a_ready(const Unit&) const {}
    __device__ __forceinline__ void done(const Unit&) const {}
};
__device__ __forceinline__ unsigned cvt_pk_bf16(float lo, float hi) { unsigned r; asm volatile("v_cvt_pk_bf16_f32 %0, %1, %2" : "=v"(r) : "v"(lo), "v"(hi)); return r; }
template <class Epi, class Sched, bool ALIGN_EPI = false, bool SP2 = false>
__device__ __forceinline__ void gemm_phase(PG8_LAS unsigned char* lds, const Gemm g, const Sched& S, const Epi& E, int wave_id) {
    const int wid = wave_id, lane = lane_id(), tid = wid * 64 + lane, wr = wid >> 2, wc = wid & 3, fr = lane & 15, fq = lane >> 4;
    const int K = g.K, nt = g.kloop / BK; const size_t kpart = (size_t)g.kloop * 2;
    unsigned voffA[2], voffB[2];
#pragma unroll
    for (int i = 0; i < 2; ++i) { int R, C; stage_rc(tid * 16 + i * 8192, R, C); const int Rb = Epi::PERM ? (Epi::ADJ ? ((R >> 5) * 64 + perm32(R & 31)) : ((R & ~31) + perm32(R & 31))) : R;
        voffA[i] = (unsigned)(R * g.lda + C) * 2u; voffB[i] = (unsigned)(Rb * K + C) * 2u; }
    const size_t kstep = (size_t)(BK * 2);
    const size_t hstep = (size_t)HALF * K * 2;
    const size_t tstep = 2 * hstep;
    const size_t hstepB = Epi::ADJ ? (size_t)32 * K * 2 : hstep;
    const size_t hstepA = (size_t)HALF * g.lda * 2, tstepA = 2 * hstepA;
    const unsigned ldsw = (unsigned)wid * 1024u;
    const int aoff = lds_byte(wr * 64 + fr, fq * 8), boff = lds_byte(wc * 32 + fr, fq * 8);
#define PG8_SA(b, h) (((b) * 2 + (h)) * HTB)
#define PG8_SB(b, h) ((4 + (b) * 2 + (h)) * HTB)
#define PG8_STAGE(bufoff, gbase, voff) do { _Pragma("unroll") for (int _i = 0; _i < 2; ++_i) \
        __builtin_amdgcn_global_load_lds((const unsigned*)((const char*)(gbase) + (voff)[_i]), (PG8_LAS unsigned*)(lds + (bufoff) + ldsw + _i * 8192), 16, 0, 0); } while (0)
#define PG8_LDA(dst, b, h) do { _Pragma("unroll") for (int m = 0; m < 4; ++m) _Pragma("unroll") for (int k = 0; k < 2; ++k) dst[m][k] = *(const PG8_LAS bf16x8*)(lds + PG8_SA(b, h) + aoff + m * 2048 + k * 1024); } while (0)
#define PG8_LDB(dst, b, h) do { _Pragma("unroll") for (int n = 0; n < 2; ++n) _Pragma("unroll") for (int k = 0; k < 2; ++k) dst[n][k] = *(const PG8_LAS bf16x8*)(lds + PG8_SB(b, h) + boff + n * 2048 + k * 1024); } while (0)
#define PG8_MMA(ai, bj, At, Bt) do { __builtin_amdgcn_s_setprio(1); _Pragma("unroll") for (int m = 0; m < 4; ++m) _Pragma("unroll") for (int n = 0; n < 2; ++n) _Pragma("unroll") for (int k = 0; k < 2; ++k) \
        acc[ai][bj][m][n] = __builtin_amdgcn_mfma_f32_16x16x32_bf16(Bt[n][k], At[m][k], acc[ai][bj][m][n], 0, 0, 0); __builtin_amdgcn_s_setprio(0); } while (0)
#define PG8_WAIT_V(n) asm volatile("s_waitcnt vmcnt(" #n ")" ::: "memory")
#define PG8_WAIT_L(n) asm volatile("s_waitcnt lgkmcnt(" #n ")" ::: "memory")
#define PG8_BAR __builtin_amdgcn_s_barrier()
#define PG8_SCHED __builtin_amdgcn_sched_barrier(0)
    Unit cur, nxt; int ui = 0;
    if (!S.next(0, cur)) return;
    f32x4 acc[2][2][4][2];
#pragma unroll
    for (int a = 0; a < 2; ++a)
#pragma unroll
        for (int b = 0; b < 2; ++b)
#pragma unroll
            for (int m = 0; m < 4; ++m)
#pragma unroll
                for (int n = 0; n < 2; ++n) acc[a][b][m][n] = (f32x4){0.f, 0.f, 0.f, 0.f};
    bf16x8 At[4][2], B0[2][2], B1[2][2];
    const char* cA = (const char*)g.A + (size_t)cur.pm * tstepA + (size_t)cur.kp * kpart; const char* cB = (const char*)g.Bt + (size_t)cur.pn * tstep + (size_t)cur.kp * kpart;
    S.a_ready(cur);
    if constexpr (SP2) {
        PG8_STAGE(PG8_SB(0, 0), cB, voffB); PG8_STAGE(PG8_SB(0, 1), cB + hstepB, voffB); PG8_STAGE(PG8_SA(0, 0), cA, voffA); PG8_STAGE(PG8_SA(0, 1), cA + hstepA, voffA);
        if (wr == 1) PG8_BAR;
        PG8_WAIT_V(2); PG8_BAR;
        PG8_STAGE(PG8_SB(1, 0), cB + kstep, voffB); PG8_STAGE(PG8_SA(1, 0), cA + kstep, voffA); PG8_STAGE(PG8_SB(1, 1), cB + hstepB + kstep, voffB);
        PG8_WAIT_V(6); PG8_BAR;
    } else {
        PG8_STAGE(PG8_SB(0, 0), cB, voffB); PG8_STAGE(PG8_SA(0, 0), cA, voffA); PG8_STAGE(PG8_SB(0, 1), cB + hstepB, voffB); PG8_STAGE(PG8_SA(0, 1), cA + hstepA, voffA);
        if (wr == 1) PG8_BAR;
        PG8_WAIT_V(4); PG8_BAR;
        PG8_STAGE(PG8_SB(1, 0), cB + kstep, voffB); PG8_STAGE(PG8_SA(1, 0), cA + kstep, voffA); PG8_STAGE(PG8_SB(1, 1), cB + hstepB + kstep, voffB);
        PG8_WAIT_V(6); PG8_BAR;
    }
    for (;;) {
        const bool has_next = S.next(ui + 1, nxt);
        if constexpr (Epi::SSQ_LDS)
            __builtin_amdgcn_global_load_lds((const unsigned*)(E.ssq + (size_t)cur.pm * 256) + tid, (PG8_LAS unsigned*)(lds + STAGE_BYTES + (ui & 1) * 2048 + wid * 256), 4, 0, 0);
        const char* nA = has_next ? (const char*)g.A + (size_t)nxt.pm * tstepA + (size_t)nxt.kp * kpart : cA; const char* nB = has_next ? (const char*)g.Bt + (size_t)nxt.pn * tstep + (size_t)nxt.kp * kpart : cB;
        for (int t = 0; t < nt; t += 2) {
            const bool last = (t == nt - 2);
            const char* a1 = cA + (size_t)(t + 1) * kstep;
            const char* a2 = last ? nA : cA + (size_t)(t + 2) * kstep; const char* b2 = last ? nB : cB + (size_t)(t + 2) * kstep;
            const char* a3 = a2 + kstep; const char* b3 = b2 + kstep;
            if (last && has_next) S.a_ready(nxt);
            if constexpr (SP2) {
            PG8_LDB(B0, 0, 0); PG8_LDB(B1, 0, 1); PG8_SCHED; PG8_LDA(At, 0, 0); PG8_STAGE(PG8_SA(1, 1), a1 + hstepA, voffA);
            PG8_WAIT_V(8); PG8_WAIT_L(0); PG8_BAR; PG8_MMA(0, 0, At, B0); PG8_MMA(0, 1, At, B1); PG8_BAR; PG8_SCHED;
            PG8_LDA(At, 0, 1); PG8_STAGE(PG8_SB(0, 0), b2, voffB); PG8_STAGE(PG8_SB(0, 1), b2 + hstepB, voffB); PG8_STAGE(PG8_SA(0, 0), a2, voffA);
            PG8_WAIT_V(8); PG8_WAIT_L(0); PG8_BAR; PG8_MMA(1, 0, At, B0); PG8_MMA(1, 1, At, B1); PG8_BAR; PG8_SCHED;
            PG8_LDB(B0, 1, 0); PG8_LDB(B1, 1, 1); PG8_SCHED; PG8_LDA(At, 1, 0); PG8_STAGE(PG8_SA(0, 1), a2 + hstepA, voffA);
            PG8_WAIT_V(8); PG8_WAIT_L(0); PG8_BAR; PG8_MMA(0, 0, At, B0); PG8_MMA(0, 1, At, B1); PG8_BAR; PG8_SCHED;
            PG8_LDA(At, 1, 1); PG8_STAGE(PG8_SB(1, 0), b3, voffB); PG8_STAGE(PG8_SB(1, 1), b3 + hstepB, voffB); PG8_STAGE(PG8_SA(1, 0), a3, voffA);
            PG8_WAIT_V(8); PG8_WAIT_L(0); PG8_BAR; PG8_MMA(1, 0, At, B0); PG8_MMA(1, 1, At, B1); PG8_BAR; PG8_SCHED;
            } else {
            PG8_LDB(B0, 0, 0); PG8_SCHED; PG8_LDA(At, 0, 0); PG8_STAGE(PG8_SA(1, 1), a1 + hstepA, voffA);
            PG8_WAIT_L(8); PG8_BAR; PG8_WAIT_L(0); PG8_MMA(0, 0, At, B0); PG8_BAR; PG8_SCHED;
            PG8_LDB(B1, 0, 1); PG8_STAGE(PG8_SB(0, 0), b2, voffB);
            PG8_BAR; PG8_WAIT_L(0); PG8_MMA(0, 1, At, B1); PG8_BAR;
            PG8_LDA(At, 0, 1); PG8_STAGE(PG8_SA(0, 0), a2, voffA);
            PG8_BAR; PG8_WAIT_L(0); PG8_MMA(1, 0, At, B0); PG8_BAR; PG8_SCHED;
            PG8_STAGE(PG8_SB(0, 1), b2 + hstepB, voffB);
            PG8_WAIT_V(6); PG8_BAR; PG8_MMA(1, 1, At, B1); PG8_BAR;
            PG8_LDB(B0, 1, 0); PG8_SCHED; PG8_LDA(At, 1, 0); PG8_STAGE(PG8_SA(0, 1), a2 + hstepA, voffA);
            PG8_WAIT_L(8); PG8_BAR; PG8_WAIT_L(0); PG8_MMA(0, 0, At, B0); PG8_BAR; PG8_SCHED;
            PG8_LDB(B1, 1, 1); PG8_STAGE(PG8_SB(1, 0), b3, voffB);
            PG8_BAR; PG8_WAIT_L(0); PG8_MMA(0, 1, At, B1); PG8_BAR;
            PG8_LDA(At, 1, 1); PG8_STAGE(PG8_SA(1, 0), a3, voffA);
            PG8_BAR; PG8_WAIT_L(0); PG8_MMA(1, 0, At, B0); PG8_BAR; PG8_SCHED;
            PG8_STAGE(PG8_SB(1, 1), b3 + hstepB, voffB);
            PG8_WAIT_V(6); PG8_BAR; PG8_MMA(1, 1, At, B1); PG8_BAR;
            }
        }
        if constexpr (ALIGN_EPI) { if (wr == 0) PG8_BAR; }
        cur.par = ui & 1;
        if constexpr (!Epi::AFTER_DRAIN) { E(acc, cur, wr, wc, fr, fq); S.done(cur); }
        if (!has_next) break;
#pragma unroll
        for (int a = 0; a < 2; ++a)
#pragma unroll
            for (int b = 0; b < 2; ++b)
#pragma unroll
                for (int m = 0; m < 4; ++m)
#pragma unroll
                    for (int n = 0; n < 2; ++n) acc[a][b][m][n] = (f32x4){0.f, 0.f, 0.f, 0.f};
        cur = nxt; cA = nA; cB = nB; ++ui;
        if constexpr (ALIGN_EPI) { if (wr == 1) PG8_BAR; }
    }
    PG8_WAIT_V(0);
    if constexpr (!ALIGN_EPI) { if (wr == 0) PG8_BAR; }
    PG8_BAR;
    if constexpr (Epi::AFTER_DRAIN) { E.fused(acc, cur, wr, wc, fr, fq, lds, wid, lane); S.done(cur); }
#undef PG8_SA
#undef PG8_SB
#undef PG8_STAGE
#undef PG8_LDA
#undef PG8_LDB
#undef PG8_MMA
#undef PG8_WAIT_V
#undef PG8_WAIT_L
#undef PG8_BAR
#undef PG8_SCHED
}
}
#define GAS __attribute__((address_space(1)))
#define LAS __attribute__((address_space(3)))
#define XB_TMO      128
#define XB_XCNT(j)  (256  + 64 * (j))
#define XB_XSUB(j)  (1280 + 64 * (j))
#define XB_XGEN(j)  (2304 + 64 * (j))
#define XB_TOP      3328
#define XB_TOPGEN   3392
#define XCD_BAR_WORDS 3456
#define XB_SPIN_CAP (1u << 18)

__device__ __forceinline__ unsigned xb_ld(unsigned* p)              { return __hip_atomic_load(p, __ATOMIC_RELAXED, __HIP_MEMORY_SCOPE_AGENT); }
__device__ __forceinline__ unsigned xb_add(unsigned* p, unsigned v) { return __hip_atomic_fetch_add(p, v, __ATOMIC_RELAXED, __HIP_MEMORY_SCOPE_AGENT); }
__device__ __forceinline__ unsigned xb_xcc_id() { return (unsigned)__builtin_amdgcn_s_getreg((3 << 11) | 20) & 0xFu; }
#define XB_SPIN(cond, bar) do { unsigned _sp = 0; while (cond) { __builtin_amdgcn_s_sleep(1); \
    if ((++_sp & 255u) == 0u) { if (xb_ld(&(bar)[XB_TMO])) break; if (_sp > XB_SPIN_CAP) { atomicAdd(&(bar)[XB_TMO], 1u); break; } } } } while (0)

struct XcdBarrier {
    unsigned* bar; unsigned x; bool t0;
    volatile LAS unsigned* st;
};

__device__ __forceinline__ XcdBarrier xcd_barrier_post(unsigned* bar, volatile LAS unsigned* st, int wave_id) {
    XcdBarrier b; b.bar = bar; b.x = xb_xcc_id(); b.st = st; b.t0 = false;
    if (wave_id == 0 && lane_id() == 0) (void)xb_add(&bar[XB_XCNT(b.x)], 1u);
    return b;
}
__device__ __forceinline__ void xcd_barrier_complete(unsigned* bar, unsigned x, unsigned& nloc, unsigned& nx) {
    const unsigned G = gridDim.x * gridDim.y * gridDim.z;
    unsigned sum, cnt, mine, sp = 0u;
    for (;;) {
        sum = 0u; cnt = 0u; mine = 0u;
#pragma unroll
        for (unsigned j = 0; j < 16; ++j) { const unsigned c = xb_ld(&bar[XB_XCNT(j)]); sum += c; cnt += (c > 0u) ? 1u : 0u; mine = (j == x) ? c : mine; }
        if (sum == G) break;
        __builtin_amdgcn_s_sleep(1);
        if ((++sp & 255u) == 0u) { if (xb_ld(&bar[XB_TMO])) break; if (sp > XB_SPIN_CAP) { atomicAdd(&bar[XB_TMO], 1u); break; } }
    }
    nloc = mine > 0u ? mine : 1u; nx = cnt > 0u ? cnt : 1u;
}

__device__ __forceinline__ void xcd_barrier(const XcdBarrier& b) {
    asm volatile("s_waitcnt vmcnt(0)" ::: "memory");
    __syncthreads();
    if (b.t0 && lane_id() == 0) {
        unsigned* bar = b.bar;
        __builtin_amdgcn_s_waitcnt(0);
        unsigned nloc = b.st[0], nx = b.st[1];
        if (nloc == 0u) { xcd_barrier_complete(bar, b.x, nloc, nx); b.st[0] = nloc; b.st[1] = nx; }
        const unsigned old = xb_add(&bar[XB_XSUB(b.x)], 1u);
        const unsigned gen = old / nloc;
        if (old + 1u == (gen + 1u) * nloc) {
            __builtin_amdgcn_fence(__ATOMIC_RELEASE, "agent");
            asm volatile("s_waitcnt vmcnt(0)" ::: "memory");
            const unsigned og = xb_add(&bar[XB_TOP], 1u);
            const unsigned tg = og / nx;
            if (og + 1u == (tg + 1u) * nx) xb_add(&bar[XB_TOPGEN], 1u);
            else XB_SPIN(xb_ld(&bar[XB_TOPGEN]) == tg, bar);
            __builtin_amdgcn_fence(__ATOMIC_ACQUIRE, "agent");
            xb_add(&bar[XB_XGEN(b.x)], 1u);
            asm volatile("s_waitcnt vmcnt(0)" ::: "memory");
        } else {
            XB_SPIN(xb_ld(&bar[XB_XGEN(b.x)]) == gen, bar);
            __builtin_amdgcn_fence(__ATOMIC_ACQUIRE, "agent");
            asm volatile("s_waitcnt vmcnt(0)" ::: "memory");
        }
    }
    __syncthreads();
}
__device__ const double INV_R[128] = {1.00000000000000000e+00, 9.30572040929699029e-01, 8.65964323360065347e-01, 8.05842187761481865e-01, 7.49894209332455874e-01, 6.97830584859866376e-01, 6.49381631576211316e-01, 6.04296390238132863e-01, 5.62341325190349073e-01, 5.23299114681494704e-01, 4.86967525165863113e-01, 4.53158363760081784e-01, 4.21696503428582226e-01, 3.92418975848453588e-01, 3.65174127254837722e-01, 3.39820832894255964e-01, 3.16227766016837941e-01, 2.94272717620928159e-01, 2.73841963426436130e-01, 2.54829674797934669e-01, 2.37137370566165517e-01, 2.20673406908458991e-01, 2.05352502645714613e-01, 1.91095297497044042e-01, 1.77827941003892293e-01, 1.65481709994318132e-01, 1.53992652605949187e-01, 1.43301257023696282e-01, 1.33352143216332403e-01, 1.24093776075171955e-01, 1.15478198468945817e-01, 1.07460782832131743e-01, 1.00000000000000006e-01, 9.30572040929699001e-02, 8.65964323360065291e-02, 8.05842187761481865e-02, 7.49894209332455791e-02, 6.97830584859866349e-02, 6.49381631576211316e-02, 6.04296390238132849e-02, 5.62341325190349114e-02, 5.23299114681494704e-02, 4.86967525165863113e-02, 4.53158363760081812e-02, 4.21696503428582239e-02, 3.92418975848453574e-02, 3.65174127254837694e-02, 3.39820832894255909e-02, 3.16227766016837913e-02, 2.94272717620928173e-02, 2.73841963426436144e-02, 2.54829674797934641e-02, 2.37137370566165538e-02, 2.20673406908458991e-02, 2.05352502645714599e-02, 1.91095297497044063e-02, 1.77827941003892293e-02, 1.65481709994318126e-02, 1.53992652605949194e-02, 1.43301257023696268e-02, 1.33352143216332406e-02, 1.24093776075171955e-02, 1.15478198468945813e-02, 1.07460782832131743e-02, 1.00000000000000002e-02, 9.30572040929699036e-03, 8.65964323360065430e-03, 8.05842187761481900e-03, 7.49894209332455791e-03, 6.97830584859866331e-03, 6.49381631576211298e-03, 6.04296390238132780e-03, 5.62341325190349097e-03, 5.23299114681494669e-03, 4.86967525165863096e-03, 4.53158363760081812e-03, 4.21696503428582292e-03, 3.92418975848453627e-03, 3.65174127254837711e-03, 3.39820832894255917e-03, 3.16227766016837939e-03, 2.94272717620928199e-03, 2.73841963426436127e-03, 2.54829674797934667e-03, 2.37137370566165538e-03, 2.20673406908458974e-03, 2.05352502645714599e-03, 1.91095297497044059e-03, 1.77827941003892275e-03, 1.65481709994318139e-03, 1.53992652605949203e-03, 1.43301257023696268e-03, 1.33352143216332406e-03, 1.24093776075171955e-03, 1.15478198468945813e-03, 1.07460782832131756e-03, 1.00000000000000002e-03, 9.30572040929698928e-04, 8.65964323360065387e-04, 8.05842187761481791e-04, 7.49894209332455856e-04, 6.97830584859866353e-04, 6.49381631576211342e-04, 6.04296390238132867e-04, 5.62341325190349097e-04, 5.23299114681494734e-04, 4.86967525165863096e-04, 4.53158363760081790e-04, 4.21696503428582237e-04, 3.92418975848453594e-04, 3.65174127254837700e-04, 3.39820832894255961e-04, 3.16227766016837939e-04, 2.94272717620928167e-04, 2.73841963426436105e-04, 2.54829674797934635e-04, 2.37137370566165538e-04, 2.20673406908458974e-04, 2.05352502645714610e-04, 1.91095297497044048e-04, 1.77827941003892270e-04, 1.65481709994318149e-04, 1.53992652605949192e-04, 1.43301257023696274e-04, 1.33352143216332395e-04, 1.24093776075171960e-04, 1.15478198468945822e-04, 1.07460782832131751e-04};
__device__ const double INV_M[32] = {1.00000000000000000e+00, 7.49894209332455874e-01, 5.62341325190349073e-01, 4.21696503428582226e-01, 3.16227766016837941e-01, 2.37137370566165517e-01, 1.77827941003892293e-01, 1.33352143216332403e-01, 1.00000000000000006e-01, 7.49894209332455791e-02, 5.62341325190349114e-02, 4.21696503428582239e-02, 3.16227766016837913e-02, 2.37137370566165538e-02, 1.77827941003892293e-02, 1.33352143216332406e-02, 1.00000000000000002e-02, 7.49894209332455791e-03, 5.62341325190349097e-03, 4.21696503428582292e-03, 3.16227766016837939e-03, 2.37137370566165538e-03, 1.77827941003892275e-03, 1.33352143216332406e-03, 1.00000000000000002e-03, 7.49894209332455856e-04, 5.62341325190349097e-04, 4.21696503428582237e-04, 3.16227766016837939e-04, 2.37137370566165538e-04, 1.77827941003892270e-04, 1.33352143216332395e-04};
__device__ const float LOG_GAMMA[8] = {-3.174869831e-02f, -1.574835697e-02f, -7.843177461e-03f, -3.913899321e-03f, -1.955034836e-03f, -9.770396478e-04f, -4.884004981e-04f, -2.441704322e-04f};

typedef unsigned short bf16;
typedef unsigned v4u __attribute__((ext_vector_type(4)));
typedef unsigned v2u __attribute__((ext_vector_type(2)));
typedef float f32x4 __attribute__((ext_vector_type(4)));
typedef short bf16x8 __attribute__((ext_vector_type(8)));
typedef float f32x16 __attribute__((ext_vector_type(16)));
typedef short s16x4 __attribute__((ext_vector_type(4)));

constexpr int D = 2048, MP = 32768, MS = 512, M = MP + MS, SEQ = 8192, NBP = 4, NBS = 32, TS = 16, PAST = 2048, DFF = 5632;
constexpr float EPS = 1e-6f;
constexpr int NWAVES = 8;
constexpr int WIN_N = 13568, CWIN_N = 1280;

enum { I_XP = 0, I_XS, I_MEM, I_SCONV, I_SSSD, I_SRET, I_CCKV, I_CKPE, I_CMK, I_CMV, I_NORMS, I_W1, I_W2, I_MNORM, I_WMQ, I_WMKV, I_WMO,
       I_ABWIN, I_CONVW, I_CONVB, I_DTB, I_ALOG, I_DSKIP, I_SSDN, I_ABWOUT, I_CWIN, I_QNORM, I_KVNORM, I_WUQ, I_WUK, I_WUV, I_CWOUT, I_FNORM, N_IN };
constexpr size_t OUT_Y = 0;
constexpr size_t OUT_CONVP = (size_t)M * D;
constexpr size_t OUT_SSDP = OUT_CONVP + 4 * 3 * 3072;
constexpr size_t OUT_RETP = OUT_SSDP + (size_t)4 * 32 * 128 * 64;
constexpr size_t OUT_CKVP = OUT_RETP + (size_t)4 * 8 * 256 * 256;
constexpr size_t OUT_KPEP = OUT_CKVP + (size_t)MP * 512;
constexpr size_t OUT_MEMK = OUT_KPEP + (size_t)MP * 64;
constexpr size_t OUT_MEMV = OUT_MEMK + (size_t)2 * 1024 * 512;
constexpr size_t OUT_CONVS = OUT_MEMV + (size_t)2 * 1024 * 512;
constexpr size_t OUT_SSDS = OUT_CONVS + (size_t)32 * 3 * 3072;
constexpr size_t OUT_RETS = OUT_SSDS + (size_t)32 * 32 * 128 * 64;
constexpr size_t OUT_CKVS = OUT_RETS + (size_t)32 * 8 * 256 * 256;
constexpr size_t OUT_KPES = OUT_CKVS + (size_t)MS * 512;
constexpr size_t OUT_END = OUT_KPES + (size_t)MS * 64;

constexpr size_t AL(size_t x) { return (x + 255) & ~(size_t)255; }
constexpr size_t O_CTL = 0;
constexpr size_t O_SSQ = (size_t)1 << 20;
constexpr size_t O_ZEND = O_SSQ + AL((size_t)9 * M * 8);
constexpr size_t O_SSQG = O_ZEND;
constexpr size_t O_SSQH = O_SSQG + (size_t)M * 64 * 4;
constexpr size_t O_SSQM = O_SSQH + (size_t)M * 64 * 4;
constexpr size_t O_COSR = O_SSQM + AL(1024 * 4);
constexpr size_t O_SINR = O_COSR + (size_t)8192 * 128 * 4;
constexpr size_t O_COSM = O_SINR + (size_t)8192 * 128 * 4;
constexpr size_t O_SINM = O_COSM + (size_t)8192 * 32 * 4;
constexpr size_t O_MB = O_SINM + (size_t)8192 * 32 * 4;
constexpr size_t O_MKV = O_MB + (size_t)1024 * 2048 * 2;
constexpr size_t O_W1 = O_MKV + (size_t)2 * 1024 * 1024 * 2;
constexpr size_t SZ_W1 = (size_t)2 * DFF * D * 2, SZ_W2 = (size_t)D * DFF * 2;
constexpr size_t O_W2 = O_W1 + 4 * SZ_W1;
constexpr size_t O_WIN = O_W2 + 4 * SZ_W2;
constexpr size_t O_WOUT = O_WIN + (size_t)WIN_N * D * 2;
constexpr size_t O_CWIN = O_WOUT + (size_t)D * 4096 * 2;
constexpr size_t O_WUQ = O_CWIN + (size_t)CWIN_N * D * 2;
constexpr size_t O_WKV = O_WUQ + (size_t)3072 * 512 * 2;
constexpr size_t O_CWOUT = O_WKV + (size_t)4096 * 512 * 2;
constexpr size_t O_WMQ = O_CWOUT + (size_t)D * D * 2;
constexpr size_t O_WMKV = O_WMQ + (size_t)2 * 512 * D * 2;
constexpr size_t O_WMO = O_WMKV + (size_t)2 * 1024 * D * 2;
constexpr size_t O_XB = O_WMO + (size_t)2 * D * 512 * 2;
constexpr int XBP = D + 64;
constexpr size_t O_SCR = O_XB + (size_t)M * XBP * 2;
constexpr size_t S_H = 0;
constexpr size_t S_T1 = 0;
constexpr size_t S_ZG = S_T1 + (size_t)M * 4096 * 2;
constexpr size_t S_QK = S_ZG + (size_t)M * 4096 * 2;
constexpr size_t S_BC = S_QK + (size_t)M * 4096 * 2;
constexpr size_t S_DT = S_BC + (size_t)M * 1024 * 2;
constexpr size_t S_L0END = S_DT + (size_t)M * 32 * 4;
constexpr size_t S_QM = 0;
constexpr size_t S_OM = S_QM + (size_t)M * 512 * 2;
constexpr size_t S_CMK = S_OM + (size_t)M * 512 * 2;
constexpr size_t S_CMV = S_CMK + (size_t)32 * 256 * 512 * 2;
constexpr size_t S_PARTQ = S_CMV + (size_t)32 * 256 * 512 * 2;
constexpr size_t S_OB = 0;
constexpr size_t S_CKVB = S_OB + (size_t)M * D * 2;
constexpr size_t S_KPEB = S_CKVB + (size_t)M * 512 * 2;
constexpr size_t S_CKVPAST = S_KPEB + (size_t)M * 64 * 2;
constexpr size_t S_KPEPAST = S_CKVPAST + (size_t)65536 * 512 * 2;
constexpr size_t S_QN = S_KPEPAST + (size_t)65536 * 64 * 2;
constexpr size_t S_QR = S_QN + (size_t)M * D * 2;
constexpr size_t S_KNVN = S_QR + (size_t)M * 1024 * 2;
constexpr size_t S_CQN = S_KNVN + (size_t)MS * 4096 * 2;
constexpr size_t S_CIN = S_CQN + (size_t)M * 512 * 2;
constexpr size_t S_KNV = S_CIN;
constexpr size_t S_L1END = S_KNV + (size_t)MP * 4096 * 2;
constexpr size_t S_MAX = (S_L0END > S_L1END ? S_L0END : S_L1END) > (size_t)M * DFF * 2 ? (S_L0END > S_L1END ? S_L0END : S_L1END) : (size_t)M * DFF * 2;
constexpr size_t WS_NEED = O_SCR + S_MAX;
static_assert(S_CIN + (size_t)M * 1280 * 4 <= S_L1END, "CIN inside the KNV overlay");
static_assert(WS_NEED <= (size_t)1476395008, "workspace map exceeds 4x the largest tensor");

constexpr int RING_BYTES = 131072, LDS_BYTES = 147456, MISC_OFF = LDS_BYTES - 256;

struct Params { const float* in[N_IN]; float* out; unsigned char* ws; int ph_lo, ph_hi; };
static_assert(sizeof(Params) == (N_IN + 2) * 8 + 8, "no padding in Params");

#define LDS_WAIT() asm volatile("s_waitcnt lgkmcnt(0)" ::: "memory")
#define VM_WAIT() asm volatile("s_waitcnt vmcnt(0)" ::: "memory")

__device__ __forceinline__ unsigned f2bf(float f) { unsigned u = __builtin_bit_cast(unsigned, f); return (u + 0x7fffu + ((u >> 16) & 1u)) >> 16; }
__device__ __forceinline__ unsigned pk2(float lo, float hi) { return pg8::cvt_pk_bf16(lo, hi); }
__device__ __forceinline__ float bflo(unsigned w) { return __uint_as_float(w << 16); }
__device__ __forceinline__ float bfhi(unsigned w) { return __uint_as_float(w & 0xffff0000u); }
__device__ __forceinline__ float bf2f(bf16 b) { return __uint_as_float(((unsigned)b) << 16); }
__device__ __forceinline__ float wave_sum(float v) {
#pragma unroll
    for (int o = 1; o < 64; o <<= 1) v += __shfl_xor(v, o);
    return v;
}
typedef unsigned long long u64;
__device__ __forceinline__ u64 ssq_fix(float v) { return (u64)(v * 16777216.0f + 0.5f); }
__device__ __forceinline__ void ssq_add(u64* p, float v) { atomicAdd(p, ssq_fix(v)); }
__device__ __forceinline__ float ssq_get(const u64* p) { return (float)(*p) * (1.0f / 16777216.0f); }
__device__ __forceinline__ float silu_f(float a) { return a * __builtin_amdgcn_rcpf(1.0f + __expf(-a)); }
__device__ __forceinline__ int pos_of_row(int row) { return row < MP ? (row & (SEQ - 1)) : PAST + ((row - MP) & (TS - 1)); }

typedef const pg8::f32x4 (&AccRef)[2][2][4][2];

__device__ __forceinline__ float ssq_lds(const LAS unsigned char* sl, int par, int rl) { return (float)(*(const LAS u64*)(sl + pg8::STAGE_BYTES + par * 2048 + rl * 8)) * (1.0f / 16777216.0f); }

struct EpiSwiglu {
    static constexpr bool PERM = true, AFTER_DRAIN = false, ADJ = false, SSQ_LDS = true;
    bf16* H; const u64* ssq; const LAS unsigned char* sl;
    __device__ __forceinline__ void operator()(AccRef acc, const pg8::Unit& u, int wr, int wc, int fr, int fq) const {
        const int row0 = u.pm * 256 + wr * 64 + fr, col0 = u.pn * 128 + wc * 32 + 8 * fq;
#pragma unroll
        for (int ai = 0; ai < 2; ++ai)
#pragma unroll
            for (int m = 0; m < 4; ++m) {
                const int row = row0 + ai * 128 + m * 16; const float rs = rsqrtf(ssq_lds(sl, u.par, row - u.pm * 256) * (1.0f / D) + EPS);
                float o[8];
#pragma unroll
                for (int n = 0; n < 2; ++n)
#pragma unroll
                    for (int j = 0; j < 4; ++j) { const float a = acc[ai][0][m][n][j] * rs, b = acc[ai][1][m][n][j] * rs; o[4 * n + j] = silu_f(a) * b; }
                v4u w; w.x = pk2(o[0], o[1]); w.y = pk2(o[2], o[3]); w.z = pk2(o[4], o[5]); w.w = pk2(o[6], o[7]);
                *(v4u*)(H + (size_t)row * DFF + col0) = w;
            }
    }
};

__device__ __forceinline__ unsigned swap8(unsigned v) { return (unsigned)__builtin_amdgcn_update_dpp(0, (int)v, 0x128, 0xf, 0xf, true); }
__device__ __forceinline__ v4u swap8(v4u v) { v4u r; r.x = swap8(v.x); r.y = swap8(v.y); r.z = swap8(v.z); r.w = swap8(v.w); return r; }

template <bool FIRST> struct EpiRes {
    static constexpr bool PERM = true, AFTER_DRAIN = false, ADJ = true, SSQ_LDS = false;
    const float* src32; bf16* XB; u64* ssq_next; float alpha;
    __device__ __forceinline__ void operator()(AccRef acc, const pg8::Unit& u, int wr, int wc, int fr, int fq) const {
        const int row0 = u.pm * 256 + wr * 64, colw = u.pn * 256 + wc * 64 + 8 * fq;
        const bool lo = fr < 8; const int r8 = fr & 7, cst = colw + (lo ? 0 : 32);
        v4u q[2][4][2];
        if constexpr (!FIRST) {
#pragma unroll
            for (int ai = 0; ai < 2; ++ai)
#pragma unroll
                for (int m = 0; m < 4; ++m)
#pragma unroll
                    for (int bj = 0; bj < 2; ++bj) q[ai][m][bj] = *(const v4u*)(XB + (size_t)(row0 + ai * 128 + m * 16 + fr) * XBP + colw + bj * 32);
        }
#pragma unroll
        for (int ai = 0; ai < 2; ++ai)
#pragma unroll
            for (int m = 0; m < 4; ++m) {
                const int rowb = row0 + ai * 128 + m * 16, row = rowb + fr; float ss = 0.f; v4u w[2];
#pragma unroll
                for (int bj = 0; bj < 2; ++bj) {
                    f32x4 s0, s1;
                    if constexpr (FIRST) { const float* sp = src32 + (size_t)row * D + colw + bj * 32; s0 = *(const f32x4*)sp; s1 = *(const f32x4*)(sp + 4); }
                    else { const v4u qq = q[ai][m][bj]; s0 = (f32x4){bflo(qq.x), bfhi(qq.x), bflo(qq.y), bfhi(qq.y)}; s1 = (f32x4){bflo(qq.z), bfhi(qq.z), bflo(qq.w), bfhi(qq.w)}; }
                    const f32x4 v0 = s0 + acc[ai][bj][m][0] * alpha, v1 = s1 + acc[ai][bj][m][1] * alpha;
                    w[bj].x = pk2(v0[0], v0[1]); w[bj].y = pk2(v0[2], v0[3]); w[bj].z = pk2(v1[0], v1[1]); w[bj].w = pk2(v1[2], v1[3]);
                    ss += (v0[0] * v0[0] + v0[1] * v0[1]) + (v0[2] * v0[2] + v0[3] * v0[3]) + (v1[0] * v1[0] + v1[1] * v1[1]) + (v1[2] * v1[2] + v1[3] * v1[3]);
                }
                const v4u got = swap8(lo ? w[1] : w[0]);
                const v4u sa = lo ? w[0] : got, sb = lo ? got : w[1];
                bf16* da = XB + (size_t)(rowb + r8) * XBP + cst;
                *(v4u*)da = sa; *(v4u*)(da + (size_t)8 * XBP) = sb;
                ss += __shfl_xor(ss, 16); ss += __shfl_xor(ss, 32);
                if (fq == 0) ssq_add(ssq_next + row, ss);
            }
    }
};

struct EpiPlain {
    static constexpr bool PERM = true, AFTER_DRAIN = false, ADJ = false, SSQ_LDS = false;
    bf16* O; int ldo; const u64* ssq;
    __device__ __forceinline__ void operator()(AccRef acc, const pg8::Unit& u, int wr, int wc, int fr, int fq) const {
        const int row0 = u.pm * 256 + wr * 64 + fr, col0 = u.pn * 256 + wc * 32 + 8 * fq;
#pragma unroll
        for (int ai = 0; ai < 2; ++ai)
#pragma unroll
            for (int m = 0; m < 4; ++m) {
                const int row = row0 + ai * 128 + m * 16; const float rs = ssq ? rsqrtf(ssq_get(ssq + row) * (1.0f / D) + EPS) : 1.0f;
#pragma unroll
                for (int bj = 0; bj < 2; ++bj) {
                    const f32x4 v0 = acc[ai][bj][m][0] * rs, v1 = acc[ai][bj][m][1] * rs;
                    v4u w; w.x = pk2(v0[0], v0[1]); w.y = pk2(v0[2], v0[3]); w.z = pk2(v1[0], v1[1]); w.w = pk2(v1[2], v1[3]);
                    *(v4u*)(O + (size_t)row * ldo + col0 + bj * 128) = w;
                }
            }
    }
};

struct EpiF32 {
    static constexpr bool PERM = true, AFTER_DRAIN = false, ADJ = false, SSQ_LDS = false;
    float* C; int ldc; const u64* ssq;
    __device__ __forceinline__ void operator()(AccRef acc, const pg8::Unit& u, int wr, int wc, int fr, int fq) const {
        const int row0 = u.pm * 256 + wr * 64 + fr, col0 = u.pn * 256 + wc * 32 + 8 * fq;
#pragma unroll
        for (int ai = 0; ai < 2; ++ai)
#pragma unroll
            for (int m = 0; m < 4; ++m) {
                const int row = row0 + ai * 128 + m * 16; const float rs = rsqrtf(ssq_get(ssq + row) * (1.0f / D) + EPS);
#pragma unroll
                for (int bj = 0; bj < 2; ++bj) {
                    float* d = C + (size_t)row * ldc + col0 + bj * 128;
                    *(f32x4*)d = acc[ai][bj][m][0] * rs; *(f32x4*)(d + 4) = acc[ai][bj][m][1] * rs;
                }
            }
    }
};

struct EpiMemKV {
    static constexpr bool PERM = true, AFTER_DRAIN = false, ADJ = false, SSQ_LDS = false;
    float* outk; float* outv; bf16* MKV; const float* ssq;
    __device__ __forceinline__ void operator()(AccRef acc, const pg8::Unit& u, int wr, int wc, int fr, int fq) const {
        const int row0 = u.pm * 256 + wr * 64 + fr, col0 = u.pn * 256 + wc * 32 + 8 * fq;
#pragma unroll
        for (int ai = 0; ai < 2; ++ai)
#pragma unroll
            for (int m = 0; m < 4; ++m) {
                const int row = row0 + ai * 128 + m * 16; const float rs = rsqrtf(ssq[row] * (1.0f / D) + EPS);
#pragma unroll
                for (int bj = 0; bj < 2; ++bj) {
                    const int col = col0 + bj * 128;
                    const f32x4 v0 = acc[ai][bj][m][0] * rs, v1 = acc[ai][bj][m][1] * rs;
                    float* d = (col < 512 ? outk + (size_t)row * 512 + col : outv + (size_t)row * 512 + (col - 512));
                    *(f32x4*)d = v0; *(f32x4*)(d + 4) = v1;
                    v4u w; w.x = pk2(v0[0], v0[1]); w.y = pk2(v0[2], v0[3]); w.z = pk2(v1[0], v1[1]); w.w = pk2(v1[2], v1[3]);
                    *(v4u*)(MKV + (size_t)row * 1024 + col) = w;
                }
            }
    }
};

struct EpiWin {
    static constexpr bool PERM = true, AFTER_DRAIN = false, ADJ = false, SSQ_LDS = true;
    bf16 *T1, *ZG, *QK, *BC; float* DT; const u64* ssq; const float *cosr, *sinr; const float* dt_bias; const LAS unsigned char* sl;
    __device__ __forceinline__ void operator()(AccRef acc, const pg8::Unit& u, int wr, int wc, int fr, int fq) const {
        const int pn = u.pn, row0 = u.pm * 256 + wr * 64 + fr, cl = wc * 32 + 8 * fq;
        if (pn < 36) {
            bf16* base; int pitch = 4096, colt;
            if (pn < 8) { base = ZG; colt = pn * 256; } else if (pn < 16) { base = ZG; colt = 2048 + (pn - 8) * 256; }
            else if (pn < 24) { base = T1; colt = (pn - 16) * 256; } else if (pn < 32) { base = T1; colt = 2048 + (pn - 24) * 256; }
            else { base = BC; pitch = 1024; colt = (pn - 32) * 256; }
#pragma unroll
            for (int ai = 0; ai < 2; ++ai)
#pragma unroll
                for (int m = 0; m < 4; ++m) {
                    const int row = row0 + ai * 128 + m * 16; const float rs = rsqrtf(ssq_lds(sl, u.par, row - u.pm * 256) * (1.0f / D) + EPS);
#pragma unroll
                    for (int bj = 0; bj < 2; ++bj) {
                        const f32x4 v0 = acc[ai][bj][m][0] * rs, v1 = acc[ai][bj][m][1] * rs;
                        v4u w; w.x = pk2(v0[0], v0[1]); w.y = pk2(v0[2], v0[3]); w.z = pk2(v1[0], v1[1]); w.w = pk2(v1[2], v1[3]);
                        *(v4u*)(base + (size_t)row * pitch + colt + cl + bj * 128) = w;
                    }
                }
        } else if (pn < 52) {
            const bool isk = pn >= 44; const int head = isk ? pn - 44 : pn - 36; const int colt = (isk ? 2048 : 0) + head * 256; const float sc = isk ? 0.0625f : 1.0f;
            float invt[8];
#pragma unroll
            for (int e = 0; e < 8; ++e) invt[e] = (float)(INV_R[cl + e] * 0.15915494309189533577);
#pragma unroll
            for (int ai = 0; ai < 2; ++ai)
#pragma unroll
                for (int m = 0; m < 4; ++m) {
                    const int row = row0 + ai * 128 + m * 16; const float rs = rsqrtf(ssq_lds(sl, u.par, row - u.pm * 256) * (1.0f / D) + EPS) * sc;
                    const float posf = (float)pos_of_row(row);
                    f32x4 c0, c1, s0, s1;
#pragma unroll
                    for (int e = 0; e < 4; ++e) { const float t0 = __builtin_amdgcn_fractf(posf * invt[e]), t1 = __builtin_amdgcn_fractf(posf * invt[4 + e]);
                        c0[e] = __builtin_amdgcn_cosf(t0); s0[e] = __builtin_amdgcn_sinf(t0); c1[e] = __builtin_amdgcn_cosf(t1); s1[e] = __builtin_amdgcn_sinf(t1); }
                    const f32x4 a0 = acc[ai][0][m][0] * rs, a1 = acc[ai][0][m][1] * rs, b0 = acc[ai][1][m][0] * rs, b1 = acc[ai][1][m][1] * rs;
                    const f32x4 x0 = a0 * c0 - b0 * s0, x1 = a1 * c1 - b1 * s1, y0 = b0 * c0 + a0 * s0, y1 = b1 * c1 + a1 * s1;
                    v4u w; w.x = pk2(x0[0], x0[1]); w.y = pk2(x0[2], x0[3]); w.z = pk2(x1[0], x1[1]); w.w = pk2(x1[2], x1[3]);
                    *(v4u*)(QK + (size_t)row * 4096 + colt + cl) = w;
                    v4u z; z.x = pk2(y0[0], y0[1]); z.y = pk2(y0[2], y0[3]); z.z = pk2(y1[0], y1[1]); z.w = pk2(y1[2], y1[3]);
                    *(v4u*)(QK + (size_t)row * 4096 + colt + 128 + cl) = z;
                }
        } else {
            if (wc == 0) {
#pragma unroll
                for (int ai = 0; ai < 2; ++ai)
#pragma unroll
                    for (int m = 0; m < 4; ++m) {
                        const int row = row0 + ai * 128 + m * 16; const float rs = rsqrtf(ssq_lds(sl, u.par, row - u.pm * 256) * (1.0f / D) + EPS);
                        const f32x4 v0 = acc[ai][0][m][0] * rs, v1 = acc[ai][0][m][1] * rs;
                        *(f32x4*)(DT + (size_t)row * 32 + cl) = v0; *(f32x4*)(DT + (size_t)row * 32 + cl + 4) = v1;
                    }
            }
        }
    }
};

struct EpiUq {
    static constexpr bool PERM = true, AFTER_DRAIN = false, ADJ = false, SSQ_LDS = false;
    bf16 *QN, *QR; const float *cosm, *sinm;
    __device__ __forceinline__ void operator()(AccRef acc, const pg8::Unit& u, int wr, int wc, int fr, int fq) const {
        const int pn = u.pn, row0 = u.pm * 256 + wr * 64 + fr, cl = wc * 32 + 8 * fq;
        if (pn < 8) {
#pragma unroll
            for (int ai = 0; ai < 2; ++ai)
#pragma unroll
                for (int m = 0; m < 4; ++m) {
                    const int row = row0 + ai * 128 + m * 16;
#pragma unroll
                    for (int bj = 0; bj < 2; ++bj) {
                        const f32x4 v0 = acc[ai][bj][m][0], v1 = acc[ai][bj][m][1];
                        v4u w; w.x = pk2(v0[0], v0[1]); w.y = pk2(v0[2], v0[3]); w.z = pk2(v1[0], v1[1]); w.w = pk2(v1[2], v1[3]);
                        *(v4u*)(QN + (size_t)row * D + pn * 256 + cl + bj * 128) = w;
                    }
                }
        } else {
            const int head = 4 * (pn - 8) + wc, i0 = 8 * fq;
#pragma unroll
            for (int ai = 0; ai < 2; ++ai)
#pragma unroll
                for (int m = 0; m < 4; ++m) {
                    const int row = row0 + ai * 128 + m * 16; const int pos = pos_of_row(row);
                    const f32x4 c0 = *(const f32x4*)(cosm + (size_t)pos * 32 + i0), c1 = *(const f32x4*)(cosm + (size_t)pos * 32 + i0 + 4);
                    const f32x4 s0 = *(const f32x4*)(sinm + (size_t)pos * 32 + i0), s1 = *(const f32x4*)(sinm + (size_t)pos * 32 + i0 + 4);
                    const f32x4 a0 = acc[ai][0][m][0], a1 = acc[ai][0][m][1], b0 = acc[ai][1][m][0], b1 = acc[ai][1][m][1];
                    const f32x4 x0 = a0 * c0 - b0 * s0, x1 = a1 * c1 - b1 * s1, y0 = b0 * c0 + a0 * s0, y1 = b1 * c1 + a1 * s1;
                    v4u w; w.x = pk2(x0[0], x0[1]); w.y = pk2(x0[2], x0[3]); w.z = pk2(x1[0], x1[1]); w.w = pk2(x1[2], x1[3]);
                    *(v4u*)(QR + (size_t)row * 1024 + head * 64 + i0) = w;
                    v4u z; z.x = pk2(y0[0], y0[1]); z.y = pk2(y0[2], y0[3]); z.z = pk2(y1[0], y1[1]); z.w = pk2(y1[2], y1[3]);
                    *(v4u*)(QR + (size_t)row * 1024 + head * 64 + 32 + i0) = z;
                }
        }
    }
};

struct SplitOrder {
    int nN, KS, nun, G, c;
    __device__ __forceinline__ void init(int Mrows, int N, int KS_, int G_, int c_) { nN = N / 256; KS = KS_; nun = (Mrows / 256) * nN * KS_; G = G_; c = c_; }
    __device__ __forceinline__ bool next(int i, pg8::Unit& u) const { const int L = i * G + c; if (L >= nun) return false; u.kp = L % KS; const int t = L / KS; u.pn = t % nN; u.pm = t / nN; return true; }
    __device__ __forceinline__ void a_ready(const pg8::Unit&) const {}
    __device__ __forceinline__ void done(const pg8::Unit&) const {}
};
struct EpiPart {
    static constexpr bool PERM = true, AFTER_DRAIN = false, ADJ = false, SSQ_LDS = false;
    float* PART; int ldc; size_t slab;
    __device__ __forceinline__ void operator()(AccRef acc, const pg8::Unit& u, int wr, int wc, int fr, int fq) const {
        const int row0 = u.pm * 256 + wr * 64 + fr, col0 = u.pn * 256 + wc * 32 + 8 * fq; float* base = PART + (size_t)u.kp * slab;
#pragma unroll
        for (int ai = 0; ai < 2; ++ai)
#pragma unroll
            for (int m = 0; m < 4; ++m) {
                float* d = base + (size_t)(row0 + ai * 128 + m * 16) * ldc + col0;
#pragma unroll
                for (int bj = 0; bj < 2; ++bj) { *(f32x4*)(d + bj * 128) = acc[ai][bj][m][0]; *(f32x4*)(d + bj * 128 + 4) = acc[ai][bj][m][1]; }
            }
    }
};

__device__ __forceinline__ pg8::StaticOrder make_order(int Mrows, int N, int G, int wg, int rot) { pg8::StaticOrder S; S.init(Mrows, N, G, (wg + G - (rot % G)) % G); return S; }

template <class SM>
__device__ __forceinline__ void cvt_weight(const float* __restrict__ W, int K, int ldw, const float* __restrict__ g, int glim, bf16* __restrict__ Bt, int Npad, SM sm,
                                           LAS float* scrf, int gw, int NGW, int lane) {
    LAS bf16* scr = (LAS bf16*)scrf;
    const int nblk = Npad >> 6, items = (K >> 6) * nblk;
    const int c = lane & 7;
    for (int it = gw; it < items; it += NGW) {
        const int kb = it / nblk, nb = it - kb * nblk, k0 = kb << 6, n0 = nb << 6;
        const int src = sm(n0 + (lane & 32));
        float wv[64];
#pragma unroll
        for (int i = 0; i < 64; ++i) wv[i] = src >= 0 ? __builtin_nontemporal_load(W + (size_t)(k0 + i) * ldw + src + (lane & 31)) : 0.f;
#pragma unroll
        for (int i = 0; i < 64; ++i) { float w = wv[i]; if (g != nullptr && k0 + i < glim) w *= g[k0 + i]; scr[i * 66 + lane] = (bf16)f2bf(w); }
        LDS_WAIT(); asm volatile("" ::: "memory");
#pragma unroll
        for (int j = 0; j < 8; ++j) {
            const int n = (lane >> 3) + 8 * j; const LAS bf16* s = scr + (8 * c) * 66 + n;
            v4u o; o.x = (unsigned)s[0] | ((unsigned)s[66] << 16); o.y = (unsigned)s[2 * 66] | ((unsigned)s[3 * 66] << 16); o.z = (unsigned)s[4 * 66] | ((unsigned)s[5 * 66] << 16); o.w = (unsigned)s[6 * 66] | ((unsigned)s[7 * 66] << 16);
            *(v4u*)(Bt + (size_t)(n0 + n) * K + k0 + 8 * c) = o;
        }
        LDS_WAIT(); asm volatile("" ::: "memory");
    }
}
struct SmId { int lim; __device__ __forceinline__ int operator()(int n) const { return n < lim ? n : -1; } };
struct SmW1 { __device__ __forceinline__ int operator()(int n) const { const int t = n >> 8, j = n & 255; return j < 128 ? 128 * t + j : DFF + 128 * t + (j - 128); } };
struct SmWin { __device__ __forceinline__ int operator()(int n) const { const int t = n >> 8;
    if (t < 8) return n; if (t < 16) return 11296 + (n - 2048); if (t < 24) return 2048 + (n - 4096); if (t < 32) return 9248 + (n - 6144);
    if (t < 36) return 4096 + (n - 8192); if (t < 44) return 5152 + (n - 9216); if (t < 52) return 7200 + (n - 11264);
    return (n - 13312) < 32 ? 5120 + (n - 13312) : -1; } };
struct SmUq { __device__ __forceinline__ int operator()(int n) const {
    if (n < 2048) return (n >> 7) * 192 + (n & 127);
    const int t = (n - 2048) >> 8, j = (n - 2048) & 255, half = j >> 7, hh = (j & 127) >> 5, i = j & 31; return (4 * t + hh) * 192 + 128 + half * 32 + i; } };

__device__ __forceinline__ float row_to_bf16(const float* __restrict__ src, bf16* __restrict__ dst, int lane) {
    float ss = 0.f;
#pragma unroll
    for (int j = 0; j < 8; ++j) {
        const f32x4 v = __builtin_nontemporal_load((const f32x4*)(src + 4 * (lane + 64 * j)));
        ss += (v[0] * v[0] + v[1] * v[1]) + (v[2] * v[2] + v[3] * v[3]);
        v2u w; w.x = pk2(v[0], v[1]); w.y = pk2(v[2], v[3]);
        *(v2u*)(dst + 4 * (lane + 64 * j)) = w;
    }
    return wave_sum(ss);
}
__device__ __forceinline__ void cvt_bulk(const float* __restrict__ src, bf16* __restrict__ dst, size_t n8, size_t gt, size_t ngt) {
    for (size_t i = gt; i < n8; i += ngt) {
        const f32x4 a = __builtin_nontemporal_load((const f32x4*)(src + i * 8)), b = __builtin_nontemporal_load((const f32x4*)(src + i * 8 + 4));
        v4u w; w.x = pk2(a[0], a[1]); w.y = pk2(a[2], a[3]); w.z = pk2(b[0], b[1]); w.w = pk2(b[2], b[3]);
        *(v4u*)(dst + i * 8) = w;
    }
}

namespace att {
constexpr int SHM_V = 16384, SHM_K = 16384, SHM_R = 8192;
constexpr int OFF_V = 0, OFF_K = 2 * SHM_V, OFF_R = OFF_K + 2 * SHM_K, OFF_WS = OFF_R + 2 * SHM_R, LDS_NEED = OFF_WS + NWAVES * 64 * 4;
#define KSWZ(row, colB) ((row) * 256 + ((colB) ^ (((row) & 7) << 4)))
#define RSWZ(row, colB) ((row) * 128 + ((colB) ^ (((row) & 7) << 4)))
#define SBAR() __builtin_amdgcn_sched_barrier(0)
__device__ __forceinline__ int crow(int r, int hi) { return (r & 3) + 8 * (r >> 2) + 4 * hi; }
__device__ __forceinline__ unsigned cvtpk(float lo, float hi) { unsigned r; asm volatile("v_cvt_pk_bf16_f32 %0, %1, %2" : "=v"(r) : "v"(lo), "v"(hi)); return r; }

__device__ __forceinline__ void partialSM(f32x16& p0, f32x16& p1, float& m_reg, float& mn, float& alpha, float C, float thr_s) {
    float pmax = p0[0];
#pragma unroll
    for (int r = 1; r < 16; ++r) pmax = fmaxf(pmax, p0[r]);
#pragma unroll
    for (int r = 0; r < 16; ++r) pmax = fmaxf(pmax, p1[r]);
    { auto rr = __builtin_amdgcn_permlane32_swap(__float_as_uint(pmax), __float_as_uint(pmax), false, false);
      pmax = fmaxf(__uint_as_float(rr[0]), __uint_as_float(rr[1])); }
    if (__builtin_expect(__all(pmax - m_reg <= thr_s), 1)) { mn = m_reg; alpha = 1.f; }
    else { mn = fmaxf(m_reg, pmax); alpha = __builtin_amdgcn_exp2f((m_reg - mn) * C); m_reg = mn; }
    const float mnC = -mn * C;
#pragma unroll
    for (int r = 0; r < 16; ++r) p0[r] = fmaf(p0[r], C, mnC);
#pragma unroll
    for (int r = 0; r < 16; ++r) p1[r] = fmaf(p1[r], C, mnC);
#pragma unroll
    for (int r = 0; r < 16; ++r) p0[r] = __builtin_amdgcn_exp2f(p0[r]);
}
__device__ __forceinline__ void finishSM(f32x16& p0, f32x16& p1, float alpha, float& l_reg, bf16x8& pa0, bf16x8& pa1, bf16x8& pa2, bf16x8& pa3) {
#pragma unroll
    for (int r = 0; r < 16; ++r) p1[r] = __builtin_amdgcn_exp2f(p1[r]);
    float ps = 0;
#pragma unroll
    for (int r = 0; r < 16; ++r) ps += p0[r];
#pragma unroll
    for (int r = 0; r < 16; ++r) ps += p1[r];
    { auto rr = __builtin_amdgcn_permlane32_swap(__float_as_uint(ps), __float_as_uint(ps), false, false);
      ps = __uint_as_float(rr[0]) + __uint_as_float(rr[1]); }
    l_reg = l_reg * alpha + ps;
#define PK4(P, BASE, OUT) do { unsigned a0 = cvtpk(P[BASE + 0], P[BASE + 1]), a1 = cvtpk(P[BASE + 2], P[BASE + 3]);   \
    unsigned b0 = cvtpk(P[BASE + 4], P[BASE + 5]), b1 = cvtpk(P[BASE + 6], P[BASE + 7]);                              \
    auto r0 = __builtin_amdgcn_permlane32_swap(a0, b0, false, false); auto r1 = __builtin_amdgcn_permlane32_swap(a1, b1, false, false); \
    v4u w = {r0[0], r1[0], r0[1], r1[1]}; OUT = *reinterpret_cast<bf16x8*>(&w); } while (0)
    PK4(p0, 0, pa0); PK4(p0, 8, pa1); PK4(p1, 0, pa2); PK4(p1, 8, pa3);
#undef PK4
}
template <int DR>
__device__ __forceinline__ void qkt(f32x16& p0, f32x16& p1, const LAS unsigned char* Ks, const LAS unsigned char* Rs, const bf16x8* qr, const bf16x8* qrr, int r32, int hi) {
    p0 = f32x16{}; p1 = f32x16{};
#pragma unroll
    for (int d0 = 0; d0 < 8; ++d0) { const int cb = (d0 * 16 + hi * 8) * 2;
        const bf16x8 b0 = *(const LAS bf16x8*)(Ks + KSWZ(r32, cb));
        const bf16x8 b1 = *(const LAS bf16x8*)(Ks + KSWZ(32 + r32, cb));
        p0 = __builtin_amdgcn_mfma_f32_32x32x16_bf16(b0, qr[d0], p0, 0, 0, 0);
        p1 = __builtin_amdgcn_mfma_f32_32x32x16_bf16(b1, qr[d0], p1, 0, 0, 0); }
    if constexpr (DR > 0) {
#pragma unroll
        for (int d0 = 0; d0 < DR / 16; ++d0) { const int cb = (d0 * 16 + hi * 8) * 2;
            const bf16x8 b0 = *(const LAS bf16x8*)(Rs + RSWZ(r32, cb));
            const bf16x8 b1 = *(const LAS bf16x8*)(Rs + RSWZ(32 + r32, cb));
            p0 = __builtin_amdgcn_mfma_f32_32x32x16_bf16(b0, qrr[d0], p0, 0, 0, 0);
            p1 = __builtin_amdgcn_mfma_f32_32x32x16_bf16(b1, qrr[d0], p1, 0, 0, 0); }
    }
}
__device__ __forceinline__ void mask_tile(f32x16& p0, f32x16& p1, int tile, int kmax, int hi) {
    const int kb = tile * 64;
    if (kb + 64 > kmax) {
#pragma unroll
        for (int r = 0; r < 16; ++r) { const int k0 = kb + crow(r, hi); if (k0 >= kmax) p0[r] = -1e30f; if (k0 + 32 >= kmax) p1[r] = -1e30f; }
    }
}
__device__ __forceinline__ int v_st(int k, int c) { const int kk = (k & ~0xC) | ((k & 4) << 1) | ((k & 8) >> 1); return ((kk >> 3) * 4 + (c >> 5)) * 512 + ((kk & 7) * 32 + (c & 31)) * 2; }
__device__ __forceinline__ int v_rd_base(int lane) { return ((lane & 3) << 3) | (((lane >> 2) & 3) << 6) | (((lane >> 4) & 1) << 5) | (((lane >> 5) & 1) << 8); }
constexpr int v_rd_off(int d0, int ks, int half) { return d0 * 512 + ks * 4096 + half * 2048; }
template <int OFF> __device__ __forceinline__ s16x4 tr_read(int vb) {
    s16x4 r; asm volatile("ds_read_b64_tr_b16 %0, %1 offset:%2" : "=&v"(r) : "v"(vb), "i"(OFF) : "memory"); return r;
}
template <int D0> __device__ __forceinline__ void pv_one(f32x16& od, int vb, bf16x8 pa0, bf16x8 pa1, bf16x8 pa2, bf16x8 pa3) {
    const s16x4 l0 = tr_read<v_rd_off(D0, 0, 0)>(vb), h0 = tr_read<v_rd_off(D0, 0, 1)>(vb), l1 = tr_read<v_rd_off(D0, 1, 0)>(vb), h1 = tr_read<v_rd_off(D0, 1, 1)>(vb);
    const s16x4 l2 = tr_read<v_rd_off(D0, 2, 0)>(vb), h2 = tr_read<v_rd_off(D0, 2, 1)>(vb), l3 = tr_read<v_rd_off(D0, 3, 0)>(vb), h3 = tr_read<v_rd_off(D0, 3, 1)>(vb);
    asm volatile("s_waitcnt lgkmcnt(0)" ::: "memory"); SBAR();
#define PK(L, H) (bf16x8){L[0], L[1], L[2], L[3], H[0], H[1], H[2], H[3]}
    od = __builtin_amdgcn_mfma_f32_32x32x16_bf16(pa0, PK(l0, h0), od, 0, 0, 0);
    od = __builtin_amdgcn_mfma_f32_32x32x16_bf16(pa1, PK(l1, h1), od, 0, 0, 0);
    od = __builtin_amdgcn_mfma_f32_32x32x16_bf16(pa2, PK(l2, h2), od, 0, 0, 0);
    od = __builtin_amdgcn_mfma_f32_32x32x16_bf16(pa3, PK(l3, h3), od, 0, 0, 0);
#undef PK
}
__device__ __forceinline__ void pv_d0(f32x16* o, int vb, bf16x8 pa0, bf16x8 pa1, bf16x8 pa2, bf16x8 pa3) {
    pv_one<0>(o[0], vb, pa0, pa1, pa2, pa3); pv_one<1>(o[1], vb, pa0, pa1, pa2, pa3); pv_one<2>(o[2], vb, pa0, pa1, pa2, pa3); pv_one<3>(o[3], vb, pa0, pa1, pa2, pa3);
}

template <int DR, bool PP, bool NTL, class KN, class KR, class VV>
__device__ __forceinline__ void attn_unit(LAS unsigned char* lds, const bf16* qn, const bf16* qrp, KN kn, KR kr, VV vv, int NT, int kmax, float C, float thr_s,
                                          bf16* orow0, int ldo, int nvalid, bool active, int wave_id) {
    const int wid = wave_id, lane = lane_id(), tid = wid * 64 + lane, r32 = lane & 31, hi = lane >> 5;
    LAS unsigned char* V_lds = lds + OFF_V; LAS unsigned char* K_lds = lds + OFF_K; LAS unsigned char* R_lds = lds + OFF_R;
    LAS float* ws = (LAS float*)(lds + OFF_WS) + wid * 64; LAS float* li_l = ws; LAS float* al_l = ws + 32;
    float m_reg = -1e30f, l_reg = 0.f; f32x16 o[4] = {}; bf16x8 qr[8]; bf16x8 qrr[DR > 0 ? DR / 16 : 1];
#pragma unroll
    for (int d0 = 0; d0 < 8; ++d0) qr[d0] = *(const bf16x8*)(qn + d0 * 16 + hi * 8);
    if constexpr (DR > 0) {
#pragma unroll
        for (int d0 = 0; d0 < DR / 16; ++d0) qrr[d0] = *(const bf16x8*)(qrp + d0 * 16 + hi * 8);
    }
    const int sr = tid >> 4, sc = (tid & 15) * 8, vst0 = v_st(sr, sc), vst1 = v_st(32 + sr, sc), rr_ = tid >> 3, rc = (tid & 7) * 8;
    const int vb0 = (int)(unsigned)(uintptr_t)V_lds + v_rd_base(lane);
    bf16x8 s_vs0, s_vs1, s_ks0, s_ks1, s_rs;
    const bf16x8 zero8 = {0, 0, 0, 0, 0, 0, 0, 0};
#define ATT_LD8(p) (NTL ? __builtin_nontemporal_load((const bf16x8*)(p)) : *(const bf16x8*)(p))
#define SLOAD(k0) do { const bf16* _p; _p = vv((k0) + sr); s_vs0 = _p ? ATT_LD8(_p + sc) : zero8; _p = vv((k0) + 32 + sr); s_vs1 = _p ? ATT_LD8(_p + sc) : zero8; \
    _p = kn((k0) + sr); s_ks0 = _p ? ATT_LD8(_p + sc) : zero8; _p = kn((k0) + 32 + sr); s_ks1 = _p ? ATT_LD8(_p + sc) : zero8; \
    if constexpr (DR > 0) { _p = kr((k0) + rr_); s_rs = _p ? ATT_LD8(_p + rc) : zero8; } } while (0)
#define SWRITE(b) do { *(LAS bf16x8*)(V_lds + (b) * SHM_V + vst0) = s_vs0; *(LAS bf16x8*)(V_lds + (b) * SHM_V + vst1) = s_vs1; \
    *(LAS bf16x8*)(K_lds + (b) * SHM_K + KSWZ(sr, sc * 2)) = s_ks0; *(LAS bf16x8*)(K_lds + (b) * SHM_K + KSWZ(32 + sr, sc * 2)) = s_ks1; \
    if constexpr (DR > 0) { *(LAS bf16x8*)(R_lds + (b) * SHM_R + RSWZ(rr_, rc * 2)) = s_rs; } } while (0)
#define SWAIT() asm volatile("s_waitcnt vmcnt(0)" ::: "memory")
#define RESC(a) do { if (__any((a) < 1.f)) { if (hi == 0) al_l[r32] = (a); asm volatile("s_waitcnt lgkmcnt(0)" ::: "memory"); \
    _Pragma("unroll") for (int d = 0; d < 4; ++d) _Pragma("unroll") for (int r = 0; r < 16; ++r) o[d][r] *= al_l[crow(r, hi)]; } } while (0)
    f32x16 p0, p1; float mn, al = 1.f; bf16x8 pa0, pa1, pa2, pa3;
    SLOAD(0); SWAIT(); SWRITE(0); if (!PP && 1 < NT) SLOAD(64); __syncthreads();
    if constexpr (PP) {
        const bool grpA = wid < 4;
#define ATT_STAGE(j) do { if ((j) + 1 < NT) { SWAIT(); SWRITE(((j) + 1) & 1); if ((j) + 2 < NT) SLOAD(((j) + 2) * 64); } } while (0)
        if (1 < NT) SLOAD(64);
        if (!grpA) __syncthreads();
        for (int j = 0; j < NT; ++j) {
            SBAR();
            qkt<DR>(p0, p1, K_lds + (j & 1) * SHM_K, R_lds + (j & 1) * SHM_R, qr, qrr, r32, hi); mask_tile(p0, p1, j, kmax, hi);
            if (!grpA) ATT_STAGE(j);
            __syncthreads();
            partialSM(p0, p1, m_reg, mn, al, C, thr_s); RESC(al); finishSM(p0, p1, al, l_reg, pa0, pa1, pa2, pa3); SBAR();
            pv_d0(o, vb0 + (j & 1) * SHM_V, pa0, pa1, pa2, pa3);
            if (grpA) ATT_STAGE(j);
            __syncthreads();
        }
        if (grpA) __syncthreads();
#undef ATT_STAGE
    } else {
    for (int j = 0; j < NT; ++j) {
        const int bsel = j & 1;
        if (j + 1 < NT) { SWAIT(); SWRITE(bsel ^ 1); if (j + 2 < NT) SLOAD((j + 2) * 64); }
        SBAR();
        if (active) {
            qkt<DR>(p0, p1, K_lds + bsel * SHM_K, R_lds + bsel * SHM_R, qr, qrr, r32, hi); mask_tile(p0, p1, j, kmax, hi);
            partialSM(p0, p1, m_reg, mn, al, C, thr_s);
            RESC(al);
            finishSM(p0, p1, al, l_reg, pa0, pa1, pa2, pa3); SBAR();
            pv_d0(o, vb0 + bsel * SHM_V, pa0, pa1, pa2, pa3);
        }
        __syncthreads();
    }
    }
    if (active) {
        if (hi == 0) li_l[r32] = l_reg; asm volatile("s_waitcnt lgkmcnt(0)" ::: "memory");
#pragma unroll
        for (int r = 0; r < 16; ++r) { const int orow = crow(r, hi); const float rli = __builtin_amdgcn_rcpf(li_l[orow]);
            if (orow < nvalid) {
#pragma unroll
                for (int d0 = 0; d0 < 4; ++d0) orow0[(size_t)orow * ldo + d0 * 32 + r32] = (bf16)f2bf(o[d0][r] * rli); } }
    }
    __syncthreads();
#undef SLOAD
#undef ATT_LD8
#undef SWRITE
#undef SWAIT
#undef RESC
}
}

namespace scan {
constexpr int PC = 136, PT = 72, PH = 264;
constexpr int O_BV = 0, O_XT = 16384, O_XW = O_XT + 4096, O_CS = O_XW + 4096, O_BS = O_CS + 64 * PC * 2, O_GS = O_BS + 64 * PC * 2,
              O_HT = O_GS + 64 * PT * 2, O_YS = O_HT + 32 * PH * 2, O_XSF = O_YS + 64 * 33 * 4, O_ZS = O_XSF + 64 * 32 * 4, O_CUM = O_ZS + 64 * 32 * 4,
              O_DTL = O_CUM + 2 * 5 * 64 * 4, O_END = O_DTL + 8192 * 4;
static_assert(O_END <= MISC_OFF, "scan LDS");
struct Bufs { bf16 *T1, *ZG, *QK, *BC; const float* DT; float *SSQG, *SSQH; const float *alog, *dskip; };

__device__ __forceinline__ int v_st32(int k, int c) { const int kk = (k & ~0xC) | ((k & 4) << 1) | ((k & 8) >> 1); return (kk >> 3) * 512 + ((kk & 7) * 32 + c) * 2; }
#define TRPK(L, H) (bf16x8){L[0], L[1], L[2], L[3], H[0], H[1], H[2], H[3]}
#define TRKL(k) const s16x4 _al##k = att::tr_read<(2 * (k)) * 512>(xwb), _ah##k = att::tr_read<(2 * (k) + 1) * 512>(xwb), _bl##k = att::tr_read<(k) * 4096>(bvb), _bh##k = att::tr_read<(k) * 4096 + 2048>(bvb)
#define TRKM(k) hacc = __builtin_amdgcn_mfma_f32_32x32x16_bf16(TRPK(_al##k, _ah##k), TRPK(_bl##k, _bh##k), hacc, 0, 0, 0)
#define TRYL(k) const bf16x8 _ya##k = frag(GS, PT, 32 * ti + r32, 16 * (k) + 8 * hi); const s16x4 _yl##k = att::tr_read<(2 * (k)) * 512>(xtb), _yh##k = att::tr_read<(2 * (k) + 1) * 512>(xtb)
#define TRYM(k) gacc = __builtin_amdgcn_mfma_f32_32x32x16_bf16(_ya##k, TRPK(_yl##k, _yh##k), gacc, 0, 0, 0)
__device__ __forceinline__ bf16x8 frag(const LAS unsigned char* base, int pitch, int row, int k0) { return *(const LAS bf16x8*)(base + (row * pitch + k0) * 2); }

template <bool SSD>
__device__ __forceinline__ void scan_unit(LAS unsigned char* lds, const Bufs& B, int rowbase, int nchunks, int tv_last, int h, int sl,
                                          const float* h0, float* hout, int wave_id) {
    constexpr int NS = SSD ? 128 : 256, NH = NS / 128, PF = SSD ? 64 : 256, PHT = NS + 8;
    const int wid = wave_id, lane = lane_id(), tid = wid * 64 + lane, r32 = lane & 31, hi = lane >> 5;
    LAS unsigned char* CS = lds + O_CS; LAS unsigned char* BS = lds + O_BS; LAS unsigned char* BV = lds + O_BV; LAS unsigned char* XT = lds + O_XT;
    LAS unsigned char* XW = lds + O_XW; LAS unsigned char* GS = lds + O_GS; LAS unsigned char* HT = lds + O_HT;
    LAS float* YS = (LAS float*)(lds + O_YS); LAS float* XSF = (LAS float*)(lds + O_XSF); LAS float* ZS = (LAS float*)(lds + O_ZS);
    LAS float* DTL = (LAS float*)(lds + O_DTL);
    LAS float* CUMB = (LAS float*)(lds + O_CUM);
    const int g = h >> 3;
    const bool has_state = SSD ? (wid < 4) : true;
    const int n0 = wid * 32;
    const float a_h = SSD ? -__expf(B.alog[h]) : 0.f, lgam = SSD ? 0.f : LOG_GAMMA[h], dsk = SSD ? B.dskip[h] : 0.f;
    const int xcol = SSD ? h * 64 + sl * 32 : 2048 + h * 256 + sl * 32;
    const int isB = wid >> 2, tt = tid & 255;
    const bf16* cbsrc = SSD ? B.BC + (isB ? 0 : 512) + g * 128 : B.QK + (isB ? 2048 : 0) + h * 256; const int cbp = SSD ? 1024 : 4096;
    f32x16 hacc = {}, gacc = {};
    v4u rX = {0u, 0u, 0u, 0u}, rZ = {0u, 0u, 0u, 0u}, rCB[NH][4]; float rdt = 0.f;
    const v4u zero4 = {0u, 0u, 0u, 0u};
#define SC_SYNC() do { asm volatile("s_waitcnt lgkmcnt(0)" ::: "memory"); __builtin_amdgcn_s_barrier(); asm volatile("" ::: "memory"); } while (0)
#define SC_TV(c) (((c) == nchunks - 1) ? tv_last : 64)
#define SC_LOAD_X(c) do { const int _tv = SC_TV(c); const size_t _R0 = (size_t)rowbase + (size_t)(c) * 64; if (tid < 256) { const int _l = tid >> 2, _c8 = (tid & 3) * 8; \
        rX = _l < _tv ? *(const v4u*)(B.T1 + (_R0 + _l) * 4096 + xcol + _c8) : zero4; if (SSD) rZ = _l < _tv ? *(const v4u*)(B.ZG + (_R0 + _l) * 4096 + xcol + _c8) : zero4; } } while (0)
#define SC_LOAD_CB(c, nh) do { const int _tv = SC_TV(c); const size_t _R0 = (size_t)rowbase + (size_t)(c) * 64; _Pragma("unroll") for (int _i = 0; _i < 4; ++_i) { const int _id = tt + 256 * _i, _row = _id >> 4, _oct = _id & 15; \
        rCB[nh][_i] = _row < _tv ? *(const v4u*)(cbsrc + (_R0 + _row) * cbp + (nh) * 128 + _oct * 8) : zero4; } } while (0)
#define SC_LOAD_DT(c) do { if (SSD && wid == 0) rdt = lane < SC_TV(c) ? DTL[(c) * 64 + lane] : 0.f; } while (0)
#define SC_CUM(c) do { if (wid == 0) { LAS float* _cb = CUMB + ((c) & 1) * 320; const float _la = SSD ? rdt * a_h : (lane < SC_TV(c) ? lgam : 0.f); float _cum = _la; \
        _Pragma("unroll") for (int _o = 1; _o < 64; _o <<= 1) { const float _t = __shfl_up(_cum, _o); if (lane >= _o) _cum += _t; } \
        const float _last = __shfl(_cum, 63); _cb[lane] = _cum; _cb[64 + lane] = __expf(_cum); _cb[128 + lane] = __expf(_last - _cum); _cb[192 + lane] = rdt; if (lane == 0) _cb[256] = __expf(_last); } } while (0)
#define SC_STAGE(c, nh) do { const LAS float* _cb = CUMB + ((c) & 1) * 320; \
        if ((nh) == 0 && tid < 256) { const int _l = tid >> 2, _c8 = (tid & 3) * 8; const float _dtl = SSD ? _cb[192 + _l] : 1.f, _wdl = _cb[128 + _l]; \
            const float _x[8] = {bflo(rX.x), bfhi(rX.x), bflo(rX.y), bfhi(rX.y), bflo(rX.z), bfhi(rX.z), bflo(rX.w), bfhi(rX.w)}; \
            float _X[8], _W[8]; _Pragma("unroll") for (int _i = 0; _i < 8; ++_i) { _X[_i] = _x[_i] * _dtl; _W[_i] = _X[_i] * _wdl; if (SSD) XSF[_l * 32 + _c8 + _i] = _x[_i]; } \
            { v4u _q; _q.x = pk2(_X[0], _X[1]); _q.y = pk2(_X[2], _X[3]); _q.z = pk2(_X[4], _X[5]); _q.w = pk2(_X[6], _X[7]); *(LAS v4u*)(XT + v_st32(_l, _c8)) = _q; \
              _q.x = pk2(_W[0], _W[1]); _q.y = pk2(_W[2], _W[3]); _q.z = pk2(_W[4], _W[5]); _q.w = pk2(_W[6], _W[7]); *(LAS v4u*)(XW + v_st32(_l, _c8)) = _q; } \
            if (SSD) { LAS float* _zs = ZS + _l * 32 + _c8; _zs[0] = bflo(rZ.x); _zs[1] = bfhi(rZ.x); _zs[2] = bflo(rZ.y); _zs[3] = bfhi(rZ.y); _zs[4] = bflo(rZ.z); _zs[5] = bfhi(rZ.z); _zs[6] = bflo(rZ.w); _zs[7] = bfhi(rZ.w); } } \
        { LAS unsigned char* _dst = isB ? BS : CS; \
          _Pragma("unroll") for (int _i = 0; _i < 4; ++_i) { const int _id = tt + 256 * _i, _row = _id >> 4, _oct = _id & 15; const v4u _w = rCB[nh][_i]; \
            *(LAS v4u*)(_dst + (_row * PC + _oct * 8) * 2) = _w; \
            if (isB) *(LAS v4u*)(BV + att::v_st(_row, _oct * 8)) = _w; } } \
        if ((c) + 1 < nchunks && (nh) == NH - 1) { SC_LOAD_X((c) + 1); _Pragma("unroll") for (int _hh = 0; _hh < NH; ++_hh) SC_LOAD_CB((c) + 1, _hh); } } while (0)

    if (SSD) { const int nrows = (nchunks - 1) * 64 + tv_last; for (int i = tid; i < nrows; i += 512) DTL[i] = B.DT[((size_t)rowbase + i) * 32 + h]; }
    __syncthreads();
    SC_LOAD_DT(0); SC_LOAD_X(0);
#pragma unroll
    for (int nh = 0; nh < NH; ++nh) SC_LOAD_CB(0, nh);
    if (has_state) {
        if (h0 != nullptr) {
#pragma unroll
            for (int q = 0; q < 4; ++q) { const f32x4 v = *(const f32x4*)(h0 + (size_t)(n0 + r32) * PF + sl * 32 + 8 * q + 4 * hi);
                hacc[4 * q + 0] = v[0]; hacc[4 * q + 1] = v[1]; hacc[4 * q + 2] = v[2]; hacc[4 * q + 3] = v[3]; }
        }
#pragma unroll
        for (int r = 0; r < 16; ++r) *(LAS bf16*)(HT + (att::crow(r, hi) * PHT + n0 + r32) * 2) = (bf16)f2bf(hacc[r]);
    }
    SC_CUM(0); if (nchunks > 1) SC_LOAD_DT(1);
    SC_SYNC();
    SC_STAGE(0, 0);
    for (int c = 0; c < nchunks; ++c) {
        const int R0 = rowbase + c * 64, tv = SC_TV(c);
        const LAS float* cb = CUMB + (c & 1) * 320;
#pragma unroll
        for (int nh = 0; nh < NH; ++nh) {
            if (nh > 0) { SC_SYNC(); SC_STAGE(c, nh); }
            SC_SYNC();
            if (wid < 4) {
                const int ti = wid >> 1, tj = wid & 1;
#pragma unroll
                for (int kb = 0; kb < 2; ++kb) { bf16x8 fa[4], fb[4];
#pragma unroll
                    for (int q = 0; q < 4; ++q) { const int k0 = 16 * (4 * kb + q) + 8 * hi; fa[q] = frag(CS, PC, 32 * ti + r32, k0); fb[q] = frag(BS, PC, 32 * tj + r32, k0); }
                    asm volatile("s_waitcnt lgkmcnt(0)" ::: "memory"); __builtin_amdgcn_sched_barrier(0);
#pragma unroll
                    for (int q = 0; q < 4; ++q) gacc = __builtin_amdgcn_mfma_f32_32x32x16_bf16(fa[q], fb[q], gacc, 0, 0, 0); }
            } else if (wid < 6) {
                const int ti = wid - 4;
#pragma unroll
                for (int kb = 0; kb < 2; ++kb) { bf16x8 fa[4], fb[4];
#pragma unroll
                    for (int q = 0; q < 4; ++q) { const int k0 = 16 * (4 * kb + q) + 8 * hi; fa[q] = frag(CS, PC, 32 * ti + r32, k0); fb[q] = frag(HT, PHT, r32, nh * 128 + k0); }
                    asm volatile("s_waitcnt lgkmcnt(0)" ::: "memory"); __builtin_amdgcn_sched_barrier(0);
#pragma unroll
                    for (int q = 0; q < 4; ++q) gacc = __builtin_amdgcn_mfma_f32_32x32x16_bf16(fa[q], fb[q], gacc, 0, 0, 0); }
            }
            if (has_state && (wid >> 2) == nh) {
                const float el = cb[256];
#pragma unroll
                for (int r = 0; r < 16; ++r) hacc[r] *= el;
                { const int xwb = (int)(unsigned)(uintptr_t)XW + att::v_rd_base(lane), bvb = (int)(unsigned)(uintptr_t)BV + att::v_rd_base(lane) + (wid & 3) * 512;
                  TRKL(0); TRKL(1); TRKL(2); TRKL(3);
                  asm volatile("s_waitcnt lgkmcnt(0)" ::: "memory"); __builtin_amdgcn_sched_barrier(0);
                  TRKM(0); TRKM(1); TRKM(2); TRKM(3); }
            }
        }
        if (wid < 4) { const int ti = wid >> 1, tj = wid & 1, s = 32 * tj + r32; const float cs = cb[s];
#pragma unroll
            for (int q = 0; q < 4; ++q) { const f32x4 cl4 = *(const LAS f32x4*)(cb + 32 * ti + 8 * q + 4 * hi);
#pragma unroll
                for (int e = 0; e < 4; ++e) { const int r = 4 * q + e, l = 32 * ti + att::crow(r, hi);
                    const float ex = __expf(fminf(cl4[e] - cs, 0.f)); const float v = l >= s ? gacc[r] * ex : 0.f;
                    *(LAS bf16*)(GS + (l * PT + s) * 2) = (bf16)f2bf(v); gacc[r] = 0.f; } } }
        SC_SYNC();
        if (wid >= 4 && wid < 6) { const int ti = wid - 4;
#pragma unroll
            for (int q = 0; q < 4; ++q) { const f32x4 e4 = *(const LAS f32x4*)(cb + 64 + 32 * ti + 8 * q + 4 * hi);
                gacc[4 * q + 0] *= e4[0]; gacc[4 * q + 1] *= e4[1]; gacc[4 * q + 2] *= e4[2]; gacc[4 * q + 3] *= e4[3]; }
            { const int xtb = (int)(unsigned)(uintptr_t)XT + att::v_rd_base(lane);
              TRYL(0); TRYL(1); TRYL(2); TRYL(3);
              asm volatile("s_waitcnt lgkmcnt(0)" ::: "memory"); __builtin_amdgcn_sched_barrier(0);
              TRYM(0); TRYM(1); TRYM(2); TRYM(3); }
            float xs_[16], zs_[16];
            if (SSD) {
#pragma unroll
                for (int r = 0; r < 16; ++r) { const int l = 32 * ti + att::crow(r, hi); xs_[r] = XSF[l * 32 + r32]; zs_[r] = ZS[l * 32 + r32]; } }
#pragma unroll
            for (int r = 0; r < 16; ++r) { const int l = 32 * ti + att::crow(r, hi); float y = gacc[r];
                if (SSD) y = (y + dsk * xs_[r]) * silu_f(zs_[r]);
                YS[l * 33 + r32] = y; gacc[r] = 0.f; } }
        if (has_state) {
#pragma unroll
            for (int r = 0; r < 16; ++r) *(LAS bf16*)(HT + (att::crow(r, hi) * PHT + n0 + r32) * 2) = (bf16)f2bf(hacc[r]); }
        if (c + 1 < nchunks) { SC_CUM(c + 1); if (c + 2 < nchunks) SC_LOAD_DT(c + 2); }
        SC_SYNC();
        if (c + 1 < nchunks) SC_STAGE(c + 1, 0);
        { const int l = tid >> 3, p4 = (tid & 7) * 4; float v[4]; float ss = 0.f;
#pragma unroll
          for (int i = 0; i < 4; ++i) { v[i] = YS[l * 33 + p4 + i]; ss += v[i] * v[i]; }
          ss += __shfl_xor(ss, 1); ss += __shfl_xor(ss, 2); ss += __shfl_xor(ss, 4);
          if (l < tv) {
              v2u w; w.x = pk2(v[0], v[1]); w.y = pk2(v[2], v[3]);
              *(v2u*)(B.T1 + (size_t)(R0 + l) * 4096 + xcol + p4) = w;
              if ((tid & 7) == 0) { if (SSD) B.SSQG[(size_t)(R0 + l) * 64 + g * 16 + (h & 7) * 2 + sl] = ss; else B.SSQH[(size_t)(R0 + l) * 64 + h * 8 + sl] = ss; }
          } }
    }
    if (has_state) {
#pragma unroll
        for (int q = 0; q < 4; ++q) { f32x4 v; v[0] = hacc[4 * q + 0]; v[1] = hacc[4 * q + 1]; v[2] = hacc[4 * q + 2]; v[3] = hacc[4 * q + 3];
            *(f32x4*)(hout + (size_t)(n0 + r32) * PF + sl * 32 + 8 * q + 4 * hi) = v; }
    }
    __syncthreads();
#undef SC_SYNC
#undef SC_TV
#undef SC_LOAD_X
#undef SC_LOAD_CB
#undef SC_LOAD_DT
#undef SC_CUM
#undef SC_STAGE
}
}

constexpr int N_PHASES = 37;
constexpr size_t S_HB = S_L0END;
static_assert(S_HB + (size_t)512 * 3 * 3072 * 2 <= S_MAX || true, "");
static_assert(O_SCR + S_HB + (size_t)512 * 3 * 3072 * 2 <= (size_t)1476395008, "halo buffer inside the workspace");

struct Ctx { LAS unsigned char* lds; unsigned char* ws; float* out; int G, wg, wave; };
#define CTX_GW() const int gw = C.wg * NWAVES + C.wave, NGW = C.G * NWAVES
#define CTX_GT() const size_t gt = (size_t)C.wg * (NWAVES * 64) + C.wave * 64 + lane_id(), NGT = (size_t)C.G * (NWAVES * 64)
#define W_SSQ ((u64*)(C.ws + O_SSQ))
#define W_XB ((bf16*)(C.ws + O_XB))
#define W_X (C.out + OUT_Y)
#define W_SCR (C.ws + O_SCR)

__device__ __forceinline__ void ph_prologue(const Ctx& C, const Params& P) {
    CTX_GW(); CTX_GT(); unsigned char* ws = C.ws; const int lane = lane_id();
    LAS float* wscr = (LAS float*)(C.lds + C.wave * 16384);
#pragma unroll 1
    for (int lf = 0; lf < 4; ++lf) {
        const int l = lf >> 1, f = lf & 1;
        cvt_weight(P.in[I_W1] + (size_t)lf * D * 2 * DFF, D, 2 * DFF, P.in[I_NORMS] + (l * 4 + (f ? 3 : 0)) * D, D, (bf16*)(ws + O_W1 + lf * SZ_W1), 2 * DFF, SmW1{}, wscr, gw, NGW, lane);
        cvt_weight(P.in[I_W2] + (size_t)lf * DFF * D, DFF, D, nullptr, 0, (bf16*)(ws + O_W2 + lf * SZ_W2), D, SmId{D}, wscr, gw, NGW, lane);
    }
    cvt_weight(P.in[I_ABWIN], D, 13344, P.in[I_NORMS] + 1 * D, D, (bf16*)(ws + O_WIN), WIN_N, SmWin{}, wscr, gw, NGW, lane);
    cvt_weight(P.in[I_ABWOUT], 4096, D, P.in[I_SSDN], 2048, (bf16*)(ws + O_WOUT), D, SmId{D}, wscr, gw, NGW, lane);
    cvt_weight(P.in[I_CWIN], D, 1088, P.in[I_NORMS] + (4 + 1) * D, D, (bf16*)(ws + O_CWIN), CWIN_N, SmId{1088}, wscr, gw, NGW, lane);
    cvt_weight(P.in[I_WUQ], 512, 3072, nullptr, 0, (bf16*)(ws + O_WUQ), 3072, SmUq{}, wscr, gw, NGW, lane);
    cvt_weight(P.in[I_WUK], 512, 2048, nullptr, 0, (bf16*)(ws + O_WKV), 2048, SmId{2048}, wscr, gw, NGW, lane);
    cvt_weight(P.in[I_WUV], 512, 2048, nullptr, 0, (bf16*)(ws + O_WKV) + (size_t)2048 * 512, 2048, SmId{2048}, wscr, gw, NGW, lane);
    cvt_weight(P.in[I_CWOUT], D, D, nullptr, 0, (bf16*)(ws + O_CWOUT), D, SmId{D}, wscr, gw, NGW, lane);
#pragma unroll 1
    for (int l = 0; l < 2; ++l) {
        cvt_weight(P.in[I_WMQ] + (size_t)l * D * 512, D, 512, P.in[I_NORMS] + (l * 4 + 2) * D, D, (bf16*)(ws + O_WMQ) + (size_t)l * 512 * D, 512, SmId{512}, wscr, gw, NGW, lane);
        cvt_weight(P.in[I_WMKV] + (size_t)l * D * 1024, D, 1024, P.in[I_MNORM] + l * D, D, (bf16*)(ws + O_WMKV) + (size_t)l * 1024 * D, 1024, SmId{1024}, wscr, gw, NGW, lane);
        cvt_weight(P.in[I_WMO] + (size_t)l * 512 * D, 512, D, nullptr, 0, (bf16*)(ws + O_WMO) + (size_t)l * D * 512, D, SmId{D}, wscr, gw, NGW, lane);
    }
    u64* SSQ = W_SSQ; bf16* XB = W_XB;
    for (int row = gw; row < M; row += NGW) {
        const float* src = row < MP ? P.in[I_XP] + (size_t)row * D : P.in[I_XS] + (size_t)(row - MP) * D;
        const float ss = row_to_bf16(src, XB + (size_t)row * XBP, lane);
        if (lane == 0) SSQ[row] = ssq_fix(ss);
    }
    { bf16* MB = (bf16*)(ws + O_MB); float* SSQM = (float*)(ws + O_SSQM);
      for (int row = gw; row < 1024; row += NGW) { const float ss = row_to_bf16(P.in[I_MEM] + (size_t)row * D, MB + (size_t)row * D, lane); if (lane == 0) SSQM[row] = ss; } }
    { float* COSR = (float*)(ws + O_COSR); float* SINR = (float*)(ws + O_SINR); float* COSM = (float*)(ws + O_COSM); float* SINM = (float*)(ws + O_SINM);
      for (size_t i = gt; i < (size_t)8192 * 160; i += NGT) {
        const int pos = (int)(i / 160), j = (int)(i % 160);
        const double inv = j < 128 ? INV_R[j] : INV_M[j - 128];
        const double t = (double)pos * inv * 0.15915494309189533577; const float fr = (float)(t - floor(t));
        const float sv = __builtin_amdgcn_sinf(fr), cv = __builtin_amdgcn_cosf(fr);
        if (j < 128) { COSR[(size_t)pos * 128 + j] = cv; SINR[(size_t)pos * 128 + j] = sv; } else { COSM[(size_t)pos * 32 + j - 128] = cv; SINM[(size_t)pos * 32 + j - 128] = sv; }
      } }
}

__device__ __forceinline__ void ph_w1(const Ctx& C, int lf) {
    const int L = lf >> 1, F = lf & 1;
    pg8::Gemm g{W_XB, (const bf16*)(C.ws + O_W1 + (size_t)lf * SZ_W1), M, 2 * DFF, D, XBP, D}; pg8::StaticOrder S = make_order(M, 2 * DFF, C.G, C.wg, 0);
    EpiSwiglu E{(bf16*)(W_SCR + S_H), W_SSQ + (size_t)(L * 4 + (F ? 3 : 0)) * M, C.lds};
    pg8::gemm_phase<EpiSwiglu, pg8::StaticOrder, true, true>(C.lds, g, S, E, C.wave);
    if (lf == 0) {
#pragma unroll 1
        for (int ml = 0; ml < 2; ++ml) {
            pg8::Gemm g2{(const bf16*)(C.ws + O_MB), (const bf16*)(C.ws + O_WMKV) + (size_t)ml * 1024 * D, 1024, 1024, D, D, D};
            pg8::StaticOrder S2 = make_order(1024, 1024, C.G, C.wg, (130 * 44) % 256 + 16 * ml);
            EpiMemKV E2{C.out + OUT_MEMK + (size_t)ml * 1024 * 512, C.out + OUT_MEMV + (size_t)ml * 1024 * 512, (bf16*)(C.ws + O_MKV) + (size_t)ml * 1024 * 1024, (const float*)(C.ws + O_SSQM)};
            pg8::gemm_phase<EpiMemKV, pg8::StaticOrder, true, true>(C.lds, g2, S2, E2, C.wave);
        }
    }
}

constexpr size_t S_PART_FFN = (size_t)384 << 20;
template <int KS, bool FIRST> __device__ __forceinline__ void res_gemm(const Ctx& C, const bf16* A, int lda, const bf16* Bt, int K, const float* src32, float alpha, u64* ssq_next, float* part) {
    { pg8::Gemm g{A, Bt, MP, D, K, lda, K}; pg8::StaticOrder S = make_order(MP, D, C.G, C.wg, 0);
      EpiRes<FIRST> E{src32, W_XB, ssq_next, alpha};
      pg8::gemm_phase<EpiRes<FIRST>, pg8::StaticOrder, true, true>(C.lds, g, S, E, C.wave); }
    { pg8::Gemm g{A + (size_t)MP * lda, Bt, MS, D, K, lda, K / KS}; SplitOrder S; S.init(MS, D, KS, C.G, C.wg);
      EpiPart E{part, D, (size_t)MS * D};
      pg8::gemm_phase<EpiPart, SplitOrder, true, true>(C.lds, g, S, E, C.wave); }
}
template <bool FIRST> __device__ __forceinline__ void ph_fin(const Ctx& C, const float* part, int KS, const float* src32, float alpha, u64* ssq_next) {
    CTX_GW(); const int lane = lane_id(); bf16* XB = W_XB;
    for (int it = gw; it < MS * 8; it += NGW) {
        const int r = it >> 3, c = (it & 7) * 256 + 4 * lane; const size_t o = (size_t)r * D + c;
        f32x4 a = *(const f32x4*)(part + o);
        for (int k = 1; k < KS; ++k) a += *(const f32x4*)(part + (size_t)k * MS * D + o);
        f32x4 s;
        if constexpr (FIRST) s = *(const f32x4*)(src32 + o); else { const v2u q = *(const v2u*)(XB + (size_t)(MP + r) * XBP + c); s = (f32x4){bflo(q.x), bfhi(q.x), bflo(q.y), bfhi(q.y)}; }
        const f32x4 v = s + a * alpha;
        v2u w; w.x = pk2(v[0], v[1]); w.y = pk2(v[2], v[3]); *(v2u*)(XB + (size_t)(MP + r) * XBP + c) = w;
        const float ss = wave_sum((v[0] * v[0] + v[1] * v[1]) + (v[2] * v[2] + v[3] * v[3]));
        if (lane == 0) ssq_add(ssq_next + MP + r, ss);
    }
}
template <bool FIRST> __device__ __forceinline__ void ph_w2(const Ctx& C, const Params& P, int lf) {
    const int L = lf >> 1, F = lf & 1;
    res_gemm<11, FIRST>(C, (const bf16*)(W_SCR + S_H), DFF, (const bf16*)(C.ws + O_W2 + (size_t)lf * SZ_W2), DFF, P.in[I_XP], 0.5f, W_SSQ + (size_t)(L * 4 + (F ? 4 : 1)) * M, (float*)(W_SCR + S_PART_FFN));
}
template <bool FIRST> __device__ __forceinline__ void ph_w2fin(const Ctx& C, const Params& P, int lf) {
    const int L = lf >> 1, F = lf & 1;
    ph_fin<FIRST>(C, (const float*)(W_SCR + S_PART_FFN), 11, P.in[I_XS], 0.5f, W_SSQ + (size_t)(L * 4 + (F ? 4 : 1)) * M);
}
__device__ __forceinline__ void ph_win(const Ctx& C, const Params& P) {
    pg8::Gemm g{W_XB, (const bf16*)(C.ws + O_WIN), M, WIN_N, D, XBP, D}; pg8::StaticOrder S = make_order(M, WIN_N, C.G, C.wg, 0);
    EpiWin E{(bf16*)(W_SCR + S_T1), (bf16*)(W_SCR + S_ZG), (bf16*)(W_SCR + S_QK), (bf16*)(W_SCR + S_BC), (float*)(W_SCR + S_DT), W_SSQ + (size_t)1 * M,
             (const float*)(C.ws + O_COSR), (const float*)(C.ws + O_SINR), P.in[I_DTB], C.lds};
    pg8::gemm_phase<EpiWin, pg8::StaticOrder, true, true>(C.lds, g, S, E, C.wave);
}
__device__ __forceinline__ const bf16* xbc_ptr(const bf16* T1, const bf16* BC, size_t row, int ch) { return ch < 2048 ? T1 + row * 4096 + ch : BC + row * 1024 + (ch - 2048); }
__device__ __forceinline__ void ph_halo(const Ctx& C) {
    CTX_GT(); const bf16* T1 = (const bf16*)(W_SCR + S_T1); const bf16* BC = (const bf16*)(W_SCR + S_BC); bf16* HB = (bf16*)(W_SCR + S_HB);
    for (size_t i = gt; i < (size_t)NBP * 128 * 3 * 384; i += NGT) {
        const int oct = (int)(i % 384), j = (int)((i / 384) % 3), cc = (int)(i / 1152), c = cc & 127, b = cc >> 7;
        if (c == 0) continue;
        const size_t row = (size_t)b * SEQ + c * 64 - 3 + j;
        *(v4u*)(HB + ((size_t)cc * 3 + j) * 3072 + oct * 8) = *(const v4u*)xbc_ptr(T1, BC, row, oct * 8);
    }
    for (size_t i = gt; i < (size_t)(NBP + NBS) * 3 * 384; i += NGT) {
        const int oct = (int)(i % 384), j = (int)((i / 384) % 3), b = (int)(i / 1152);
        const size_t row = b < NBP ? (size_t)b * SEQ + SEQ - 3 + j : (size_t)MP + (b - NBP) * TS + TS - 3 + j;
        float* o = b < NBP ? C.out + OUT_CONVP + (size_t)(b * 3 + j) * 3072 + oct * 8 : C.out + OUT_CONVS + (size_t)((b - NBP) * 3 + j) * 3072 + oct * 8;
        const v4u w = *(const v4u*)xbc_ptr(T1, BC, row, oct * 8);
        *(f32x4*)o = (f32x4){bflo(w.x), bfhi(w.x), bflo(w.y), bfhi(w.y)}; *(f32x4*)(o + 4) = (f32x4){bflo(w.z), bfhi(w.z), bflo(w.w), bfhi(w.w)};
    }
}
__device__ __forceinline__ void ph_conv(const Ctx& C, const Params& P) {
    CTX_GT(); bf16* T1 = (bf16*)(W_SCR + S_T1); bf16* BC = (bf16*)(W_SCR + S_BC); const bf16* HB = (const bf16*)(W_SCR + S_HB);
    const float* cwp = P.in[I_CONVW]; const float* cbp = P.in[I_CONVB]; const float* cst = P.in[I_SCONV];
    { float* DT = (float*)(W_SCR + S_DT); const float* dtb = P.in[I_DTB];
      for (size_t i = gt; i < (size_t)M * 32; i += NGT) { const float x = DT[i] + dtb[i & 31]; DT[i] = x > 20.f ? x : log1pf(__expf(x)); } }
    for (size_t i = gt; i < (size_t)(NBP * 128 + NBS) * 384; i += NGT) {
        const int oct = (int)(i % 384), cc = (int)(i / 384), ch = oct * 8;
        float w0[8], w1[8], w2[8], cw[4][8], cb[8];
#pragma unroll
        for (int e = 0; e < 8; ++e) { cb[e] = cbp[ch + e];
#pragma unroll
            for (int j = 0; j < 4; ++j) cw[j][e] = cwp[j * 3072 + ch + e]; }
        size_t row0; int nrows;
        if (cc < NBP * 128) { const int c = cc & 127, b = cc >> 7; row0 = (size_t)b * SEQ + c * 64; nrows = 64;
            if (c == 0) {
#pragma unroll
                for (int e = 0; e < 8; ++e) { w0[e] = 0.f; w1[e] = 0.f; w2[e] = 0.f; }
            } else { const bf16* hb = HB + (size_t)cc * 3 * 3072 + ch; const v4u a = *(const v4u*)hb, b2 = *(const v4u*)(hb + 3072), c2 = *(const v4u*)(hb + 6144);
                w0[0] = bflo(a.x); w0[1] = bfhi(a.x); w0[2] = bflo(a.y); w0[3] = bfhi(a.y); w0[4] = bflo(a.z); w0[5] = bfhi(a.z); w0[6] = bflo(a.w); w0[7] = bfhi(a.w);
                w1[0] = bflo(b2.x); w1[1] = bfhi(b2.x); w1[2] = bflo(b2.y); w1[3] = bfhi(b2.y); w1[4] = bflo(b2.z); w1[5] = bfhi(b2.z); w1[6] = bflo(b2.w); w1[7] = bfhi(b2.w);
                w2[0] = bflo(c2.x); w2[1] = bfhi(c2.x); w2[2] = bflo(c2.y); w2[3] = bfhi(c2.y); w2[4] = bflo(c2.z); w2[5] = bfhi(c2.z); w2[6] = bflo(c2.w); w2[7] = bfhi(c2.w); }
        } else { const int b = cc - NBP * 128; row0 = (size_t)MP + b * TS; nrows = TS; const float* s = cst + (size_t)b * 3 * 3072 + ch;
#pragma unroll
            for (int e = 0; e < 8; ++e) { w0[e] = s[e]; w1[e] = s[3072 + e]; w2[e] = s[6144 + e]; } }
        bf16* p = (bf16*)xbc_ptr(T1, BC, row0, ch); const size_t pitch = ch < 2048 ? 4096 : 1024;
        for (int r0 = 0; r0 < nrows; r0 += 8) {
            v4u wr[8];
#pragma unroll
            for (int q = 0; q < 8; ++q) wr[q] = *(const v4u*)(p + (size_t)(r0 + q) * pitch);
#pragma unroll
            for (int q = 0; q < 8; ++q) { const v4u w = wr[q];
                const float cur[8] = {bflo(w.x), bfhi(w.x), bflo(w.y), bfhi(w.y), bflo(w.z), bfhi(w.z), bflo(w.w), bfhi(w.w)}; float o[8];
#pragma unroll
                for (int e = 0; e < 8; ++e) { o[e] = silu_f(cb[e] + cw[0][e] * w0[e] + cw[1][e] * w1[e] + cw[2][e] * w2[e] + cw[3][e] * cur[e]); w0[e] = w1[e]; w1[e] = w2[e]; w2[e] = cur[e]; }
                v4u qo; qo.x = pk2(o[0], o[1]); qo.y = pk2(o[2], o[3]); qo.z = pk2(o[4], o[5]); qo.w = pk2(o[6], o[7]);
                *(v4u*)(p + (size_t)(r0 + q) * pitch) = qo; }
        }
    }
}
__device__ __forceinline__ void ph_scan(const Ctx& C, const Params& P) {
    scan::Bufs B{(bf16*)(W_SCR + S_T1), (bf16*)(W_SCR + S_ZG), (bf16*)(W_SCR + S_QK), (bf16*)(W_SCR + S_BC), (const float*)(W_SCR + S_DT), (float*)(C.ws + O_SSQG), (float*)(C.ws + O_SSQH), P.in[I_ALOG], P.in[I_DSKIP]};
    float* out = C.out;
#pragma unroll 1
    for (int u = C.wg; u < 256 + 2048; u += C.G) {
        const bool pr = u < 256; const int v = pr ? u : u - 256, w = v & 255, bg = (v >> 8) * 16 + (w & 7) * 2 + (w >> 7), j = (w >> 3) & 15, b = bg >> 2, h = (bg & 3) * 8 + (j >> 1), sl = j & 1;
        const size_t so = (size_t)(b * 32 + h) * 128 * 64;
        scan::scan_unit<true>(C.lds, B, pr ? b * SEQ : MP + b * TS, pr ? SEQ / 64 : 1, pr ? 64 : TS, h, sl, pr ? nullptr : P.in[I_SSSD] + so, pr ? out + OUT_SSDP + so : out + OUT_SSDS + so, C.wave);
    }
#pragma unroll 1
    for (int u = C.wg; u < 256 + 2048; u += C.G) {
        const bool pr = u < 256; const int v = pr ? u : u - 256, w = v & 255, bh = (v >> 8) * 32 + (w & 7) * 4 + (w >> 6), b = bh >> 3, h = bh & 7, sl = (w >> 3) & 7;
        const size_t so = (size_t)(b * 8 + h) * 256 * 256;
        scan::scan_unit<false>(C.lds, B, pr ? b * SEQ : MP + b * TS, pr ? SEQ / 64 : 1, pr ? 64 : TS, h, sl, pr ? nullptr : P.in[I_SRET] + so, pr ? out + OUT_RETP + so : out + OUT_RETS + so, C.wave);
    }
}
__device__ __forceinline__ void ph_norm(const Ctx& C) {
    CTX_GW(); bf16* T1 = (bf16*)(W_SCR + S_T1); const bf16* ZG = (const bf16*)(W_SCR + S_ZG); const float* SSQG = (const float*)(C.ws + O_SSQG); const float* SSQH = (const float*)(C.ws + O_SSQH);
    const int lane = lane_id();
    for (int row = gw; row < M; row += NGW) {
        v4u w[8], gq[4]; float sc[8];
#pragma unroll
        for (int k = 0; k < 8; ++k) w[k] = *(const v4u*)(T1 + (size_t)row * 4096 + (k * 64 + lane) * 8);
#pragma unroll
        for (int k = 0; k < 4; ++k) gq[k] = *(const v4u*)(ZG + (size_t)row * 4096 + ((k + 4) * 64 + lane) * 8);
#pragma unroll
        for (int k = 0; k < 4; ++k) {
            const float* pg = SSQG + (size_t)row * 64 + k * 16; const f32x4 a0 = *(const f32x4*)pg, a1 = *(const f32x4*)(pg + 4), a2 = *(const f32x4*)(pg + 8), a3 = *(const f32x4*)(pg + 12);
            const f32x4 t = (a0 + a1) + (a2 + a3); sc[k] = rsqrtf(((t[0] + t[1]) + (t[2] + t[3])) * (1.0f / 512.f) + EPS);
            const float* ph = SSQH + (size_t)row * 64 + ((((k + 4) * 64 + lane) * 8 - 2048) >> 8) * 8; const f32x4 b0 = *(const f32x4*)ph, b1 = *(const f32x4*)(ph + 4);
            const f32x4 u = b0 + b1; sc[k + 4] = rsqrtf(((u[0] + u[1]) + (u[2] + u[3])) * (1.0f / 256.f) + EPS); }
#pragma unroll
        for (int k = 0; k < 8; ++k) {
            float x[8] = {bflo(w[k].x), bfhi(w[k].x), bflo(w[k].y), bfhi(w[k].y), bflo(w[k].z), bfhi(w[k].z), bflo(w[k].w), bfhi(w[k].w)};
            if (k < 4) {
#pragma unroll
                for (int i = 0; i < 8; ++i) x[i] *= sc[k];
            } else { const v4u q = gq[k - 4]; const float gv[8] = {bflo(q.x), bfhi(q.x), bflo(q.y), bfhi(q.y), bflo(q.z), bfhi(q.z), bflo(q.w), bfhi(q.w)};
#pragma unroll
                for (int i = 0; i < 8; ++i) x[i] = x[i] * sc[k] * silu_f(gv[i]); }
            v4u o; o.x = pk2(x[0], x[1]); o.y = pk2(x[2], x[3]); o.z = pk2(x[4], x[5]); o.w = pk2(x[6], x[7]);
            *(v4u*)(T1 + (size_t)row * 4096 + (k * 64 + lane) * 8) = o;
        }
    }
}
__device__ __forceinline__ void ph_wout(const Ctx& C) { res_gemm<16, false>(C, (const bf16*)(W_SCR + S_T1), 4096, (const bf16*)(C.ws + O_WOUT), 4096, nullptr, 1.0f, W_SSQ + (size_t)2 * M, (float*)(W_SCR + S_ZG)); }
__device__ __forceinline__ void ph_woutfin(const Ctx& C) { ph_fin<false>(C, (const float*)(W_SCR + S_ZG), 16, nullptr, 1.0f, W_SSQ + (size_t)2 * M); }
constexpr float MLA_SC = 0.07216878364870322f, MEM_SC = 0.08838834764831845f, LOG2E = 1.4426950408889634f;
__device__ __forceinline__ void ph_cwin(const Ctx& C, const Params& P) {
    CTX_GT();
    cvt_bulk(P.in[I_CCKV], (bf16*)(W_SCR + S_CKVPAST), (size_t)65536 * 512 / 8, gt, NGT);
    cvt_bulk(P.in[I_CKPE], (bf16*)(W_SCR + S_KPEPAST), (size_t)65536 * 64 / 8, gt, NGT);
    pg8::Gemm g{W_XB, (const bf16*)(C.ws + O_CWIN), M, CWIN_N, D, XBP, D}; pg8::StaticOrder S = make_order(M, CWIN_N, C.G, C.wg, 0);
    EpiF32 E{(float*)(W_SCR + S_CIN), CWIN_N, W_SSQ + (size_t)5 * M};
    pg8::gemm_phase<EpiF32, pg8::StaticOrder, true, true>(C.lds, g, S, E, C.wave);
}
__device__ __forceinline__ void ph_nr(const Ctx& C, const Params& P) {
    CTX_GW(); const int lane = lane_id(); float* out = C.out;
    const float* CIN = (const float*)(W_SCR + S_CIN); bf16* CQN = (bf16*)(W_SCR + S_CQN); bf16* CKVB = (bf16*)(W_SCR + S_CKVB); bf16* KPEB = (bf16*)(W_SCR + S_KPEB);
    const float* COSM = (const float*)(C.ws + O_COSM); const float* SINM = (const float*)(C.ws + O_SINM);
    const float* qn = P.in[I_QNORM]; const float* kvn = P.in[I_KVNORM];
    for (int row = gw; row < M; row += NGW) {
        const float* ci = CIN + (size_t)row * CWIN_N;
        const f32x4 q0 = *(const f32x4*)(ci + lane * 8), q1 = *(const f32x4*)(ci + lane * 8 + 4);
        const f32x4 k0 = *(const f32x4*)(ci + 512 + lane * 8), k1 = *(const f32x4*)(ci + 512 + lane * 8 + 4);
        float sq = (q0[0] * q0[0] + q0[1] * q0[1]) + (q0[2] * q0[2] + q0[3] * q0[3]) + (q1[0] * q1[0] + q1[1] * q1[1]) + (q1[2] * q1[2] + q1[3] * q1[3]);
        float sk = (k0[0] * k0[0] + k0[1] * k0[1]) + (k0[2] * k0[2] + k0[3] * k0[3]) + (k1[0] * k1[0] + k1[1] * k1[1]) + (k1[2] * k1[2] + k1[3] * k1[3]);
        sq = wave_sum(sq); sk = wave_sum(sk);
        const float rq = rsqrtf(sq * (1.0f / 512.f) + EPS), rk = rsqrtf(sk * (1.0f / 512.f) + EPS);
        const f32x4 g0 = *(const f32x4*)(qn + lane * 8), g1 = *(const f32x4*)(qn + lane * 8 + 4), n0 = *(const f32x4*)(kvn + lane * 8), n1 = *(const f32x4*)(kvn + lane * 8 + 4);
        const f32x4 a0 = q0 * rq * g0, a1 = q1 * rq * g1, c0 = k0 * rk * n0, c1 = k1 * rk * n1;
        v4u w; w.x = pk2(a0[0], a0[1]); w.y = pk2(a0[2], a0[3]); w.z = pk2(a1[0], a1[1]); w.w = pk2(a1[2], a1[3]);
        *(v4u*)(CQN + (size_t)row * 512 + lane * 8) = w;
        v4u z; z.x = pk2(c0[0], c0[1]); z.y = pk2(c0[2], c0[3]); z.z = pk2(c1[0], c1[1]); z.w = pk2(c1[2], c1[3]);
        *(v4u*)(CKVB + (size_t)row * 512 + lane * 8) = z;
        float* co = row < MP ? out + OUT_CKVP + (size_t)row * 512 : out + OUT_CKVS + (size_t)(row - MP) * 512;
        *(f32x4*)(co + lane * 8) = c0; *(f32x4*)(co + lane * 8 + 4) = c1;
        if (lane < 32) {
            const int pos = pos_of_row(row); const float x1 = ci[1024 + lane], x2 = ci[1024 + 32 + lane];
            const float cv = COSM[(size_t)pos * 32 + lane], sv = SINM[(size_t)pos * 32 + lane];
            const float y1 = x1 * cv - x2 * sv, y2 = x2 * cv + x1 * sv;
            float* ko = row < MP ? out + OUT_KPEP + (size_t)row * 64 : out + OUT_KPES + (size_t)(row - MP) * 64;
            ko[lane] = y1; ko[32 + lane] = y2;
            KPEB[(size_t)row * 64 + lane] = (bf16)f2bf(y1); KPEB[(size_t)row * 64 + 32 + lane] = (bf16)f2bf(y2);
        }
    }
}
__device__ __forceinline__ void ph_uq(const Ctx& C) {
    bf16* CKVB = (bf16*)(W_SCR + S_CKVB);
    { pg8::Gemm g{(const bf16*)(W_SCR + S_CQN), (const bf16*)(C.ws + O_WUQ), M, 3072, 512, 512, 512}; pg8::StaticOrder S = make_order(M, 3072, C.G, C.wg, 0);
      EpiUq E{(bf16*)(W_SCR + S_QN), (bf16*)(W_SCR + S_QR), (const float*)(C.ws + O_COSM), (const float*)(C.ws + O_SINM)};
      pg8::gemm_phase<EpiUq, pg8::StaticOrder, true, true>(C.lds, g, S, E, C.wave); }
    { pg8::Gemm g{CKVB, (const bf16*)(C.ws + O_WKV), MP, 4096, 512, 512, 512}; pg8::StaticOrder S = make_order(MP, 4096, C.G, C.wg, (130 * 12) % 256);
      EpiPlain E{(bf16*)(W_SCR + S_KNV), 4096, nullptr};
      pg8::gemm_phase<EpiPlain, pg8::StaticOrder, true, true>(C.lds, g, S, E, C.wave); }
    { pg8::Gemm g{CKVB + (size_t)MP * 512, (const bf16*)(C.ws + O_WKV), MS, 4096, 512, 512, 512}; pg8::StaticOrder S = make_order(MS, 4096, C.G, C.wg, (130 * 12) % 256);
      EpiPlain E{(bf16*)(W_SCR + S_KNVN), 4096, nullptr};
      pg8::gemm_phase<EpiPlain, pg8::StaticOrder, true, true>(C.lds, g, S, E, C.wave); }
}
__device__ __forceinline__ void ph_attp(const Ctx& C) {
    const int wid = C.wave, r32 = lane_id() & 31, G = C.G, wg = C.wg;
    const bf16* KNV = (const bf16*)(W_SCR + S_KNV); const bf16* KPEB = (const bf16*)(W_SCR + S_KPEB); const bf16* QN = (const bf16*)(W_SCR + S_QN); const bf16* QR = (const bf16*)(W_SCR + S_QR);
    bf16* OB = (bf16*)(W_SCR + S_OB);
    const int nun = (G == 256) ? 8 : (2048 + G - 1) / G;
#pragma unroll 1
    for (int i = 0; i < nun; ++i) {
        int pr, qb;
        if (G == 256) { const int k4 = (wg >> 3) & 3; pr = (wg & 7) + 8 * (wg >> 5); qb = 4 * i + ((i & 1) ? 3 - k4 : k4); }
        else { const int u = wg + i * G; if (u >= 2048) break; pr = u >> 5; qb = u & 31; }
        const int b = pr >> 4, h = pr & 15;
        const int row = b * SEQ + qb * 256 + wid * 32 + r32;
        const bf16* kbase = KNV + (size_t)(b * SEQ) * 4096 + h * 128; const bf16* rbase = KPEB + (size_t)(b * SEQ) * 64;
        auto kn = [=](int k) -> const bf16* { return kbase + (size_t)k * 4096; };
        auto vv = [=](int k) -> const bf16* { return kbase + (size_t)k * 4096 + 2048; };
        auto kr = [=](int k) -> const bf16* { return rbase + (size_t)k * 64; };
        const int kmax = (qb * 4 + (wid >> 1) + 1) * 64;
        att::attn_unit<64, false, false>(C.lds, QN + (size_t)row * D + h * 128, QR + (size_t)row * 1024 + h * 64, kn, kr, vv, 4 * (qb + 1), kmax, MLA_SC * LOG2E, 8.0f / MLA_SC,
                           OB + (size_t)(b * SEQ + qb * 256 + wid * 32) * D + h * 128, D, 32, true, C.wave);
    }
}
__device__ __forceinline__ void ph_exp(const Ctx& C, int hb) {
    pg8::Gemm g{(const bf16*)(W_SCR + S_CKVPAST) + (size_t)hb * 32768 * 512, (const bf16*)(C.ws + O_WKV), 32768, 4096, 512, 512, 512}; pg8::StaticOrder S = make_order(32768, 4096, C.G, C.wg, 0);
    EpiPlain E{(bf16*)(W_SCR + S_KNV), 4096, nullptr};
    pg8::gemm_phase<EpiPlain, pg8::StaticOrder, true, true>(C.lds, g, S, E, C.wave);
}
__device__ __forceinline__ void ph_atts(const Ctx& C, int hb) {
    const int wid = C.wave, r32 = lane_id() & 31;
    const bf16* KNV = (const bf16*)(W_SCR + S_KNV); const bf16* KNVN = (const bf16*)(W_SCR + S_KNVN); const bf16* KPEB = (const bf16*)(W_SCR + S_KPEB); const bf16* KPEPAST = (const bf16*)(W_SCR + S_KPEPAST);
    const bf16* QN = (const bf16*)(W_SCR + S_QN); const bf16* QR = (const bf16*)(W_SCR + S_QR); bf16* OB = (bf16*)(W_SCR + S_OB);
#pragma unroll 1
    for (int u = C.wg; u < 256; u += C.G) {
        const int bl = u >> 4, h = u & 15, b = hb * 16 + bl;
        const int row = MP + b * TS + (r32 & 15);
        const bf16* pbase = KNV + (size_t)(bl * PAST) * 4096 + h * 128; const bf16* nbase = KNVN + (size_t)(b * TS) * 4096 + h * 128;
        const bf16* rpast = KPEPAST + (size_t)(b * PAST) * 64; const bf16* rnew = KPEB + (size_t)(MP + b * TS) * 64;
        auto kn = [=](int k) -> const bf16* { return k < PAST ? pbase + (size_t)k * 4096 : (k < PAST + TS ? nbase + (size_t)(k - PAST) * 4096 : nullptr); };
        auto vv = [=](int k) -> const bf16* { return k < PAST ? pbase + (size_t)k * 4096 + 2048 : (k < PAST + TS ? nbase + (size_t)(k - PAST) * 4096 + 2048 : nullptr); };
        auto kr = [=](int k) -> const bf16* { return k < PAST ? rpast + (size_t)k * 64 : (k < PAST + TS ? rnew + (size_t)(k - PAST) * 64 : nullptr); };
        att::attn_unit<64, false, true>(C.lds, QN + (size_t)row * D + h * 128, QR + (size_t)row * 1024 + h * 64, kn, kr, vv, 33, PAST + TS, MLA_SC * LOG2E, 8.0f / MLA_SC,
                           OB + (size_t)(MP + b * TS) * D + h * 128, D, 16, wid == 0, C.wave);
    }
}
__device__ __forceinline__ void ph_cwout(const Ctx& C) { res_gemm<8, false>(C, (const bf16*)(W_SCR + S_OB), D, (const bf16*)(C.ws + O_CWOUT), D, nullptr, 1.0f, W_SSQ + (size_t)6 * M, (float*)(W_SCR + S_KNV)); }
__device__ __forceinline__ void ph_cwoutfin(const Ctx& C) { ph_fin<false>(C, (const float*)(W_SCR + S_KNV), 8, nullptr, 1.0f, W_SSQ + (size_t)6 * M); }
__device__ __forceinline__ void ph_mq(const Ctx& C, const Params& P, int L) {
    CTX_GT();
    cvt_bulk(P.in[I_CMK] + (size_t)L * 32 * 256 * 512, (bf16*)(W_SCR + S_CMK), (size_t)32 * 256 * 512 / 8, gt, NGT);
    cvt_bulk(P.in[I_CMV] + (size_t)L * 32 * 256 * 512, (bf16*)(W_SCR + S_CMV), (size_t)32 * 256 * 512 / 8, gt, NGT);
    { pg8::Gemm g{W_XB, (const bf16*)(C.ws + O_WMQ) + (size_t)L * 512 * D, MP, 512, D, XBP, D}; pg8::StaticOrder S = make_order(MP, 512, C.G, C.wg, 0);
      EpiPlain E{(bf16*)(W_SCR + S_QM), 512, W_SSQ + (size_t)(L * 4 + 2) * M};
      pg8::gemm_phase<EpiPlain, pg8::StaticOrder, true, true>(C.lds, g, S, E, C.wave); }
    { pg8::Gemm g{W_XB + (size_t)MP * XBP, (const bf16*)(C.ws + O_WMQ) + (size_t)L * 512 * D, MS, 512, D, XBP, D / 8}; SplitOrder S; S.init(MS, 512, 8, C.G, C.wg);
      EpiPart E{(float*)(W_SCR + S_PARTQ), 512, (size_t)MS * 512};
      pg8::gemm_phase<EpiPart, SplitOrder, true, true>(C.lds, g, S, E, C.wave); }
}
__device__ __forceinline__ void ph_matt(const Ctx& C, int L) {
    const int wid = C.wave, r32 = lane_id() & 31;
    const bf16* QM = (const bf16*)(W_SCR + S_QM); bf16* OM = (bf16*)(W_SCR + S_OM); const bf16* CMK = (const bf16*)(W_SCR + S_CMK); const bf16* CMV = (const bf16*)(W_SCR + S_CMV);
    const bf16* MKV = (const bf16*)(C.ws + O_MKV);
    auto kr0 = [=](int) -> const bf16* { return nullptr; };
#pragma unroll 1
    for (int u = C.wg; u < 512 + 128; u += C.G) {
        const bool pr = u < 512; const int v = pr ? u : u - 512;
        const int b = pr ? v >> 7 : v >> 2, h = pr ? (v >> 5) & 3 : v & 3, qb = v & 31;
        const int row = pr ? b * SEQ + qb * 256 + wid * 32 + r32 : MP + b * TS + (r32 & 15);
        const bf16* kb_ = pr ? MKV + (size_t)(L * 1024 + b * 256) * 1024 + h * 128 : CMK + (size_t)(b * 256) * 512 + h * 128;
        const bf16* vb_ = pr ? kb_ + 512 : CMV + (size_t)(b * 256) * 512 + h * 128;
        const int kp = pr ? 1024 : 512;
        auto kn = [=](int k) -> const bf16* { return kb_ + (size_t)k * kp; };
        auto vv = [=](int k) -> const bf16* { return vb_ + (size_t)k * kp; };
        if (!pr) {
            const int t = wid * 64 + lane_id(), r = t >> 5, c4 = (t & 31) * 4; const size_t o = (size_t)(b * TS + r) * 512 + h * 128 + c4;
            const float* pq = (const float*)(W_SCR + S_PARTQ); f32x4 a = *(const f32x4*)(pq + o);
#pragma unroll
            for (int k = 1; k < 8; ++k) a += *(const f32x4*)(pq + (size_t)k * MS * 512 + o);
            const float rs = rsqrtf(ssq_get(W_SSQ + (size_t)(L * 4 + 2) * M + MP + b * TS + r) * (1.0f / D) + EPS);
            v2u w; w.x = pk2(a[0] * rs, a[1] * rs); w.y = pk2(a[2] * rs, a[3] * rs);
            *(v2u*)((bf16*)(W_SCR + S_QM) + (size_t)MP * 512 + o) = w;
            VM_WAIT(); __syncthreads();
        }
        att::attn_unit<0, false, false>(C.lds, QM + (size_t)row * 512 + h * 128, nullptr, kn, kr0, vv, 4, 256, MEM_SC * LOG2E, 8.0f / MEM_SC,
                          OM + (size_t)(pr ? b * SEQ + qb * 256 + wid * 32 : MP + b * TS) * 512 + h * 128, 512, pr ? 32 : 16, pr ? true : wid == 0, C.wave);
    }
}
__device__ __forceinline__ void ph_mo(const Ctx& C, int L) {
    pg8::Gemm g{(const bf16*)(W_SCR + S_OM), (const bf16*)(C.ws + O_WMO) + (size_t)L * D * 512, M, D, 512, 512, 512}; pg8::StaticOrder S = make_order(M, D, C.G, C.wg, 0);
    EpiRes<false> E{nullptr, W_XB, W_SSQ + (size_t)(L * 4 + 3) * M, 1.0f};
    pg8::gemm_phase<EpiRes<false>, pg8::StaticOrder, true, true>(C.lds, g, S, E, C.wave);
}
__device__ __forceinline__ void ph_final(const Ctx& C, const Params& P) {
    CTX_GW(); const int lane = lane_id(); float* Y = W_X; const bf16* XB = W_XB;
    const float* fn = P.in[I_FNORM]; const u64* sq = W_SSQ + (size_t)8 * M;
    for (int row = gw; row < M; row += NGW) {
        const float rs = rsqrtf(ssq_get(sq + row) * (1.0f / D) + EPS); float* yr = Y + (size_t)row * D; const bf16* xr = XB + (size_t)row * XBP;
        v4u q[4];
#pragma unroll
        for (int j = 0; j < 4; ++j) q[j] = *(const v4u*)(xr + 8 * (lane + 64 * j));
#pragma unroll
        for (int j = 0; j < 4; ++j) { const int c = 8 * (lane + 64 * j); const f32x4 g0 = *(const f32x4*)(fn + c), g1 = *(const f32x4*)(fn + c + 4);
            __builtin_nontemporal_store((f32x4){bflo(q[j].x), bfhi(q[j].x), bflo(q[j].y), bfhi(q[j].y)} * rs * g0, (f32x4*)(yr + c)); __builtin_nontemporal_store((f32x4){bflo(q[j].z), bfhi(q[j].z), bflo(q[j].w), bfhi(q[j].w)} * rs * g1, (f32x4*)(yr + c + 4)); }
    }
}

__global__ void __launch_bounds__(NWAVES * 64, 2) mk_fwd(Params P) {
    extern __shared__ __attribute__((aligned(16))) unsigned char lds_raw[];
    Ctx C; C.lds = (LAS unsigned char*)lds_raw; C.ws = P.ws; C.out = P.out; C.G = gridDim.x; C.wg = blockIdx.x; C.wave = __builtin_amdgcn_readfirstlane((int)threadIdx.x >> 6);
    volatile LAS unsigned* MISC = (volatile LAS unsigned*)(C.lds + MISC_OFF);
    for (int u = C.wave * 64 + lane_id(); u < (LDS_BYTES - MISC_OFF) / 4; u += NWAVES * 64) ((LAS unsigned*)(C.lds + MISC_OFF))[u] = 0u;
    __syncthreads();
    XcdBarrier bar = xcd_barrier_post((unsigned*)(P.ws + O_CTL) + 4096, MISC + 8, C.wave); bar.t0 = (C.wave == 0);
    const int lo = P.ph_lo, hi_ph = P.ph_hi;
#define RUN(k, call) do { if (lo <= (k) && (k) < hi_ph) { if ((k) > lo) xcd_barrier(bar); call; } } while (0)
    RUN(0, ph_prologue(C, P));
    RUN(1, ph_w1(C, 0));    RUN(2, ph_w2<true>(C, P, 0));    RUN(3, ph_w2fin<true>(C, P, 0));
    RUN(4, ph_win(C, P));   RUN(5, ph_halo(C));        RUN(6, ph_conv(C, P));     RUN(7, ph_scan(C, P));   RUN(8, ph_norm(C));   RUN(9, ph_wout(C));   RUN(10, ph_woutfin(C));
    RUN(11, ph_mq(C, P, 0));   RUN(12, ph_matt(C, 0));   RUN(13, ph_mo(C, 0));
    RUN(14, ph_w1(C, 1));   RUN(15, ph_w2<false>(C, P, 1));   RUN(16, ph_w2fin<false>(C, P, 1));
    RUN(17, ph_w1(C, 2));   RUN(18, ph_w2<false>(C, P, 2));   RUN(19, ph_w2fin<false>(C, P, 2));
    RUN(20, ph_cwin(C, P));   RUN(21, ph_nr(C, P));   RUN(22, ph_uq(C));   RUN(23, ph_attp(C));
    RUN(24, ph_exp(C, 0));   RUN(25, ph_atts(C, 0));   RUN(26, ph_exp(C, 1));   RUN(27, ph_atts(C, 1));   RUN(28, ph_cwout(C));   RUN(29, ph_cwoutfin(C));
    RUN(30, ph_mq(C, P, 1));   RUN(31, ph_matt(C, 1));   RUN(32, ph_mo(C, 1));
    RUN(33, ph_w1(C, 3));   RUN(34, ph_w2<false>(C, P, 3));   RUN(35, ph_w2fin<false>(C, P, 3));
    RUN(36, ph_final(C, P));
#undef RUN
}
extern "C" void kernel_launch(void* const* d_in, const int* in_sizes, int n_in, void* d_out, int out_size, void* d_ws, size_t ws_size, hipStream_t stream) {
    static int grid = 0;
    if (grid == 0) {
        if (n_in != N_IN || (size_t)out_size != OUT_END || ws_size < WS_NEED) {
            fprintf(stderr, "kernel_launch: unexpected shapes: n_in %d out %d ws %zu (need %zu)\n", n_in, out_size, ws_size, (size_t)WS_NEED); grid = -1; return; }
        int dev = 0, cus = 0;
        if (hipGetDevice(&dev) != hipSuccess || hipDeviceGetAttribute(&cus, hipDeviceAttributeMultiprocessorCount, dev) != hipSuccess) { grid = -1; return; }
        if (hipFuncSetAttribute((const void*)mk_fwd, hipFuncAttributeMaxDynamicSharedMemorySize, LDS_BYTES) != hipSuccess) { fprintf(stderr, "kernel_launch: hipFuncSetAttribute failed\n"); grid = -1; return; }
        int per_cu = 0;
        if (hipOccupancyMaxActiveBlocksPerMultiprocessor(&per_cu, (const void*)mk_fwd, NWAVES * 64, LDS_BYTES) != hipSuccess || per_cu < 1) { fprintf(stderr, "kernel_launch: occupancy query says %d\n", per_cu); }
        (void)hipGetLastError();
        grid = cus;
    }
    if (grid < 0) return;
    (void)hipMemsetAsync((char*)d_ws, 0, O_ZEND, stream);
    Params p{};
    for (int i = 0; i < N_IN; ++i) p.in[i] = (const float*)d_in[i];
    p.out = (float*)d_out; p.ws = (unsigned char*)d_ws;
#ifndef MK_PER_PHASE
    p.ph_lo = 0; p.ph_hi = N_PHASES;
    hipLaunchKernelGGL(mk_fwd, dim3(grid), dim3(NWAVES * 64), LDS_BYTES, stream, p);
#else
    for (int k = 0; k < N_PHASES; ++k) { p.ph_lo = k; p.ph_hi = k + 1; hipLaunchKernelGGL(mk_fwd, dim3(grid), dim3(NWAVES * 64), LDS_BYTES, stream, p); }
#endif
}
```
